# Optimizing an MI355X kernel written in HIP

```python
import jax, jax.numpy as jnp
from jax import lax
import numpy as np

D_MODEL = 1024
BATCH = 4
SEQ = 4096
DEPTH = 2

N_EVEN = (DEPTH + 1) // 2
N_ODD = DEPTH // 2
D_FF = 2816
RMS_EPS = 1e-6
ROPE_THETA = 10000.0

GLA_HEADS = 4
GLA_DK = 64
GLA_DV = 128
GLA_GATE_RANK = 16
GLA_GATE_TAU = 16.0
GLA_CHUNK = 64

POOL_WINDOWS = (2, 4, 8, 16)
POOL_GROUPS = 4
POOL_GROUP_DIM = 128
POOL_DIM = POOL_GROUPS * POOL_GROUP_DIM

ATT_HEADS = 8
ATT_KV_HEADS = 2
ATT_HEAD_DIM = 128
IDX_HEADS = 4
IDX_DIM = 64
TOPK_MAX = 256
Q_BLOCK = 128

EVEN_SIZES = (GLA_HEADS * GLA_DK, GLA_HEADS * GLA_DK, GLA_HEADS * GLA_DV, GLA_HEADS * GLA_DV, GLA_GATE_RANK, POOL_DIM)
EVEN_IN = sum(EVEN_SIZES)
EVEN_SPLITS = tuple(int(s) for s in np.cumsum(EVEN_SIZES)[:-1])
EVEN_MIX = GLA_HEADS * GLA_DV + POOL_DIM
ODD_SIZES = (ATT_HEADS * ATT_HEAD_DIM, ATT_KV_HEADS * ATT_HEAD_DIM, ATT_KV_HEADS * ATT_HEAD_DIM, IDX_HEADS * IDX_DIM, IDX_DIM, IDX_HEADS)
ODD_IN = sum(ODD_SIZES)
ODD_SPLITS = tuple(int(s) for s in np.cumsum(ODD_SIZES)[:-1])
ODD_MIX = ATT_HEADS * ATT_HEAD_DIM

kernel_name = "hybrid_gla_pool_dsa_macaron"


def rms_norm(x, g):
    xf = x.astype(jnp.float32)
    y = xf * lax.rsqrt(jnp.mean(xf * xf, axis=-1, keepdims=True) + RMS_EPS)
    return (y * g.astype(jnp.float32)).astype(x.dtype)


def swiglu(x, wi, wo):
    gate, up = jnp.split(x @ wi, 2, axis=-1)
    return (jax.nn.silu(gate) * up) @ wo


def rope(x, positions):
    d = x.shape[-1]
    inv = ROPE_THETA ** (-jnp.arange(0, d, 2, dtype=jnp.float32) / d)
    ang = positions.astype(jnp.float32)[..., None] * inv
    cos = jnp.cos(ang)[:, :, None, :]
    sin = jnp.sin(ang)[:, :, None, :]
    xf = x.astype(jnp.float32)
    x1, x2 = jnp.split(xf, 2, axis=-1)
    out = jnp.concatenate([x1 * cos - x2 * sin, x2 * cos + x1 * sin], axis=-1)
    return out.astype(x.dtype)


def gla_chunked(q, k, v, log_a):
    B, S, H, DK = q.shape
    DV = v.shape[-1]
    C = GLA_CHUNK
    n = S // C

    def to_chunks(t):
        return t.astype(jnp.float32).reshape(B, n, C, H, t.shape[-1]).transpose(1, 0, 3, 2, 4)

    qc = to_chunks(q.astype(jnp.float32) * (DK ** -0.5))
    kc, vc, ac = to_chunks(k), to_chunks(v), to_chunks(log_a)
    causal = jnp.tril(jnp.ones((C, C), dtype=bool))[:, :, None]

    def step(state, inp):
        qb, kb, vb, ab = inp
        b = jnp.cumsum(ab, axis=2)
        inter = jnp.einsum('bhcd,bhde->bhce', qb * jnp.exp(b), state)
        rel = jnp.where(causal, b[:, :, :, None, :] - b[:, :, None, :, :], -jnp.inf)
        scores = jnp.einsum('bhid,bhjd,bhijd->bhij', qb, kb, jnp.exp(rel))
        intra = jnp.einsum('bhij,bhje->bhie', scores, vb)
        b_last = b[:, :, -1, :]
        k_dec = kb * jnp.exp(b_last[:, :, None, :] - b)
        state = jnp.exp(b_last)[..., None] * state + jnp.einsum('bhcd,bhce->bhde', k_dec, vb)
        return state, inter + intra

    s0 = jnp.zeros((B, H, DK, DV), jnp.float32)
    _, out = lax.scan(step, s0, (qc, kc, vc, ac))
    return out.transpose(1, 0, 3, 2, 4).reshape(B, S, H, DV)


def multiscale_pool(u):
    B, S, _ = u.shape
    ug = u.astype(jnp.float32).reshape(B, S, POOL_GROUPS, POOL_GROUP_DIM)
    csum = jnp.cumsum(ug, axis=1)
    t = jnp.arange(1, S + 1, dtype=jnp.float32)
    outs = []
    for g, w in enumerate(POOL_WINDOWS):
        c = csum[:, :, g]
        c_prev = jnp.pad(c, ((0, 0), (w, 0), (0, 0)))[:, :S]
        count = jnp.minimum(t, float(w))[None, :, None]
        outs.append((c - c_prev) / count - ug[:, :, g])
    return jnp.stack(outs, axis=2)


def gla_pool_mixer(hn, w_in, gate_w, gate_b, out_norm, pool_w, pool_scale, w_out):
    B, S, _ = hn.shape
    proj = hn @ w_in
    q, k, v, g, a_lr, u = jnp.split(proj, EVEN_SPLITS, axis=-1)
    log_a = jax.nn.log_sigmoid((a_lr @ gate_w + gate_b).astype(jnp.float32)) / GLA_GATE_TAU
    o = gla_chunked(q.reshape(B, S, GLA_HEADS, GLA_DK), k.reshape(B, S, GLA_HEADS, GLA_DK),
                    v.reshape(B, S, GLA_HEADS, GLA_DV), log_a.reshape(B, S, GLA_HEADS, GLA_DK))
    o = rms_norm(o, out_norm.reshape(GLA_HEADS, GLA_DV)).reshape(B, S, GLA_HEADS * GLA_DV)
    o = (o * jax.nn.silu(g.astype(jnp.float32))).astype(hn.dtype)
    p = multiscale_pool(u)
    p = jnp.einsum('bsgc,gcd->bsgd', p, pool_w.astype(jnp.float32)).reshape(B, S, POOL_DIM)
    p = (p * pool_scale.astype(jnp.float32)).astype(hn.dtype)
    return jnp.concatenate([o, p], axis=-1) @ w_out


def dsa_attention(q, k, v, qi, ki, wi):
    B, S, H, Dh = q.shape
    G = k.shape[2]
    R = H // G
    top_k = min(TOPK_MAX, S // 4)
    n_blocks = S // Q_BLOCK
    idx_scale = (IDX_DIM ** -0.5) * (IDX_HEADS ** -0.5)
    key_pos = jnp.arange(S)
    ki_f = ki.astype(jnp.float32)

    def block(i):
        start = i * Q_BLOCK
        qb = lax.dynamic_slice_in_dim(q, start, Q_BLOCK, axis=1).reshape(B, Q_BLOCK, G, R, Dh)
        qib = lax.dynamic_slice_in_dim(qi, start, Q_BLOCK, axis=1).astype(jnp.float32)
        wib = lax.dynamic_slice_in_dim(wi, start, Q_BLOCK, axis=1).astype(jnp.float32)
        q_pos = start + jnp.arange(Q_BLOCK)
        logits = jax.nn.relu(jnp.einsum('bthd,bsd->bths', qib, ki_f))
        iscore = jnp.einsum('bth,bths->bts', wib, logits) * idx_scale
        admissible = key_pos[None, :] <= q_pos[:, None]
        iscore = jnp.where(admissible[None], iscore, -jnp.inf)
        _, sel = lax.top_k(iscore, top_k)
        valid = sel <= q_pos[None, :, None]
        k_sel = jax.vmap(lambda a, ix: a[ix])(k, sel)
        v_sel = jax.vmap(lambda a, ix: a[ix])(v, sel)
        s = jnp.einsum('btgrd,btkgd->btgrk', qb.astype(jnp.float32), k_sel.astype(jnp.float32)) * (Dh ** -0.5)
        s = jnp.where(valid[:, :, None, None, :], s, -jnp.inf)
        p = jax.nn.softmax(s, axis=-1)
        o = jnp.einsum('btgrk,btkgd->btgrd', p, v_sel.astype(jnp.float32))
        return o.reshape(B, Q_BLOCK, H * Dh).astype(q.dtype)

    out = lax.map(block, jnp.arange(n_blocks))
    return out.transpose(1, 0, 2, 3).reshape(B, S, H * Dh)


def dsa_mixer(hn, positions, w_in, w_out):
    B, S, _ = hn.shape
    proj = hn @ w_in
    q, k, v, qi, ki, wi = jnp.split(proj, ODD_SPLITS, axis=-1)
    q = rope(q.reshape(B, S, ATT_HEADS, ATT_HEAD_DIM), positions)
    k = rope(k.reshape(B, S, ATT_KV_HEADS, ATT_HEAD_DIM), positions)
    v = v.reshape(B, S, ATT_KV_HEADS, ATT_HEAD_DIM)
    qi = rope(qi.reshape(B, S, IDX_HEADS, IDX_DIM), positions)
    ki = rope(ki.reshape(B, S, 1, IDX_DIM), positions)[:, :, 0]
    o = dsa_attention(q, k, v, qi, ki, wi)
    return o @ w_out


def setup_inputs(seed: int = 0) -> dict:
    key = jax.random.key(seed)
    ks = jax.random.split(key, 20)
    f32 = jnp.float32

    def nrm(k, shape, scale):
        return jax.random.normal(k, shape, f32) * scale

    def gain(k, shape):
        return 1.0 + 0.02 * jax.random.normal(k, shape, f32)

    x = jax.random.normal(ks[0], (BATCH, SEQ, D_MODEL), f32)
    positions = jnp.broadcast_to(jnp.arange(SEQ, dtype=jnp.int32)[None, :], (BATCH, SEQ)).astype(jnp.int32)
    return {
        "x": x,
        "positions": positions,
        "ffn1_norm": gain(ks[1], (DEPTH, D_MODEL)),
        "ffn1_wi": nrm(ks[2], (DEPTH, D_MODEL, 2 * D_FF), D_MODEL ** -0.5),
        "ffn1_wo": nrm(ks[3], (DEPTH, D_FF, D_MODEL), D_FF ** -0.5),
        "mix_norm": gain(ks[4], (DEPTH, D_MODEL)),
        "ffn2_norm": gain(ks[5], (DEPTH, D_MODEL)),
        "ffn2_wi": nrm(ks[6], (DEPTH, D_MODEL, 2 * D_FF), D_MODEL ** -0.5),
        "ffn2_wo": nrm(ks[7], (DEPTH, D_FF, D_MODEL), D_FF ** -0.5),
        "even_w_in": nrm(ks[8], (N_EVEN, D_MODEL, EVEN_IN), D_MODEL ** -0.5),
        "gla_gate_w": nrm(ks[9], (N_EVEN, GLA_GATE_RANK, GLA_HEADS * GLA_DK), GLA_GATE_RANK ** -0.5),
        "gla_gate_b": nrm(ks[10], (N_EVEN, GLA_HEADS * GLA_DK), 0.1),
        "gla_out_norm": gain(ks[11], (N_EVEN, GLA_HEADS * GLA_DV)),
        "pool_w": nrm(ks[12], (N_EVEN, POOL_GROUPS, POOL_GROUP_DIM, POOL_GROUP_DIM), POOL_GROUP_DIM ** -0.5),
        "pool_scale": gain(ks[13], (N_EVEN, POOL_DIM)),
        "even_w_out": nrm(ks[14], (N_EVEN, EVEN_MIX, D_MODEL), EVEN_MIX ** -0.5),
        "odd_w_in": nrm(ks[15], (N_ODD, D_MODEL, ODD_IN), D_MODEL ** -0.5),
        "odd_w_out": nrm(ks[16], (N_ODD, ODD_MIX, D_MODEL), ODD_MIX ** -0.5),
        "final_norm": gain(ks[17], (D_MODEL,)),
    }


def reference(x, positions, ffn1_norm, ffn1_wi, ffn1_wo, mix_norm, ffn2_norm, ffn2_wi, ffn2_wo,
              even_w_in, gla_gate_w, gla_gate_b, gla_out_norm, pool_w, pool_scale, even_w_out,
              odd_w_in, odd_w_out, final_norm):
    h = x
    for li in range(DEPTH):
        h = h + 0.5 * swiglu(rms_norm(h, ffn1_norm[li]), ffn1_wi[li], ffn1_wo[li])
        hn = rms_norm(h, mix_norm[li])
        if li % 2 == 0:
            j = li // 2
            mix = gla_pool_mixer(hn, even_w_in[j], gla_gate_w[j], gla_gate_b[j], gla_out_norm[j],
                                 pool_w[j], pool_scale[j], even_w_out[j])
        else:
            j = li // 2
            mix = dsa_mixer(hn, positions, odd_w_in[j], odd_w_out[j])
        h = h + mix
        h = h + 0.5 * swiglu(rms_norm(h, ffn2_norm[li]), ffn2_wi[li], ffn2_wo[li])
    return rms_norm(h, final_norm)
```

```cpp
#include <hip/hip_runtime.h>
#include <hip/hip_cooperative_groups.h>
#include <cstdio>
#include <cstdint>
namespace cg = cooperative_groups;

#ifndef NDUP_P0
#define NDUP_P0 1
#endif
#ifndef NDUP_PROJ0
#define NDUP_PROJ0 1
#endif
#ifndef NDUP_G1
#define NDUP_G1 1
#endif
#ifndef NDUP_G3
#define NDUP_G3 1
#endif
#ifndef NDUP_PROJ1
#define NDUP_PROJ1 1
#endif
#ifndef NDUP_IDX
#define NDUP_IDX 1
#endif
#ifndef NDUP_ATT
#define NDUP_ATT 1
#endif
#ifndef NDUP_UP
#define NDUP_UP 1
#endif
#ifndef NDUP_DOWN
#define NDUP_DOWN 1
#endif
#ifndef NDUP_OUTP
#define NDUP_OUTP 1
#endif
constexpr int BATCH = 4, SEQ = 4096, DM = 1024, M = BATCH * SEQ, DFF = 2816, NFF = 2 * DFF;
constexpr int EVEN_IN = 2064, EVEN_N = 2304, ODD_IN = 1860, ODD_N = 2048;
constexpr float RMS_EPS = 1e-6f;
constexpr float QSCALE = 0.08838834764831845f * 1.4426950408889634f;

#define LAS __attribute__((address_space(3)))
typedef unsigned short bf16_t;
typedef short bf16x8 __attribute__((ext_vector_type(8)));
typedef short s16x4 __attribute__((ext_vector_type(4)));
typedef float f32x4 __attribute__((ext_vector_type(4)));
typedef float f32x2 __attribute__((ext_vector_type(2)));
typedef float f32x16 __attribute__((ext_vector_type(16)));
typedef unsigned u32x4 __attribute__((ext_vector_type(4)));
typedef unsigned u32x2 __attribute__((ext_vector_type(2)));

typedef __bf16 bf16x2_t __attribute__((ext_vector_type(2)));
__device__ __forceinline__ unsigned cvt_pk_bf16(float lo, float hi) { f32x2 v = {lo, hi}; bf16x2_t b = __builtin_convertvector(v, bf16x2_t); return __builtin_bit_cast(unsigned, b); }
__device__ __forceinline__ unsigned f2bf(float f) { unsigned u = __builtin_bit_cast(unsigned, f); return (u + 0x7fffu + ((u >> 16) & 1u)) >> 16; }
__device__ __forceinline__ float bf2f(unsigned h) { return __builtin_bit_cast(float, h << 16); }
__device__ __forceinline__ float rows_sum(float x) {
    { auto r = __builtin_amdgcn_permlane16_swap(__float_as_uint(x), __float_as_uint(x), false, false); x = __uint_as_float(r[0]) + __uint_as_float(r[1]); }
    { auto r = __builtin_amdgcn_permlane32_swap(__float_as_uint(x), __float_as_uint(x), false, false); x = __uint_as_float(r[0]) + __uint_as_float(r[1]); }
    return x; }
#define DPP_F(v, ctrl) __builtin_bit_cast(float, __builtin_amdgcn_update_dpp(0, __builtin_bit_cast(int, (float)(v)), (ctrl), 0xf, 0xf, true))
__device__ __forceinline__ void unpack8(const u32x4 w, f32x4& a, f32x4& b) {
    a[0] = __uint_as_float(w[0] << 16); a[1] = __uint_as_float(w[0] & 0xffff0000u); a[2] = __uint_as_float(w[1] << 16); a[3] = __uint_as_float(w[1] & 0xffff0000u);
    b[0] = __uint_as_float(w[2] << 16); b[1] = __uint_as_float(w[2] & 0xffff0000u); b[2] = __uint_as_float(w[3] << 16); b[3] = __uint_as_float(w[3] & 0xffff0000u); }
__device__ __forceinline__ u32x4 pack8(f32x4 a, f32x4 b) { u32x4 w; w.x = cvt_pk_bf16(a[0], a[1]); w.y = cvt_pk_bf16(a[2], a[3]); w.z = cvt_pk_bf16(b[0], b[1]); w.w = cvt_pk_bf16(b[2], b[3]); return w; }

constexpr size_t MiB = 1u << 20;
constexpr size_t WS_CTL = 0;
constexpr size_t WS_SSQ = 1 * MiB;
constexpr size_t WS_DVEC = 2 * MiB;
constexpr size_t WS_WI1 = 2 * MiB + 256 * 1024;
constexpr size_t WS_W = 3 * MiB;
constexpr size_t WS_WIT = WS_W;
constexpr size_t WS_WOT = WS_W + 44 * MiB;
constexpr size_t WS_EVIN = WS_W + 66 * MiB;
constexpr size_t WS_ODIN = WS_EVIN + 4608 * 1024;
constexpr size_t WS_EVOUT = WS_ODIN + 4 * MiB;
constexpr size_t WS_ODOUT = WS_EVOUT + 2 * MiB;
constexpr size_t WS_CS = 82 * MiB;
constexpr size_t WS_HB = 94 * MiB;
constexpr size_t WS_R = 126 * MiB;
constexpr size_t WS_HID = WS_R;
constexpr size_t WS_QK0 = WS_R, WS_V0 = WS_R + 16 * MiB, WS_G0 = WS_R + 32 * MiB, WS_U0 = WS_R + 48 * MiB, WS_LA = WS_R + 64 * MiB, WS_ST0 = WS_R + 80 * MiB;
constexpr size_t WS_MIX = WS_R + 96 * MiB;
constexpr size_t WS_Q1 = WS_R, WS_K1 = WS_R + 32 * MiB, WS_V1 = WS_R + 40 * MiB, WS_QIH = WS_R + 48 * MiB, WS_QIL = WS_R + 56 * MiB, WS_KIH = WS_R + 64 * MiB, WS_KIL = WS_R + 66 * MiB, WS_MASK = WS_R + 68 * MiB;
constexpr size_t WS_END = 256 * MiB;
static_assert(WS_V1 - WS_K1 == 8 * MiB, "att::VOFF");
static_assert(WS_MIX + 32 * MiB <= WS_END && WS_ODOUT + 2 * MiB <= WS_CS && WS_CS + 8 * MiB <= WS_HB + 4 * MiB && WS_HB + 32 * MiB <= WS_R, "ws map");

constexpr int RING_BYTES = 131072, LDS_BYTES = 147456;

struct KArgs {
    const float* x; const int* pos; const float* ffn1_norm; const float* ffn1_wi; const float* ffn1_wo; const float* mix_norm;
    const float* ffn2_norm; const float* ffn2_wi; const float* ffn2_wo; const float* even_w_in; const float* gate_w; const float* gate_b;
    const float* out_norm; const float* pool_w; const float* pool_scale; const float* even_w_out; const float* odd_w_in; const float* odd_w_out; const float* final_norm;
    float* out; unsigned char* ws;
};

namespace pg8 {
#define PG8_LAS __attribute__((address_space(3)))
constexpr int BM = 256, BK = 64, HALF = 128, HTB = HALF * BK * 2, STAGE_BYTES = 8 * HTB, NXCD = 8, WGM = 8;
__host__ __device__ __forceinline__ int lds_byte(int r, int c) { const int st = (r >> 4) * 2 + (c >> 5), rr = r & 15, cc = c & 31, ob = rr * 64 + cc * 2; return st * 1024 + (ob ^ (((ob >> 9) & 1) << 5)); }
__host__ __device__ __forceinline__ void stage_rc(int b, int& R, int& C) { const int st = b / 1024, sb = b % 1024, swz = sb ^ (((sb >> 9) & 1) << 5); R = (st >> 1) * 16 + swz / 64; C = (st & 1) * 32 + (swz % 64) / 2; }
__host__ __device__ __forceinline__ int perm32(int rho) { const int n = rho >> 4, i = rho & 15; return 8 * (i >> 2) + 4 * n + (i & 3); }
struct Unit { int pm, pn; };
struct Gemm { const bf16_t* A; const bf16_t* Bt; int M, N, K; };
struct StaticOrder {
    int nM, nN, nwg, G, c;
    __host__ __device__ void init(int M_, int N_, int G_, int c_) { nM = M_ / BM; nN = N_ / BM; nwg = nM * nN; G = G_; c = c_; }
    __host__ __device__ bool next(int i, Unit& u) const {
        const long L = (long)i * G + c; if (L >= nwg) return false;
        int wgid = (int)L; { const int q = nwg / NXCD, r = nwg % NXCD, xcd = wgid % NXCD, off = wgid / NXCD; wgid = (xcd < r ? xcd * (q + 1) : r * (q + 1) + (xcd - r) * q) + off; }
        const int nig = WGM * nN, gid = wgid / nig, fm = gid * WGM, gsz = (nM - fm) < WGM ? (nM - fm) : WGM;
        u.pm = fm + ((wgid % nig) % gsz); u.pn = (wgid % nig) / gsz; return true;
    }
    __device__ __forceinline__ void a_ready(const Unit&) const {}
    __device__ __forceinline__ void done(const Unit&) const {}
};

__device__ __forceinline__ float row_rs(const float* ssq, int row) {
    const f32x4* p = (const f32x4*)(ssq + (size_t)row * 16);
    const f32x4 a = p[0], b = p[1], c = p[2], d = p[3];
    const float s = ((a[0] + a[1]) + (a[2] + a[3])) + ((b[0] + b[1]) + (b[2] + b[3])) + ((c[0] + c[1]) + (c[2] + c[3])) + ((d[0] + d[1]) + (d[2] + d[3]));
    return __builtin_amdgcn_rsqf(s * (1.0f / 1024.0f) + RMS_EPS);
}
__device__ __forceinline__ float silu_f(float g) { return g * __builtin_amdgcn_rcpf(1.0f + __expf(-g)); }

__device__ __forceinline__ void rs8(const float* ssq, int row0, int fq, float (&rs)[2][4]) {
    f32x4 p[2][4];
#pragma unroll
    for (int ai = 0; ai < 2; ++ai)
#pragma unroll
        for (int m = 0; m < 4; ++m) p[ai][m] = *(const f32x4*)(ssq + (size_t)(row0 + ai * HALF + m * 16) * 16 + fq * 4);
#pragma unroll
    for (int ai = 0; ai < 2; ++ai)
#pragma unroll
        for (int m = 0; m < 4; ++m) { float t = (p[ai][m][0] + p[ai][m][1]) + (p[ai][m][2] + p[ai][m][3]); t = rows_sum(t);
            rs[ai][m] = __builtin_amdgcn_rsqf(t * (1.0f / 1024.0f) + RMS_EPS); }
}
__device__ __forceinline__ void rs4(const float* ssq, int row0, int fq, float (&rs)[4]) {
    f32x4 p[4];
#pragma unroll
    for (int m = 0; m < 4; ++m) p[m] = *(const f32x4*)(ssq + (size_t)(row0 + m * 16) * 16 + fq * 4);
#pragma unroll
    for (int m = 0; m < 4; ++m) { float t = (p[m][0] + p[m][1]) + (p[m][2] + p[m][3]); t = rows_sum(t); rs[m] = __builtin_amdgcn_rsqf(t * (1.0f / 1024.0f) + RMS_EPS); }
}
constexpr int RSB_OFF = 131072 + 10240;
__device__ __forceinline__ void rs_issue(const float* ssq, int pm, int tid, f32x4& p0, f32x4& p1) {
    const float* sp = ssq + ((size_t)pm * BM + (tid >> 1)) * 16 + (tid & 1) * 8; p0 = *(const f32x4*)sp; p1 = *(const f32x4*)(sp + 4); }
__device__ __forceinline__ void rs_commit(PG8_LAS unsigned char* lds, int parity, int tid, const f32x4 p0, const f32x4 p1) {
    float t = ((p0[0] + p0[1]) + (p0[2] + p0[3])) + ((p1[0] + p1[1]) + (p1[2] + p1[3]));
    t += __builtin_bit_cast(float, __builtin_amdgcn_update_dpp(0, __builtin_bit_cast(int, t), 0xB1, 0xF, 0xF, true));
    const float r = __builtin_amdgcn_rsqf(t * (1.0f / 1024.0f) + RMS_EPS);
    if ((tid & 1) == 0) *(PG8_LAS float*)(lds + RSB_OFF + parity * 1024 + (tid >> 1) * 4) = r; }
__device__ __forceinline__ void rs_read(const PG8_LAS float* rsb, int wr, int fr, float (&rs)[2][4]) {
    const PG8_LAS float* b = rsb + wr * 64 + fr;
#pragma unroll
    for (int ai = 0; ai < 2; ++ai)
#pragma unroll
        for (int m = 0; m < 4; ++m) rs[ai][m] = b[ai * HALF + m * 16]; }
struct EpiUp {
    static constexpr bool PERM = true, AFTER_DRAIN = false, IDEMPOTENT = true, USES_RS = true, RS_EARLY = true;
    const float* ssq; bf16_t* hid;
    __device__ __forceinline__ void operator()(const f32x4 (&acc)[2][2][4][2], const Unit& u, int wr, int wc, int fr, int fq, const PG8_LAS float* rsb) const {
        const int col0 = u.pn * 128 + wc * 32 + 8 * fq, row0 = u.pm * BM + wr * 64 + fr;
        float rs[2][4]; rs_read(rsb, wr, fr, rs);
#pragma unroll
        for (int ai = 0; ai < 2; ++ai)
#pragma unroll
            for (int m = 0; m < 4; ++m) {
                const int row = row0 + ai * HALF + m * 16; const float r = rs[ai][m], nr = r * -1.4426950408889634f, r2 = r * r;
                f32x4 o0, o1;
#pragma unroll
                for (int e = 0; e < 4; ++e) {
                    const float g0 = acc[ai][0][m][0][e], u0 = acc[ai][1][m][0][e], g1 = acc[ai][0][m][1][e], u1 = acc[ai][1][m][1][e];
                    o0[e] = (g0 * u0) * r2 * __builtin_amdgcn_rcpf(1.0f + __builtin_amdgcn_exp2f(g0 * nr));
                    o1[e] = (g1 * u1) * r2 * __builtin_amdgcn_rcpf(1.0f + __builtin_amdgcn_exp2f(g1 * nr)); }
                *(u32x4*)(hid + (size_t)row * DFF + col0) = pack8(o0, o1);
            }
    }
};
struct EpiRes {
    static constexpr bool PERM = true, AFTER_DRAIN = false, IDEMPOTENT = false, USES_RS = false, RS_EARLY = false;
    bf16_t* hb; float* ssq; float scale;
    __device__ __forceinline__ void operator()(const f32x4 (&acc)[2][2][4][2], const Unit& u, int wr, int wc, int fr, int fq, const PG8_LAS float*) const {
        const int col0 = u.pn * BM + wc * 32 + 8 * fq, row0 = u.pm * BM + wr * 64 + fr;
        u32x4 pre[2][4][2];
#pragma unroll
        for (int ai = 0; ai < 2; ++ai)
#pragma unroll
            for (int m = 0; m < 4; ++m)
#pragma unroll
                for (int bj = 0; bj < 2; ++bj) pre[ai][m][bj] = *(const u32x4*)(hb + (size_t)(row0 + ai * HALF + m * 16) * DM + col0 + bj * HALF);
#pragma unroll
        for (int ai = 0; ai < 2; ++ai) {
#pragma unroll
            for (int m = 0; m < 4; ++m) {
                const int row = row0 + ai * HALF + m * 16;
                float ss = 0.f;
#pragma unroll
                for (int bj = 0; bj < 2; ++bj) {
                    const size_t off = (size_t)row * DM + col0 + bj * HALF;
                    f32x4 b0, b1; unpack8(pre[ai][m][bj], b0, b1);
                    const f32x4 o0 = b0 + acc[ai][bj][m][0] * scale, o1 = b1 + acc[ai][bj][m][1] * scale;
                    *(u32x4*)(hb + off) = pack8(o0, o1);
                    ss += (o0[0] * o0[0] + o0[1] * o0[1]) + (o0[2] * o0[2] + o0[3] * o0[3]) + (o1[0] * o1[0] + o1[1] * o1[1]) + (o1[2] * o1[2] + o1[3] * o1[3]);
                }
                ss = rows_sum(ss);
                if (fq == 0) ssq[(size_t)row * 16 + u.pn * 4 + wc] = ss;
            }
        }
    }
};
struct EpiP0 {
    static constexpr bool PERM = true, AFTER_DRAIN = false, IDEMPOTENT = true, USES_RS = true, RS_EARLY = true;
    const float* ssq; const float* gate_b; bf16_t* qk; bf16_t* v; bf16_t* g; bf16_t* uo; float* la;
    __device__ __forceinline__ void operator()(const f32x4 (&acc)[2][2][4][2], const Unit& u, int wr, int wc, int fr, int fq, const PG8_LAS float* rsb) const {
        const int pn = u.pn, lc = wc * 32 + 8 * fq, row0 = u.pm * BM + wr * 64 + fr;
        float rs[2][4]; rs_read(rsb, wr, fr, rs);
        f32x4 gb[2][2] = {};
        if (pn == 6) {
#pragma unroll
            for (int bj = 0; bj < 2; ++bj) { gb[bj][0] = *(const f32x4*)(gate_b + lc + bj * HALF); gb[bj][1] = *(const f32x4*)(gate_b + lc + bj * HALF + 4); } }
#pragma unroll
        for (int ai = 0; ai < 2; ++ai)
#pragma unroll
            for (int m = 0; m < 4; ++m) {
                const int row = row0 + ai * HALF + m * 16; const float r = rs[ai][m];
#pragma unroll
                for (int bj = 0; bj < 2; ++bj) {
                    f32x4 a0 = acc[ai][bj][m][0] * r, a1 = acc[ai][bj][m][1] * r;
                    const int c = lc + bj * HALF;
                    if (pn < 2) { *(u32x4*)(qk + (size_t)row * 512 + pn * 256 + c) = pack8(a0, a1); }
                    else if (pn < 4) { *(u32x4*)(v + (size_t)row * 512 + (pn - 2) * 256 + c) = pack8(a0, a1); }
                    else if (pn < 6) {
#pragma unroll
                        for (int e = 0; e < 4; ++e) { a0[e] = silu_f(a0[e]); a1[e] = silu_f(a1[e]); }
                        *(u32x4*)(g + (size_t)row * 512 + (pn - 4) * 256 + c) = pack8(a0, a1); }
                    else if (pn == 6) {
#pragma unroll
                        for (int e = 0; e < 4; ++e) {
                            float x0 = a0[e] + gb[bj][0][e], x1 = a1[e] + gb[bj][1][e];
                            a0[e] = (fminf(x0, 0.f) - logf(1.0f + __expf(-fabsf(x0)))) * (1.0f / 16.0f);
                            a1[e] = (fminf(x1, 0.f) - logf(1.0f + __expf(-fabsf(x1)))) * (1.0f / 16.0f); }
                        *(f32x4*)(la + (size_t)row * 256 + c) = a0; *(f32x4*)(la + (size_t)row * 256 + c + 4) = a1; }
                    else { *(u32x4*)(uo + (size_t)row * 512 + (pn - 7) * 256 + c) = pack8(a0, a1); }
                }
            }
    }
};
struct EpiP1 {
    static constexpr bool PERM = true, AFTER_DRAIN = false, IDEMPOTENT = true, USES_RS = true, RS_EARLY = false;
    const float* ssq; const float* cs; bf16_t* q; bf16_t* k; bf16_t* v; bf16_t* qih; bf16_t* qil; bf16_t* kih; bf16_t* kil; float* wi;
    __device__ __forceinline__ void rope8(f32x4& a0, f32x4& a1, const f32x4 c0, const f32x4 c1) const {
        const float x0 = a0[0], x1 = a0[1], x2 = a0[2], x3 = a0[3], y0 = a1[0], y1 = a1[1], y2 = a1[2], y3 = a1[3];
        a0[0] = x0 * c0[0] - x1 * c0[1]; a0[1] = x1 * c0[0] + x0 * c0[1];
        a0[2] = x2 * c0[2] - x3 * c0[3]; a0[3] = x3 * c0[2] + x2 * c0[3];
        a1[0] = y0 * c1[0] - y1 * c1[1]; a1[1] = y1 * c1[0] + y0 * c1[1];
        a1[2] = y2 * c1[2] - y3 * c1[3]; a1[3] = y3 * c1[2] + y2 * c1[3];
    }
    __device__ __forceinline__ void split_store(bf16_t* ph, bf16_t* pl, f32x4 a0, f32x4 a1) const {
        const u32x4 h = pack8(a0, a1);
        f32x4 r0, r1;
        r0[0] = a0[0] - bf2f(h.x & 0xffffu); r0[1] = a0[1] - bf2f(h.x >> 16); r0[2] = a0[2] - bf2f(h.y & 0xffffu); r0[3] = a0[3] - bf2f(h.y >> 16);
        r1[0] = a1[0] - bf2f(h.z & 0xffffu); r1[1] = a1[1] - bf2f(h.z >> 16); r1[2] = a1[2] - bf2f(h.w & 0xffffu); r1[3] = a1[3] - bf2f(h.w >> 16);
        *(u32x4*)ph = h; *(u32x4*)pl = pack8(r0, r1);
    }
    __device__ __forceinline__ void operator()(const f32x4 (&acc)[2][2][4][2], const Unit& u, int wr, int wc, int fr, int fq, const PG8_LAS float* rsb) const {
        const int pn = u.pn, lc = wc * 32 + 8 * fq, row0 = u.pm * BM + wr * 64 + fr;
        const bool r128 = pn < 5, r64 = pn == 6 || (pn == 7 && wc < 2);
#pragma unroll
        for (int ai = 0; ai < 2; ++ai) {
            f32x4 cA[4], cB[4]; float rs[4];
#pragma unroll
            for (int m = 0; m < 4; ++m) rs[m] = rsb[wr * 64 + fr + ai * HALF + m * 16];
#pragma unroll
            for (int m = 0; m < 4; ++m) { const int row = row0 + ai * HALF + m * 16;
                if (r128 && pn != 5) { const float* cp = cs + ((size_t)row * 64 + (lc >> 1)) * 2; cA[m] = *(const f32x4*)cp; cB[m] = *(const f32x4*)(cp + 4); }
                else if (r64) { const float* cp = cs + ((size_t)row * 64 + (lc & 63)) * 2;
                    const f32x2 e0 = *(const f32x2*)(cp), e1 = *(const f32x2*)(cp + 4), e2 = *(const f32x2*)(cp + 8), e3 = *(const f32x2*)(cp + 12);
                    cA[m] = (f32x4){e0[0], e0[1], e1[0], e1[1]}; cB[m] = (f32x4){e2[0], e2[1], e3[0], e3[1]}; } }
#pragma unroll
            for (int m = 0; m < 4; ++m) {
                const int row = row0 + ai * HALF + m * 16;
                const int b = row >> 12, s = row & 4095; const float r = rs[m];
#pragma unroll
                for (int bj = 0; bj < 2; ++bj) {
                    f32x4 a0 = acc[ai][bj][m][0] * r, a1 = acc[ai][bj][m][1] * r;
                    if (pn < 4) { rope8(a0, a1, cA[m], cB[m]); a0 = a0 * QSCALE; a1 = a1 * QSCALE;
                        *(u32x4*)(q + ((size_t)(b * 8 + pn * 2 + bj) * SEQ + s) * 128 + lc) = pack8(a0, a1); }
                    else if (pn == 4) { rope8(a0, a1, cA[m], cB[m]);
                        *(u32x4*)(k + ((size_t)(b * 2 + bj) * SEQ + s) * 128 + lc) = pack8(a0, a1); }
                    else if (pn == 5) { *(u32x4*)(v + ((size_t)(b * 2 + bj) * SEQ + s) * 128 + lc) = pack8(a0, a1); }
                    else if (pn == 6) { const int ct = bj * HALF + lc; rope8(a0, a1, cA[m], cB[m]);
                        split_store(qih + (size_t)row * 256 + ct, qil + (size_t)row * 256 + ct, a0, a1); }
                    else if (bj == 0) {
                        if (wc < 2) { const int c64 = lc; rope8(a0, a1, cA[m], cB[m]);
                            const int q8 = c64 >> 3; const size_t tb = ((size_t)(b * 128 + (s >> 5)) * 4096) + (size_t)(((q8 >> 1) * 4 + (q8 & 1)) * 256 + (s & 31) * 8);
                            split_store(kih + tb, kih + tb + 512, a0, a1); }
                        else if (wc == 2 && fq == 0) { *(f32x4*)(wi + (size_t)row * 4) = a0; }
                    }
                }
            }
        }
    }
};

template <class Epi, class Sched, bool ALIGN_EPI = false, bool SP2 = false>
__device__ __forceinline__ void gemm_phase(PG8_LAS unsigned char* lds, const Gemm g, const Sched& S, const Epi& E, const int tid) {
    const int wid = __builtin_amdgcn_readfirstlane(tid >> 6), lane = tid & 63, wr = wid >> 2, wc = wid & 3, fr = lane & 15, fq = lane >> 4;
    const int K = g.K, nt = K / BK;
    unsigned voffA[2], voffB[2];
#pragma unroll
    for (int i = 0; i < 2; ++i) { int R, C; stage_rc(tid * 16 + i * 8192, R, C); const int Rb = Epi::PERM ? ((R & ~31) + perm32(R & 31)) : R;
        voffA[i] = (unsigned)(R * K + C) * 2u; voffB[i] = (unsigned)(Rb * K + C) * 2u; }
    const size_t kstep = (size_t)(BK * 2);
    const size_t hstep = (size_t)HALF * K * 2;
    const size_t tstep = 2 * hstep;
    const unsigned ldsw = (unsigned)wid * 1024u;
    const int aoff = lds_byte(wr * 64 + fr, fq * 8), boff = lds_byte(wc * 32 + fr, fq * 8);
#define PG8_SA(b, h) (((b) * 2 + (h)) * HTB)
#define PG8_SB(b, h) ((4 + (b) * 2 + (h)) * HTB)
#define PG8_STAGE(bufoff, gbase, voff) do { _Pragma("unroll") for (int _i = 0; _i < 2; ++_i) \
        __builtin_amdgcn_global_load_lds((const unsigned*)((const char*)(gbase) + (voff)[_i]), (PG8_LAS unsigned*)(lds + (bufoff) + ldsw + _i * 8192), 16, 0, 0); } while (0)
#define PG8_LDA(dst, b, h) do { _Pragma("unroll") for (int m = 0; m < 4; ++m) _Pragma("unroll") for (int k = 0; k < 2; ++k) dst[m][k] = *(const PG8_LAS bf16x8*)(lds + PG8_SA(b, h) + aoff + m * 2048 + k * 1024); } while (0)
#define PG8_LDB(dst, b, h) do { _Pragma("unroll") for (int n = 0; n < 2; ++n) _Pragma("unroll") for (int k = 0; k < 2; ++k) dst[n][k] = *(const PG8_LAS bf16x8*)(lds + PG8_SB(b, h) + boff + n * 2048 + k * 1024); } while (0)
#define PG8_MMA(ai, bj, At, Bt) do { __builtin_amdgcn_s_setprio(1); _Pragma("unroll") for (int m = 0; m < 4; ++m) _Pragma("unroll") for (int n = 0; n < 2; ++n) _Pragma("unroll") for (int k = 0; k < 2; ++k) \
        acc[ai][bj][m][n] = __builtin_amdgcn_mfma_f32_16x16x32_bf16(Bt[n][k], At[m][k], acc[ai][bj][m][n], 0, 0, 0); __builtin_amdgcn_s_setprio(0); } while (0)
#define PG8_WAIT_V(n) asm volatile("s_waitcnt vmcnt(" #n ")" ::: "memory")
#define PG8_WAIT_L(n) asm volatile("s_waitcnt lgkmcnt(" #n ")" ::: "memory")
#define PG8_BAR __builtin_amdgcn_s_barrier()
#define PG8_SCHED __builtin_amdgcn_sched_barrier(0)
    Unit cur, nxt; int ui = 0;
    if (!S.next(0, cur)) return;
    f32x4 acc[2][2][4][2];
#pragma unroll
    for (int a = 0; a < 2; ++a)
#pragma unroll
        for (int b = 0; b < 2; ++b)
#pragma unroll
            for (int m = 0; m < 4; ++m)
#pragma unroll
                for (int n = 0; n < 2; ++n) acc[a][b][m][n] = (f32x4){0.f, 0.f, 0.f, 0.f};
    bf16x8 At[4][2], B0[2][2], B1[2][2];
    const char* cA = (const char*)g.A + (size_t)cur.pm * tstep; const char* cB = (const char*)g.Bt + (size_t)cur.pn * tstep;
    S.a_ready(cur);
    f32x4 rf0, rf1;
    if constexpr (Epi::USES_RS) rs_issue(E.ssq, cur.pm, tid, rf0, rf1);
    if constexpr (SP2) {
        PG8_STAGE(PG8_SB(0, 0), cB, voffB); PG8_STAGE(PG8_SB(0, 1), cB + hstep, voffB); PG8_STAGE(PG8_SA(0, 0), cA, voffA); PG8_STAGE(PG8_SA(0, 1), cA + hstep, voffA);
        if (wr == 1) PG8_BAR;
        PG8_WAIT_V(2); PG8_BAR;
        PG8_STAGE(PG8_SB(1, 0), cB + kstep, voffB); PG8_STAGE(PG8_SA(1, 0), cA + kstep, voffA); PG8_STAGE(PG8_SB(1, 1), cB + hstep + kstep, voffB);
        PG8_WAIT_V(6); PG8_BAR;
    } else {
        PG8_STAGE(PG8_SB(0, 0), cB, voffB); PG8_STAGE(PG8_SA(0, 0), cA, voffA); PG8_STAGE(PG8_SB(0, 1), cB + hstep, voffB); PG8_STAGE(PG8_SA(0, 1), cA + hstep, voffA);
        if (wr == 1) PG8_BAR;
        PG8_WAIT_V(4); PG8_BAR;
        PG8_STAGE(PG8_SB(1, 0), cB + kstep, voffB); PG8_STAGE(PG8_SA(1, 0), cA + kstep, voffA); PG8_STAGE(PG8_SB(1, 1), cB + hstep + kstep, voffB);
        PG8_WAIT_V(6); PG8_BAR;
    }
    if constexpr (Epi::USES_RS) rs_commit(lds, 0, tid, rf0, rf1);
    for (;;) {
        const bool has_next = S.next(ui + 1, nxt);
        const char* nA = has_next ? (const char*)g.A + (size_t)nxt.pm * tstep : cA; const char* nB = has_next ? (const char*)g.Bt + (size_t)nxt.pn * tstep : cB;
        for (int t = 0; t < nt; t += 2) {
            const bool last = (t == nt - 2);
            const char* a1 = cA + (size_t)(t + 1) * kstep;
            const char* a2 = last ? nA : cA + (size_t)(t + 2) * kstep; const char* b2 = last ? nB : cB + (size_t)(t + 2) * kstep;
            const char* a3 = a2 + kstep; const char* b3 = b2 + kstep;
            if (last && has_next) S.a_ready(nxt);
            if constexpr (SP2) {
            PG8_LDB(B0, 0, 0); PG8_LDB(B1, 0, 1); PG8_SCHED; PG8_LDA(At, 0, 0); PG8_STAGE(PG8_SA(1, 1), a1 + hstep, voffA);
            PG8_WAIT_V(8); PG8_WAIT_L(0); PG8_BAR; PG8_MMA(0, 0, At, B0); PG8_MMA(0, 1, At, B1); PG8_BAR; PG8_SCHED;
            PG8_LDA(At, 0, 1); PG8_STAGE(PG8_SB(0, 0), b2, voffB); PG8_STAGE(PG8_SB(0, 1), b2 + hstep, voffB); PG8_STAGE(PG8_SA(0, 0), a2, voffA);
            PG8_WAIT_V(8); PG8_WAIT_L(0); PG8_BAR; PG8_MMA(1, 0, At, B0); PG8_MMA(1, 1, At, B1); PG8_BAR; PG8_SCHED;
            PG8_LDB(B0, 1, 0); PG8_LDB(B1, 1, 1); PG8_SCHED; PG8_LDA(At, 1, 0); PG8_STAGE(PG8_SA(0, 1), a2 + hstep, voffA);
            PG8_WAIT_V(8); PG8_WAIT_L(0); PG8_BAR; PG8_MMA(0, 0, At, B0); PG8_MMA(0, 1, At, B1); PG8_BAR; PG8_SCHED;
            PG8_LDA(At, 1, 1); PG8_STAGE(PG8_SB(1, 0), b3, voffB); PG8_STAGE(PG8_SB(1, 1), b3 + hstep, voffB); PG8_STAGE(PG8_SA(1, 0), a3, voffA);
            PG8_WAIT_V(8); PG8_WAIT_L(0); PG8_BAR; PG8_MMA(1, 0, At, B0); PG8_MMA(1, 1, At, B1); PG8_BAR; PG8_SCHED;
            } else {
            PG8_LDB(B0, 0, 0); PG8_SCHED; PG8_LDA(At, 0, 0); PG8_STAGE(PG8_SA(1, 1), a1 + hstep, voffA);
            PG8_WAIT_L(8); PG8_BAR; PG8_WAIT_L(0); PG8_MMA(0, 0, At, B0); PG8_BAR; PG8_SCHED;
            PG8_LDB(B1, 0, 1); PG8_STAGE(PG8_SB(0, 0), b2, voffB);
            PG8_BAR; PG8_WAIT_L(0); PG8_MMA(0, 1, At, B1); PG8_BAR;
            PG8_LDA(At, 0, 1); PG8_STAGE(PG8_SA(0, 0), a2, voffA);
            PG8_BAR; PG8_WAIT_L(0); PG8_MMA(1, 0, At, B0); PG8_BAR; PG8_SCHED;
            PG8_STAGE(PG8_SB(0, 1), b2 + hstep, voffB);
            PG8_WAIT_V(6); PG8_BAR; PG8_MMA(1, 1, At, B1); PG8_BAR;
            PG8_LDB(B0, 1, 0); PG8_SCHED; PG8_LDA(At, 1, 0); PG8_STAGE(PG8_SA(0, 1), a2 + hstep, voffA);
            PG8_WAIT_L(8); PG8_BAR; PG8_WAIT_L(0); PG8_MMA(0, 0, At, B0); PG8_BAR; PG8_SCHED;
            PG8_LDB(B1, 1, 1); PG8_STAGE(PG8_SB(1, 0), b3, voffB);
            PG8_BAR; PG8_WAIT_L(0); PG8_MMA(0, 1, At, B1); PG8_BAR;
            PG8_LDA(At, 1, 1); PG8_STAGE(PG8_SA(1, 0), a3, voffA);
            PG8_BAR; PG8_WAIT_L(0); PG8_MMA(1, 0, At, B0); PG8_BAR; PG8_SCHED;
            PG8_STAGE(PG8_SB(1, 1), b3 + hstep, voffB);
            PG8_WAIT_V(6); PG8_BAR; PG8_MMA(1, 1, At, B1); PG8_BAR;
            }
        }
        if constexpr (ALIGN_EPI) { if (wr == 0) PG8_BAR; }
        if constexpr (!Epi::AFTER_DRAIN) { int fr_ = fr, fq_ = fq; asm volatile("" : "+v"(fr_), "+v"(fq_));
            if constexpr (Epi::USES_RS) { int t_ = tid; asm volatile("" : "+v"(t_)); f32x4 rp0, rp1;
                const int npm = has_next ? nxt.pm : cur.pm;
                if constexpr (Epi::RS_EARLY) rs_issue(E.ssq, npm, t_, rp0, rp1);
                E(acc, cur, wr, wc, fr_, fq_, (const PG8_LAS float*)(lds + RSB_OFF + (ui & 1) * 1024));
                if constexpr (!Epi::RS_EARLY) rs_issue(E.ssq, npm, t_, rp0, rp1);
                rs_commit(lds, (ui + 1) & 1, t_, rp0, rp1); }
            else E(acc, cur, wr, wc, fr_, fq_, (const PG8_LAS float*)nullptr);
            S.done(cur); }
        if (!has_next) break;
#pragma unroll
        for (int a = 0; a < 2; ++a)
#pragma unroll
            for (int b = 0; b < 2; ++b)
#pragma unroll
                for (int m = 0; m < 4; ++m)
#pragma unroll
                    for (int n = 0; n < 2; ++n) acc[a][b][m][n] = (f32x4){0.f, 0.f, 0.f, 0.f};
        cur = nxt; cA = nA; cB = nB; ++ui;
        if constexpr (ALIGN_EPI) { if (wr == 1) PG8_BAR; }
    }
    PG8_WAIT_V(0);
    if constexpr (!ALIGN_EPI) { if (wr == 0) PG8_BAR; }
    PG8_BAR;
#undef PG8_SA
#undef PG8_SB
#undef PG8_STAGE
#undef PG8_LDA
#undef PG8_LDB
#undef PG8_MMA
#undef PG8_WAIT_V
#undef PG8_WAIT_L
#undef PG8_BAR
#undef PG8_SCHED
}
}

namespace att {
constexpr int D = 128, NW = 8, QBLK = 32, KVBLK = 64, QB = NW * QBLK, OSTRIDE = 1024;
constexpr float SCALE = 0.08838834764831845f, THR = 8.f;
constexpr int SHM_V = KVBLK * D * 2, SHM_K = KVBLK * D * 2;
constexpr int LDS_BYTES = 2 * SHM_V + 2 * SHM_K + NW * 64 * 4;
#define KSWZ(row, colB) ((row) * 256 + ((colB) ^ (((row) & 7) << 4)))
#define SBAR() __builtin_amdgcn_sched_barrier(0)
__device__ __forceinline__ int v_st(int k, int c) { const int kk = (k & ~0xC) | ((k & 4) << 1) | ((k & 8) >> 1); return ((kk >> 3) * 4 + (c >> 5)) * 512 + ((kk & 7) * 32 + (c & 31)) * 2; }
__device__ __forceinline__ int v_rd_base(int lane) { return ((lane & 3) << 3) | (((lane >> 2) & 3) << 6) | (((lane >> 4) & 1) << 5) | (((lane >> 5) & 1) << 8); }
constexpr int v_rd_off(int d0, int ks, int half) { return d0 * 512 + ks * 4096 + half * 2048; }
__device__ __forceinline__ int crow(int r, int hi) { return (r & 3) + 8 * (r >> 2) + 4 * hi; }
__device__ __forceinline__ unsigned cvtpk(float lo, float hi) { unsigned r; asm volatile("v_cvt_pk_bf16_f32 %0, %1, %2" : "=v"(r) : "v"(lo), "v"(hi)); return r; }
__device__ __forceinline__ bf16x8 load8(const bf16_t* p) { return *reinterpret_cast<const bf16x8*>(p); }
__device__ __forceinline__ void mask_bits(f32x16& p0, f32x16& p1, unsigned long long w, int hi) {
    const float NEG = -__builtin_inff();
    const unsigned lo = (unsigned)w >> (4 * hi), hw = (unsigned)(w >> 32) >> (4 * hi);
#pragma unroll
    for (int r = 0; r < 16; ++r) {
        const int c = (r & 3) + 8 * (r >> 2);
        if (!((lo >> c) & 1u)) p0[r] = NEG;
        if (!((hw >> c) & 1u)) p1[r] = NEG;
    }
}
__device__ __forceinline__ void partialSM(f32x16& p0, f32x16& p1, float& m_reg, float& mn, float& alpha) {
    float pmax = p0[0]; for (int r = 1; r < 16; ++r) pmax = fmaxf(pmax, p0[r]); for (int r = 0; r < 16; ++r) pmax = fmaxf(pmax, p1[r]);
    { auto rr = __builtin_amdgcn_permlane32_swap(__float_as_uint(pmax), __float_as_uint(pmax), false, false);
      pmax = fmaxf(__uint_as_float(rr[0]), __uint_as_float(rr[1])); }
    constexpr float THR2 = THR * 1.4426950408889634f;
    if (__builtin_expect(__all(pmax <= THR2), 1)) { alpha = 1.f; }
    else { const float dl = fmaxf(pmax, 0.f); m_reg += dl; alpha = __builtin_amdgcn_exp2f(-dl);
        for (int r = 0; r < 16; ++r) { p0[r] -= dl; p1[r] -= dl; } }
    mn = m_reg;
    for (int r = 0; r < 16; ++r) p0[r] = __builtin_amdgcn_exp2f(p0[r]);
}
__device__ __forceinline__ void finishSM(f32x16& p0, f32x16& p1, float alpha, float& l_reg, bf16x8& pa0, bf16x8& pa1, bf16x8& pa2, bf16x8& pa3) {
    for (int r = 0; r < 16; ++r) p1[r] = __builtin_amdgcn_exp2f(p1[r]);
    float ps = 0; for (int r = 0; r < 16; ++r) ps += p0[r]; for (int r = 0; r < 16; ++r) ps += p1[r];
    { auto rr = __builtin_amdgcn_permlane32_swap(__float_as_uint(ps), __float_as_uint(ps), false, false);
      ps = __uint_as_float(rr[0]) + __uint_as_float(rr[1]); }
    l_reg = l_reg * alpha + ps;
#define PK4(P, B_, OUT) do { unsigned a0 = cvtpk(P[B_+0], P[B_+1]), a1 = cvtpk(P[B_+2], P[B_+3]);                          \
        unsigned b0 = cvtpk(P[B_+4], P[B_+5]), b1 = cvtpk(P[B_+6], P[B_+7]);                                             \
        auto r0 = __builtin_amdgcn_permlane32_swap(a0, b0, false, false); auto r1 = __builtin_amdgcn_permlane32_swap(a1, b1, false, false); \
        u32x4 w = {r0[0], r1[0], r0[1], r1[1]}; OUT = *reinterpret_cast<bf16x8*>(&w); } while (0)
    PK4(p0, 0, pa0); PK4(p0, 8, pa1); PK4(p1, 0, pa2); PK4(p1, 8, pa3);
#undef PK4
}
template <int KB>
__device__ __forceinline__ void qkt(f32x16& p0, f32x16& p1, const char* K_lds, int r32_, int hi_, const bf16x8* qr, unsigned long long mw, float negm) {
    const int r32 = r32_, hi = hi_;
    { const int nlo = (int)~((unsigned)mw >> (4 * hi)), nhw = (int)~((unsigned)(mw >> 32) >> (4 * hi));
      const int nb = __builtin_bit_cast(int, negm);
#pragma unroll
      for (int r = 0; r < 16; ++r) { const int c = (r & 3) + 8 * (r >> 2);
          int m0 = __builtin_amdgcn_sbfe(nlo, c, 1), m1 = __builtin_amdgcn_sbfe(nhw, c, 1);
          asm("" : "+v"(m0), "+v"(m1));
          p0[r] = __builtin_bit_cast(float, (m0 & (int)0xFF800000) | (~m0 & nb));
          p1[r] = __builtin_bit_cast(float, (m1 & (int)0xFF800000) | (~m1 & nb)); } }
    const char* kb[4];
#pragma unroll
    for (int dd = 0; dd < 4; ++dd) kb[dd] = K_lds + KB * SHM_K + KSWZ(r32, (dd * 16 + hi * 8) * 2);
    bf16x8 b0 = *reinterpret_cast<const bf16x8*>(kb[0]), b1 = *reinterpret_cast<const bf16x8*>(kb[0] + 32 * 256);
#pragma unroll
    for (int d0 = 0; d0 < 8; ++d0) {
        bf16x8 n0 = b0, n1 = b1;
        if (d0 < 7) { const char* a = kb[(d0 + 1) & 3] + ((d0 + 1) >> 2) * 128; n0 = *reinterpret_cast<const bf16x8*>(a); n1 = *reinterpret_cast<const bf16x8*>(a + 32 * 256); }
        __builtin_amdgcn_sched_barrier(0);
        p0 = __builtin_amdgcn_mfma_f32_32x32x16_bf16(b0, qr[d0], p0, 0, 0, 0);
        p1 = __builtin_amdgcn_mfma_f32_32x32x16_bf16(b1, qr[d0], p1, 0, 0, 0);
        __builtin_amdgcn_sched_barrier(0);
        b0 = n0; b1 = n1; }
}
template <int VB>
__device__ __forceinline__ void pv_tile(f32x16* o, int vbase, int lane_, bf16x8 pa0, bf16x8 pa1, bf16x8 pa2, bf16x8 pa3) {
    const int vb0 = vbase + v_rd_base(lane_);
#define TRRD(dst, off) asm volatile("ds_read_b64_tr_b16 %0, %1 offset:%2" : "=&v"(dst) : "v"(vb0), "i"(off) : "memory")
#define PV_D0(d0) do { s16x4 l0, l1, l2, l3, h0, h1, h2, h3; constexpr int b_ = VB * SHM_V + v_rd_off(d0, 0, 0); \
        TRRD(l0, b_); TRRD(h0, b_ + 2048); TRRD(l1, b_ + 4096); TRRD(h1, b_ + 6144); TRRD(l2, b_ + 8192); TRRD(h2, b_ + 10240); TRRD(l3, b_ + 12288); TRRD(h3, b_ + 14336); \
        asm volatile("s_waitcnt lgkmcnt(0)" ::: "memory"); SBAR();   \
        o[d0] = __builtin_amdgcn_mfma_f32_32x32x16_bf16(pa0, (bf16x8){l0[0], l0[1], l0[2], l0[3], h0[0], h0[1], h0[2], h0[3]}, o[d0], 0, 0, 0);   \
        o[d0] = __builtin_amdgcn_mfma_f32_32x32x16_bf16(pa1, (bf16x8){l1[0], l1[1], l1[2], l1[3], h1[0], h1[1], h1[2], h1[3]}, o[d0], 0, 0, 0);   \
        o[d0] = __builtin_amdgcn_mfma_f32_32x32x16_bf16(pa2, (bf16x8){l2[0], l2[1], l2[2], l2[3], h2[0], h2[1], h2[2], h2[3]}, o[d0], 0, 0, 0);   \
        o[d0] = __builtin_amdgcn_mfma_f32_32x32x16_bf16(pa3, (bf16x8){l3[0], l3[1], l3[2], l3[3], h3[0], h3[1], h3[2], h3[3]}, o[d0], 0, 0, 0); } while (0)
    PV_D0(0); PV_D0(1); PV_D0(2); PV_D0(3);
#undef PV_D0
#undef TRRD
}
constexpr size_t VOFF = (size_t)4 * 1024 * 1024;
struct BlockRef { const bf16_t* Q; const bf16_t* K; bf16_t* O; const unsigned long long* MW; int P0; };
struct Seam { bf16x8 qr[8]; bf16x8 st_v0, st_v1, st_k0, st_k1; };
#define ROW(p, k0, rr) ((p) + (unsigned)(((k0) + (rr)) * D + sc))
#define VMW() asm volatile("s_waitcnt vmcnt(0)" ::: "memory")
#define VMWN(n) asm volatile("s_waitcnt vmcnt(%0)" :: "i"(n) : "memory")
#define SLOAD_H(Kp, Vp, k0) do { S.st_v0 = load8(ROW(Vp, k0, sr)); S.st_v1 = load8(ROW(Vp, k0, 32 + sr));              \
                         S.st_k0 = load8(ROW(Kp, k0, sr)); S.st_k1 = load8(ROW(Kp, k0, 32 + sr)); } while (0)
#define SWOFF() int t_ = tid; asm volatile("" : "+v"(t_)); const int sr_ = t_ >> 4, sc_ = (t_ & 15) * 8
#define SWRITE_HK(bf) do { SWOFF(); const int kws_ = KSWZ(sr_, sc_ * 2); *(bf16x8*)(K_lds + (bf) * SHM_K + kws_) = S.st_k0; *(bf16x8*)(K_lds + (bf) * SHM_K + kws_ + 32 * 256) = S.st_k1; } while (0)
#define SWRITE_HV(bf) do { SWOFF(); *(bf16x8*)(V_lds + (bf) * SHM_V + v_st(sr_, sc_)) = S.st_v0; *(bf16x8*)(V_lds + (bf) * SHM_V + v_st(32 + sr_, sc_)) = S.st_v1; } while (0)
#define SWRITE_H(bf) do { SWRITE_HV(bf); SWRITE_HK(bf); } while (0)
__device__ __forceinline__ void attn_prime(const BlockRef& cur, char* lds, Seam& S, const int tid) {
    const int wid = __builtin_amdgcn_readfirstlane(tid >> 6), lane = tid & 63, r32 = lane & 31, hi = lane >> 5;
    const int sr = tid >> 4, sc = (tid & 15) * 8; char* K_lds = lds + 2 * SHM_V;
#pragma unroll
    for (int d0 = 0; d0 < 8; ++d0) S.qr[d0] = load8(cur.Q + (unsigned)((wid * QBLK + r32) * D + d0 * 16 + hi * 8));
    SLOAD_H(cur.K, cur.K + VOFF, 0); VMW(); SWRITE_HK(0);
    __syncthreads();
}
__device__ __forceinline__ void attn_block(const BlockRef& cur, const BlockRef& nxt, char* lds, Seam& S, const int tid) {
    const int wid = __builtin_amdgcn_readfirstlane(tid >> 6), lane = tid & 63, r32 = lane & 31, hi = lane >> 5;
    const int NT = (cur.P0 + QB - 1) / KVBLK + 1;
    const int mro = wid * QBLK + r32;
    char* V_lds = lds; char* K_lds = lds + 2 * SHM_V;
    float* ws = (float*)(lds + 2 * SHM_V + 2 * SHM_K) + wid * 64; float* li_l = ws, * al_l = ws + 32;
    float m_reg = 0.f, l_reg = 0; f32x16 o[4] = {};
    const int sr = tid >> 4, sc = (tid & 15) * 8;
    const int vbase = (int)(uintptr_t)V_lds;
    const bf16_t* Kh = cur.K; const bf16_t* Vh = cur.K + VOFF;
#define RESC(a) do { if (__any((a) < 1.f)) { if (hi == 0) al_l[r32] = (a); asm volatile("s_waitcnt lgkmcnt(0)" ::: "memory");              \
                     for (int d_ = 0; d_ < 4; ++d_) for (int r = 0; r < 16; ++r) o[d_][r] *= al_l[crow(r, hi)]; } } while (0)
#define KBASE(t) ((t) * KVBLK)
    f32x16 pA0, pA1, pB0, pB1; float mnA, mnB, alA, alB; bf16x8 pa0, pa1, pa2, pa3; unsigned long long mwA, mwB;
    mwA = cur.MW[mro]; mwB = cur.MW[mro + (NT > 1 ? SEQ : 0)];
    const int swk_ = KSWZ(sr, sc * 2), swv0_ = v_st(sr, sc), swv1_ = v_st(32 + sr, sc);
#define SWRITE_HK2(bf) do { *(bf16x8*)(K_lds + (bf) * SHM_K + swk_) = S.st_k0; *(bf16x8*)(K_lds + (bf) * SHM_K + swk_ + 32 * 256) = S.st_k1; } while (0)
#define SWRITE_HV2(bf) do { *(bf16x8*)(V_lds + (bf) * SHM_V + swv0_) = S.st_v0; *(bf16x8*)(V_lds + (bf) * SHM_V + swv1_) = S.st_v1; } while (0)
#define SWRITE_H2(bf) do { SWRITE_HV2(bf); SWRITE_HK2(bf); } while (0)
    SWRITE_HV2(0); SBAR();
    if (NT > 1) { SLOAD_H(Kh, Vh, KBASE(1)); }
    SBAR(); qkt<0>(pA0, pA1, K_lds, r32, hi, S.qr, mwA, -m_reg);
    partialSM(pA0, pA1, m_reg, mnA, alA);
    if (NT > 1) { VMW(); SWRITE_H2(1); }
    __syncthreads();
#define HALF_STEP(PX0, PX1, mnX, alX, mwX, mwY, PY0, PY1, alY, t, KB, VB, SB) do {                                            \
        SBAR(); qkt<KB>(PX0, PX1, K_lds, r32, hi, S.qr, mwX, -m_reg);                                        \
        mwY = cur.MW[mro + ((t) + 1 < NT ? (t) + 1 : (t)) * SEQ];        \
        finishSM(PY0, PY1, alY, l_reg, pa0, pa1, pa2, pa3); SBAR();                                                           \
        if ((t) + 1 < NT) { SLOAD_H(Kh, Vh, KBASE((t) + 1)); SBAR(); }                                               \
        pv_tile<VB>(o, vbase, lane, pa0, pa1, pa2, pa3); partialSM(PX0, PX1, m_reg, mnX, alX);                                        \
        __syncthreads();                                                                                                      \
        if ((t) + 1 < NT) { VMW(); SWRITE_H2(SB); }                                                                         \
        RESC(alX); __syncthreads(); } while (0)
    for (int t = 1; t + 1 < NT; t += 2) {
        HALF_STEP(pB0, pB1, mnB, alB, mwB, mwA, pA0, pA1, alA, t, 1, 0, 0);
        HALF_STEP(pA0, pA1, mnA, alA, mwA, mwB, pB0, pB1, alB, t + 1, 0, 1, 1);
    }
    const bool even = (NT & 1) == 0;
    if (even) { SBAR(); qkt<1>(pB0, pB1, K_lds, r32, hi, S.qr, mwB, -m_reg); SBAR(); }
    SLOAD_H(nxt.K, nxt.K + VOFF, 0); SBAR();
#pragma unroll
    for (int d0 = 0; d0 < 8; ++d0) S.qr[d0] = load8(nxt.Q + (unsigned)((wid * QBLK + r32) * D + d0 * 16 + hi * 8));
    SBAR();
    finishSM(pA0, pA1, alA, l_reg, pa0, pa1, pa2, pa3); SBAR();
    pv_tile<0>(o, vbase, lane, pa0, pa1, pa2, pa3);
    if (even) { partialSM(pB0, pB1, m_reg, mnB, alB); __syncthreads(); RESC(alB);
        finishSM(pB0, pB1, alB, l_reg, pa0, pa1, pa2, pa3); SBAR(); pv_tile<1>(o, vbase, lane, pa0, pa1, pa2, pa3); }
    SBAR(); VMWN(8); SWRITE_HK2(0); SBAR();
    if (hi == 0) li_l[r32] = l_reg; asm volatile("s_waitcnt lgkmcnt(0)" ::: "memory");
    float rli[16];
#pragma unroll
    for (int r = 0; r < 16; ++r) rli[r] = __builtin_amdgcn_rcpf(li_l[crow(r, hi)]);
    bf16_t* Ow = cur.O + (unsigned)(wid * QBLK * OSTRIDE);
    int le = lane; asm volatile("" : "+v"(le)); const int r32e = le & 31, hie = le >> 5;
#pragma unroll
    for (int r = 0; r < 16; ++r) { const int orow = crow(r, hie);
#pragma unroll
        for (int d0 = 0; d0 < 4; ++d0) { const float v = o[d0][r] * rli[r];
            const float vn = DPP_F(v, 0xB1);
            if ((r32e & 1) == 0) *(unsigned*)(Ow + (unsigned)(orow * OSTRIDE + d0 * 32 + r32e)) = cvtpk(v, vn); } }
    __syncthreads();
#undef RESC
#undef KBASE
#undef HALF_STEP
#undef SWRITE_HK2
#undef SWRITE_HV2
#undef SWRITE_H2
}
#undef ROW
#undef VMW
#undef VMWN
#undef SLOAD_H
#undef SWRITE_HK
#undef SWOFF
#undef SWRITE_HV
#undef SWRITE_H
#undef SBAR
#undef KSWZ
}

__device__ __forceinline__ bf16x8 tr_frag(int base, int off) {
    const s16x4 l = __builtin_amdgcn_ds_read_tr16_b64_v4i16((__attribute__((address_space(3))) s16x4*)(base + off)), h = __builtin_amdgcn_ds_read_tr16_b64_v4i16((__attribute__((address_space(3))) s16x4*)(base + off + 2048));
    return (bf16x8){l[0], l[1], l[2], l[3], h[0], h[1], h[2], h[3]}; }
typedef const __attribute__((address_space(4))) KArgs* KArgsCP;
__device__ __forceinline__ KArgsCP kargs() { KArgsCP p = (KArgsCP)__builtin_amdgcn_kernarg_segment_ptr(); asm volatile("" : "+s"(p)); return p; }
__device__ __forceinline__ KArgs load_kargs() { KArgsCP p = kargs(); KArgs a;
    a.x = p->x; a.pos = p->pos; a.ffn1_norm = p->ffn1_norm; a.ffn1_wi = p->ffn1_wi; a.ffn1_wo = p->ffn1_wo; a.mix_norm = p->mix_norm; a.ffn2_norm = p->ffn2_norm; a.ffn2_wi = p->ffn2_wi; a.ffn2_wo = p->ffn2_wo;
    a.even_w_in = p->even_w_in; a.gate_w = p->gate_w; a.gate_b = p->gate_b; a.out_norm = p->out_norm; a.pool_w = p->pool_w; a.pool_scale = p->pool_scale; a.even_w_out = p->even_w_out; a.odd_w_in = p->odd_w_in;
    a.odd_w_out = p->odd_w_out; a.final_norm = p->final_norm; a.out = p->out; a.ws = p->ws; return a; }
__device__ __forceinline__ int opaque_lane() { int l; asm volatile("v_mbcnt_lo_u32_b32 %0, -1, 0\n\tv_mbcnt_hi_u32_b32 %0, -1, %0" : "=v"(l)); return l; }
__device__ __forceinline__ int fresh_tid_(int wv) { return (wv << 6) | opaque_lane(); }
#define fresh_tid() fresh_tid_(wv_)
__device__ __forceinline__ float wave_sum(float v) {
    v += DPP_F(v, 0xB1); v += DPP_F(v, 0x4E); v += DPP_F(v, 0x141); v += DPP_F(v, 0x140);
    return (__builtin_bit_cast(float, __builtin_amdgcn_readlane(__builtin_bit_cast(int, v), 0)) + __builtin_bit_cast(float, __builtin_amdgcn_readlane(__builtin_bit_cast(int, v), 16)))
         + (__builtin_bit_cast(float, __builtin_amdgcn_readlane(__builtin_bit_cast(int, v), 32)) + __builtin_bit_cast(float, __builtin_amdgcn_readlane(__builtin_bit_cast(int, v), 48)));
}
__constant__ float INV128[64] = {1.0f, 0.8659643530845642f, 0.7498942613601685f, 0.6493816375732422f, 0.5623413324356079f, 0.486967533826828f, 0.4216965138912201f, 0.3651741147041321f, 0.3162277638912201f, 0.2738419771194458f, 0.23713737726211548f, 0.20535250008106232f, 0.17782793939113617f, 0.1539926528930664f, 0.133352130651474f, 0.11547820270061493f, 0.10000000149011612f, 0.08659642934799194f, 0.07498941570520401f, 0.06493816524744034f, 0.05623413249850273f, 0.04869675263762474f, 0.04216965287923813f, 0.03651741147041321f, 0.03162277489900589f, 0.02738419733941555f, 0.023713737726211548f, 0.02053525112569332f, 0.017782794311642647f, 0.015399265103042126f, 0.01333521492779255f, 0.011547820642590523f, 0.009999999776482582f, 0.00865964312106371f, 0.007498941849917173f, 0.006493816152215004f, 0.005623413249850273f, 0.004869675263762474f, 0.0042169648222625256f, 0.0036517411936074495f, 0.003162277629598975f, 0.0027384196873754263f, 0.00237137358635664f, 0.0020535248331725597f, 0.0017782794311642647f, 0.0015399265103042126f, 0.0013335214462131262f, 0.0011547819012776017f, 0.0010000000474974513f, 0.0008659643353894353f, 0.0007498942431993783f, 0.0006493816617876291f, 0.000562341301701963f, 0.0004869675321970135f, 0.0004216965171508491f, 0.0003651741426438093f, 0.0003162277571391314f, 0.00027384195709601045f, 0.00023713737027719617f, 0.00020535250951070338f, 0.00017782794020604342f, 0.00015399264520965517f, 0.0001333521504420787f, 0.00011547820031410083f};

__device__ __forceinline__ void sincos_acc(float ang, float& c, float& s) {
    const double a = (double)ang;
    const double k = __builtin_rint(a * 0.63661977236758134308);
    double r = __builtin_fma(-k, 1.57079632679489661923, a);
    r = __builtin_fma(-k, 6.123233995736766e-17, r);
    const double r2 = r * r;
    double sp = -2.5052108385441718775e-8;
    sp = __builtin_fma(sp, r2, 2.7557319223985890653e-6);
    sp = __builtin_fma(sp, r2, -1.9841269841269841270e-4);
    sp = __builtin_fma(sp, r2, 8.3333333333333333333e-3);
    sp = __builtin_fma(sp, r2, -1.6666666666666666667e-1);
    const double sr = __builtin_fma(sp * r2, r, r);
    double cp = 2.0876756987868098979e-9;
    cp = __builtin_fma(cp, r2, -2.7557319223985890653e-7);
    cp = __builtin_fma(cp, r2, 2.4801587301587301587e-5);
    cp = __builtin_fma(cp, r2, -1.3888888888888888889e-3);
    cp = __builtin_fma(cp, r2, 4.1666666666666666667e-2);
    cp = __builtin_fma(cp, r2, -0.5);
    const double cr = __builtin_fma(cp, r2, 1.0);
    const int q = (int)((long long)k & 3);
    const double cc = (q == 0) ? cr : (q == 1) ? -sr : (q == 2) ? -cr : sr;
    const double ss = (q == 0) ? sr : (q == 1) ? cr : (q == 2) ? -sr : -cr;
    c = (float)cc; s = (float)ss;
}

enum { J_WI = 0, J_WO = 1, J_EVIN = 2, J_ODIN = 3, J_PLAIN = 4 };
__device__ __forceinline__ int dst_row(int job, int j) {
    switch (job) {
    case J_WI: { const int half = j >= DFF ? 1 : 0, jj = j - half * DFF; return (jj >> 7) * 256 + half * 128 + (jj & 127); }
    case J_EVIN: return j < 1536 ? j : (j < 1552 ? -1 : 1792 + (j - 1552));
    case J_ODIN: if (j < 1280) { const int d = j & 127; return (j & ~127) + 2 * (d & 63) + (d >> 6); }
                 if (j < 1536) return j;
                 if (j < 1856) { const int d = j & 63; return (j & ~63) + 2 * (d & 31) + (d >> 5); }
                 return j;
    default: return j;
    }
}
__device__ __forceinline__ void conv_item(const float* W, int N, int K, const float* gain, bf16_t* WT, int job, int k0, int c0, LAS unsigned char* scr, int lane) {
    const int c4 = lane & 15, kr = lane >> 4, col = c0 + 4 * c4;
    f32x4 v[16];
    const bool ok = col < N;
    const float* src = W + (size_t)(k0 + kr * 16) * N + col;
#pragma unroll
    for (int i = 0; i < 16; ++i) v[i] = ok ? *(const f32x4*)(src + (size_t)i * N) : (f32x4){0.f, 0.f, 0.f, 0.f};
    if (gain) {
        const f32x4* gp = (const f32x4*)(gain + k0 + kr * 16);
#pragma unroll
        for (int q = 0; q < 4; ++q) { const f32x4 g4 = gp[q];
#pragma unroll
            for (int e = 0; e < 4; ++e) v[4 * q + e] = v[4 * q + e] * g4[e]; }
    }
#pragma unroll
    for (int e = 0; e < 4; ++e) {
        u32x4 w0, w1;
        w0.x = cvt_pk_bf16(v[0][e], v[1][e]); w0.y = cvt_pk_bf16(v[2][e], v[3][e]); w0.z = cvt_pk_bf16(v[4][e], v[5][e]); w0.w = cvt_pk_bf16(v[6][e], v[7][e]);
        w1.x = cvt_pk_bf16(v[8][e], v[9][e]); w1.y = cvt_pk_bf16(v[10][e], v[11][e]); w1.z = cvt_pk_bf16(v[12][e], v[13][e]); w1.w = cvt_pk_bf16(v[14][e], v[15][e]);
        LAS unsigned char* d = scr + (4 * c4 + e) * 144 + kr * 32;
        *(LAS u32x4*)d = w0; *(LAS u32x4*)(d + 16) = w1;
    }
    asm volatile("s_waitcnt lgkmcnt(0)" ::: "memory");
#pragma unroll
    for (int j = 0; j < 8; ++j) {
        const int cl = (lane >> 3) + 8 * j, ch = lane & 7, sc_ = c0 + cl;
        const u32x4 w = *(const LAS u32x4*)(scr + cl * 144 + ch * 16);
        const int n = sc_ < N ? dst_row(job, sc_) : -1;
        if (n >= 0) *(u32x4*)(WT + (size_t)n * K + k0 + ch * 8) = w;
    }
    asm volatile("s_waitcnt lgkmcnt(0)" ::: "memory");
}


constexpr int C_WI = NFF / 64, I_WI = (DM / 64) * C_WI, C_WO = DM / 64, I_WO = (DFF / 64) * C_WO, C_EV = (EVEN_IN + 63) / 64, I_EV = (DM / 64) * C_EV, C_OD = (ODD_IN + 63) / 64, I_OD = (DM / 64) * C_OD;
constexpr int I_EO = 8 * 16, I_OO = 16 * 16;
constexpr int CV_WO0 = 4 * I_WI, CV_EV = CV_WO0 + 4 * I_WO, CV_OD = CV_EV + I_EV, CV_EO = CV_OD + I_OD, CV_OO = CV_EO + I_EO, CV_END = CV_OO + I_OO;
#define CV_WI(sub) ((sub) * I_WI)
#define CV_WO(sub) (CV_WO0 + (sub) * I_WO)
__device__ __forceinline__ void conv_range(const KArgs& A, unsigned char* ws, int lo, int hi, int widx, int nw, LAS unsigned char* scr, int lane) {
    for (int it = lo + widx; it < hi; it += nw) {
        int r = it;
        if (r < 4 * I_WI) { const int sub = r / I_WI, q = r % I_WI, l = sub >> 1, f = sub & 1;
            conv_item((f ? A.ffn2_wi : A.ffn1_wi) + (size_t)l * DM * NFF, NFF, DM, (f ? A.ffn2_norm : A.ffn1_norm) + l * DM, (bf16_t*)(ws + WS_WIT + (size_t)sub * 11 * MiB), J_WI, (q / C_WI) * 64, (q % C_WI) * 64, scr, lane); continue; } r -= 4 * I_WI;
        if (r < 4 * I_WO) { const int sub = r / I_WO, q = r % I_WO, l = sub >> 1, f = sub & 1;
            conv_item((f ? A.ffn2_wo : A.ffn1_wo) + (size_t)l * DFF * DM, DM, DFF, nullptr, (bf16_t*)(ws + WS_WOT + (size_t)sub * 5632 * 1024), J_WO, (q / C_WO) * 64, (q % C_WO) * 64, scr, lane); continue; } r -= 4 * I_WO;
        if (r < I_EV) { conv_item(A.even_w_in, EVEN_IN, DM, A.mix_norm, (bf16_t*)(ws + WS_EVIN), J_EVIN, (r / C_EV) * 64, (r % C_EV) * 64, scr, lane); continue; } r -= I_EV;
        if (r < I_OD) { conv_item(A.odd_w_in, ODD_IN, DM, A.mix_norm + DM, (bf16_t*)(ws + WS_ODIN), J_ODIN, (r / C_OD) * 64, (r % C_OD) * 64, scr, lane); continue; } r -= I_OD;
        if (r < I_EO) { conv_item(A.even_w_out, DM, DM, nullptr, (bf16_t*)(ws + WS_EVOUT), J_PLAIN, (r / 16) * 64, (r % 16) * 64, scr, lane); continue; } r -= I_EO;
        conv_item(A.odd_w_out, DM, DM, nullptr, (bf16_t*)(ws + WS_ODOUT), J_PLAIN, (r / 16) * 64, (r % 16) * 64, scr, lane);
    }
}
__device__ __forceinline__ void conv_extras_even(const KArgs& A, unsigned char* ws, int widx, int nw, int lane) {
    for (int it = widx; it < 128 * 4; it += nw) {
        const int kc = it >> 2, j = (it & 3) * 64 + lane, k0 = kc * 8;
        float gwv[16];
#pragma unroll
        for (int r = 0; r < 16; ++r) gwv[r] = A.gate_w[r * 256 + j];
        float o[8];
#pragma unroll
        for (int e = 0; e < 8; ++e) { const f32x4* wp = (const f32x4*)(A.even_w_in + (size_t)(k0 + e) * EVEN_IN + 1536); float sacc = 0.f;
#pragma unroll
            for (int q = 0; q < 4; ++q) { const f32x4 w4 = wp[q]; sacc += w4[0] * gwv[4 * q] + w4[1] * gwv[4 * q + 1] + w4[2] * gwv[4 * q + 2] + w4[3] * gwv[4 * q + 3]; }
            o[e] = sacc * A.mix_norm[k0 + e]; }
        *(u32x4*)((bf16_t*)(ws + WS_EVIN) + (size_t)(1536 + j) * DM + k0) = pack8((f32x4){o[0], o[1], o[2], o[3]}, (f32x4){o[4], o[5], o[6], o[7]});
    }
    for (int it = widx; it < 16 * 4 * 32; it += nw) {
        const int ng = it & 15, g = (it >> 4) & 3, cc = it >> 6, n = ng * 64 + lane, ci0 = cc * 4;
        const float* pw = A.pool_w + ((size_t)g * 128 + ci0) * 128; const float* ps = A.pool_scale + g * 128; const float* wo = A.even_w_out + (size_t)(512 + g * 128) * DM + n;
        float o[4] = {0.f, 0.f, 0.f, 0.f};
#pragma unroll 1
        for (int d0 = 0; d0 < 128; d0 += 32) {
            float wv_[32];
#pragma unroll
            for (int dd = 0; dd < 32; ++dd) wv_[dd] = wo[(size_t)(d0 + dd) * DM];
#pragma unroll
            for (int dd = 0; dd < 32; ++dd) { const float x = wv_[dd] * ps[d0 + dd];
#pragma unroll
                for (int e = 0; e < 4; ++e) o[e] += pw[e * 128 + d0 + dd] * x; }
        }
        u32x2 w; w.x = cvt_pk_bf16(o[0], o[1]); w.y = cvt_pk_bf16(o[2], o[3]);
        *(u32x2*)((bf16_t*)(ws + WS_EVOUT) + (size_t)n * DM + 512 + g * 128 + ci0) = w;
    }
}
__device__ __forceinline__ void conv_zero_pad_odd(unsigned char* ws, int widx, int nw, int lane) {
    bf16_t* zp = (bf16_t*)(ws + WS_ODIN) + (size_t)ODD_IN * DM;
    unsigned z_ = 0u; asm volatile("" : "+v"(z_));
    for (int idx = widx * 64 + lane; idx < (ODD_N - ODD_IN) * DM / 8; idx += nw * 64) *(u32x4*)(zp + (size_t)idx * 8) = (u32x4){z_, z_, z_, z_};
}

template <int W> __device__ __forceinline__ void pool_item(const bf16_t* U, bf16_t* mix, int m, int c0, int s) {
    u32x4 r[W];
#pragma unroll
    for (int i = 0; i < W; ++i) r[i] = *(const u32x4*)(U + (size_t)(s >= i ? m - i : m) * 512 + c0);
    float sum[8] = {0.f, 0.f, 0.f, 0.f, 0.f, 0.f, 0.f, 0.f}, cur[8];
#pragma unroll
    for (int i = 0; i < W; ++i) { const float wgt = (s >= i) ? 1.f : 0.f; const unsigned w4[4] = {r[i].x, r[i].y, r[i].z, r[i].w};
#pragma unroll
        for (int e = 0; e < 8; ++e) { const float v = bf2f((e & 1) ? (w4[e >> 1] >> 16) : (w4[e >> 1] & 0xffffu)); if (i == 0) cur[e] = v; sum[e] += wgt * v; } }
    const float ic = 1.0f / (float)((s + 1 < W) ? s + 1 : W);
    f32x4 o0, o1;
#pragma unroll
    for (int e = 0; e < 4; ++e) { o0[e] = sum[e] * ic - cur[e]; o1[e] = sum[4 + e] * ic - cur[4 + e]; }
    *(u32x4*)(mix + (size_t)m * DM + 512 + c0) = pack8(o0, o1);
}
#define XB_TMO      128
#define XB_XCNT(j)  (256  + 64 * (j))
#define XB_XSUB(j)  (1280 + 64 * (j))
#define XB_XGEN(j)  (2304 + 64 * (j))
#define XB_TOP      3328
#define XB_TOPGEN   3392
#define XCD_BAR_WORDS 3456
#define XB_SPIN_CAP (1u << 18)
__device__ __forceinline__ unsigned xb_ld(unsigned* p)              { return __hip_atomic_load(p, __ATOMIC_RELAXED, __HIP_MEMORY_SCOPE_AGENT); }
__device__ __forceinline__ unsigned xb_add(unsigned* p, unsigned v) { return __hip_atomic_fetch_add(p, v, __ATOMIC_RELAXED, __HIP_MEMORY_SCOPE_AGENT); }
__device__ __forceinline__ unsigned xb_xcc_id() { return (unsigned)__builtin_amdgcn_s_getreg((3 << 11) | 20) & 0xFu; }
#define XB_SPIN(cond, bar) do { unsigned _sp = 0; while (cond) { __builtin_amdgcn_s_sleep(1); \
    if ((++_sp & 255u) == 0u) { if (xb_ld(&(bar)[XB_TMO])) break; if (_sp > XB_SPIN_CAP) { atomicAdd(&(bar)[XB_TMO], 1u); break; } } } } while (0)
struct XcdBarrier { unsigned* bar; unsigned x; volatile LAS unsigned* st; };
__device__ __forceinline__ XcdBarrier xcd_barrier_post(unsigned* bar, volatile LAS unsigned* st) {
    XcdBarrier b; b.bar = bar; b.x = xb_xcc_id(); b.st = st;
    if (threadIdx.x == 0) (void)xb_add(&bar[XB_XCNT(b.x)], 1u);
    return b;
}
__device__ __forceinline__ void xcd_barrier_complete(unsigned* bar, unsigned x, unsigned& nloc, unsigned& nx) {
    const unsigned G = gridDim.x * gridDim.y * gridDim.z;
    unsigned sum, cnt, mine, sp = 0u;
    for (;;) {
        sum = 0u; cnt = 0u; mine = 0u;
#pragma unroll
        for (unsigned j = 0; j < 16; ++j) { const unsigned c = xb_ld(&bar[XB_XCNT(j)]); sum += c; cnt += (c > 0u) ? 1u : 0u; mine = (j == x) ? c : mine; }
        if (sum == G) break;
        __builtin_amdgcn_s_sleep(1);
        if ((++sp & 255u) == 0u) { if (xb_ld(&bar[XB_TMO])) break; if (sp > XB_SPIN_CAP) { atomicAdd(&bar[XB_TMO], 1u); break; } }
    }
    nloc = mine > 0u ? mine : 1u; nx = cnt > 0u ? cnt : 1u;
}
__device__ __forceinline__ void xcd_barrier(const XcdBarrier& b, const int wv) {
    asm volatile("s_waitcnt vmcnt(0)" ::: "memory");
    __syncthreads();
    if (wv == 0 && opaque_lane() == 0) {
        unsigned* bar = b.bar;
        __builtin_amdgcn_s_waitcnt(0);
        unsigned nloc = b.st[0], nx = b.st[1];
        if (nloc == 0u) { xcd_barrier_complete(bar, b.x, nloc, nx); b.st[0] = nloc; b.st[1] = nx; }
        const unsigned old = xb_add(&bar[XB_XSUB(b.x)], 1u);
        const unsigned gen = old / nloc;
        if (old + 1u == (gen + 1u) * nloc) {
            __builtin_amdgcn_fence(__ATOMIC_RELEASE, "agent");
            asm volatile("s_waitcnt vmcnt(0)" ::: "memory");
            const unsigned og = xb_add(&bar[XB_TOP], 1u);
            const unsigned tg = og / nx;
            if (og + 1u == (tg + 1u) * nx) xb_add(&bar[XB_TOPGEN], 1u);
            else XB_SPIN(xb_ld(&bar[XB_TOPGEN]) == tg, bar);
            __builtin_amdgcn_fence(__ATOMIC_ACQUIRE, "agent");
            xb_add(&bar[XB_XGEN(b.x)], 1u);
            asm volatile("s_waitcnt vmcnt(0)" ::: "memory");
        } else {
            XB_SPIN(xb_ld(&bar[XB_XGEN(b.x)]) == gen, bar);
            __builtin_amdgcn_fence(__ATOMIC_ACQUIRE, "agent");
            asm volatile("s_waitcnt vmcnt(0)" ::: "memory");
        }
    }
    __syncthreads();
}

__device__ __forceinline__ void cnt_ge4(unsigned& a0, unsigned& a1, unsigned& a2, unsigned& a3, unsigned k0, unsigned k1, unsigned k2, unsigned k3, unsigned cand) {
    unsigned long long m0, m1, m2, m3;
    asm volatile("v_cmp_ge_u32_e64 %4, %8, %12\n\t"
                 "v_cmp_ge_u32_e64 %5, %9, %12\n\t"
                 "v_cmp_ge_u32_e64 %6, %10, %12\n\t"
                 "v_cmp_ge_u32_e64 %7, %11, %12\n\t"
                 "v_addc_co_u32_e64 %0, %4, 0, %0, %4\n\t"
                 "v_addc_co_u32_e64 %1, %5, 0, %1, %5\n\t"
                 "v_addc_co_u32_e64 %2, %6, 0, %2, %6\n\t"
                 "v_addc_co_u32_e64 %3, %7, 0, %3, %7"
                 : "+v"(a0), "+v"(a1), "+v"(a2), "+v"(a3), "=&s"(m0), "=&s"(m1), "=&s"(m2), "=&s"(m3)
                 : "v"(k0), "v"(k1), "v"(k2), "v"(k3), "s"(cand));
}
__device__ __forceinline__ int wave_sum_u32(unsigned x) {
    x += (unsigned)__builtin_amdgcn_update_dpp(0, (int)x, 0xB1, 0xf, 0xf, true);
    x += (unsigned)__builtin_amdgcn_update_dpp(0, (int)x, 0x4E, 0xf, 0xf, true);
    x += (unsigned)__builtin_amdgcn_update_dpp(0, (int)x, 0x141, 0xf, 0xf, true);
    x += (unsigned)__builtin_amdgcn_update_dpp(0, (int)x, 0x140, 0xf, 0xf, true);
    return (int)(__builtin_amdgcn_readlane((int)x, 0) + __builtin_amdgcn_readlane((int)x, 16) + __builtin_amdgcn_readlane((int)x, 32) + __builtin_amdgcn_readlane((int)x, 48));
}

__device__ __forceinline__ unsigned wave_prefix_incl_u32(unsigned x, int lane) {
    x += (unsigned)__builtin_amdgcn_update_dpp(0, (int)x, 0x111, 0xf, 0xf, false);
    x += (unsigned)__builtin_amdgcn_update_dpp(0, (int)x, 0x112, 0xf, 0xf, false);
    x += (unsigned)__builtin_amdgcn_update_dpp(0, (int)x, 0x114, 0xf, 0xf, false);
    x += (unsigned)__builtin_amdgcn_update_dpp(0, (int)x, 0x118, 0xf, 0xf, false);
    const unsigned r0 = (unsigned)__builtin_amdgcn_readlane((int)x, 15), r1 = (unsigned)__builtin_amdgcn_readlane((int)x, 31), r2 = (unsigned)__builtin_amdgcn_readlane((int)x, 47);
    const int row = lane >> 4;
    return x + (row > 0 ? r0 : 0u) + (row > 1 ? r1 : 0u) + (row > 2 ? r2 : 0u);
}
__device__ __forceinline__ unsigned wave_max_u32(unsigned x) {
    unsigned y;
    y = (unsigned)__builtin_amdgcn_update_dpp(0, (int)x, 0xB1, 0xf, 0xf, true); x = x > y ? x : y;
    y = (unsigned)__builtin_amdgcn_update_dpp(0, (int)x, 0x4E, 0xf, 0xf, true); x = x > y ? x : y;
    y = (unsigned)__builtin_amdgcn_update_dpp(0, (int)x, 0x141, 0xf, 0xf, true); x = x > y ? x : y;
    y = (unsigned)__builtin_amdgcn_update_dpp(0, (int)x, 0x140, 0xf, 0xf, true); x = x > y ? x : y;
    const unsigned a = (unsigned)__builtin_amdgcn_readlane((int)x, 0), b = (unsigned)__builtin_amdgcn_readlane((int)x, 16), c = (unsigned)__builtin_amdgcn_readlane((int)x, 32), d = (unsigned)__builtin_amdgcn_readlane((int)x, 48);
    const unsigned ab = a > b ? a : b, cd = c > d ? c : d; return ab > cd ? ab : cd;
}

__global__ void __launch_bounds__(512, 2) fwd_megakernel(KArgs Aarg) {
    extern __shared__ __attribute__((aligned(16))) unsigned char lds[];
    cg::grid_group grid = cg::this_grid();
    (void)Aarg;
    const int G = gridDim.x, bx = blockIdx.x;
    const int wv_ = __builtin_amdgcn_readfirstlane((int)threadIdx.x >> 6);
    const int vcu = (G % 8 == 0) ? (bx % 8) * (G / 8) + bx / 8 : bx;
    LAS unsigned char* ldsl = (LAS unsigned char*)lds;
#define PHASE_ARGS() const KArgs A = load_kargs(); unsigned char* const ws = A.ws; (void)ws
#define PHASE_IDS() PHASE_ARGS(); const int tid = fresh_tid(), lane = tid & 63, wave = __builtin_amdgcn_readfirstlane(tid >> 6); const int gw = vcu * 8 + wave, NGW = G * 8; (void)lane; (void)gw; (void)NGW
#define SSQ ((float*)(ws + WS_SSQ))
#define DVEC ((float*)(ws + WS_DVEC))
#define WI1 ((float*)(ws + WS_WI1))
#define HB ((bf16_t*)(ws + WS_HB))
#define HID ((bf16_t*)(ws + WS_HID))
#define CS ((float*)(ws + WS_CS))
#define QK0 ((bf16_t*)(ws + WS_QK0))
#define V0 ((bf16_t*)(ws + WS_V0))
#define G0 ((bf16_t*)(ws + WS_G0))
#define U0 ((bf16_t*)(ws + WS_U0))
#define LA ((float*)(ws + WS_LA))
#define ST0 ((bf16_t*)(ws + WS_ST0))
#define MIX ((bf16_t*)(ws + WS_MIX))
#define Q1 ((bf16_t*)(ws + WS_Q1))
#define K1 ((bf16_t*)(ws + WS_K1))
#define V1 ((bf16_t*)(ws + WS_V1))
#define QIH ((bf16_t*)(ws + WS_QIH))
#define QIL ((bf16_t*)(ws + WS_QIL))
#define KIH ((bf16_t*)(ws + WS_KIH))
#define KIL ((bf16_t*)(ws + WS_KIL))
#define MASK ((unsigned long long*)(ws + WS_MASK))
    for (int u_ = threadIdx.x; u_ < (LDS_BYTES - RING_BYTES) / 4; u_ += 512) ((LAS unsigned*)(ldsl + RING_BYTES))[u_] = 0u;
    __syncthreads();
    XcdBarrier xbar;
    { KArgsCP kp_ = kargs(); xbar = xcd_barrier_post((unsigned*)(kp_->ws + WS_CTL) + 4096, (volatile LAS unsigned*)(ldsl + RING_BYTES + 512)); }
#define GSYNC() xcd_barrier(xbar, wv_)

#ifndef NO_P0
    for (int dup_ = 0; dup_ < NDUP_P0; ++dup_) { if (dup_) { GSYNC(); }
    {
        PHASE_IDS();
        LAS unsigned char* scr = ldsl + wave * 16384;
        conv_range(A, ws, CV_WI(0), CV_WI(1), gw, NGW, scr, lane);
        if (G != 256) { conv_range(A, ws, CV_WI(1), CV_END, gw, NGW, scr, lane); conv_extras_even(A, ws, gw, NGW, lane); conv_zero_pad_odd(ws, gw, NGW, lane); }
        for (int m0 = gw * 4; m0 < M; m0 += NGW * 4) {
            f32x4 v[4][4];
#pragma unroll
            for (int i = 0; i < 4; ++i) { const f32x4* xr = (const f32x4*)(A.x + (size_t)(m0 + i) * DM) + lane;
#pragma unroll
                for (int j = 0; j < 4; ++j) v[i][j] = xr[64 * j]; }
#pragma unroll
            for (int i = 0; i < 4; ++i) { const int m = m0 + i; float s = 0.f;
#pragma unroll
                for (int j = 0; j < 4; ++j) s += (v[i][j][0] * v[i][j][0] + v[i][j][1] * v[i][j][1]) + (v[i][j][2] * v[i][j][2] + v[i][j][3] * v[i][j][3]);
                s = wave_sum(s);
                u32x2* o8 = (u32x2*)(HB + (size_t)m * DM) + lane;
#pragma unroll
                for (int j = 0; j < 4; ++j) { u32x2 w; w.x = cvt_pk_bf16(v[i][j][0], v[i][j][1]); w.y = cvt_pk_bf16(v[i][j][2], v[i][j][3]); o8[64 * j] = w; }
                if (lane < 16) SSQ[(size_t)m * 16 + lane] = (lane == 0) ? s : 0.f; }
        }
        for (int idx = (vcu * 512 + tid); idx < M * 64; idx += G * 512) {
            const int m = idx >> 6, i = idx & 63;
            const float ang = (float)A.pos[m] * INV128[i];
            float c, s; sincos_acc(ang, c, s);
            *(f32x2*)(CS + (size_t)idx * 2) = (f32x2){c, s};
        }
    }
    }
#endif
    { KArgsCP kp_ = kargs(); if (kp_->ws == nullptr) grid.sync(); }
    GSYNC();

    for (int li = 0; li < 2; ++li) {
        for (int f = 0; f < 2; ++f) {
            if (f == 1) {
                if (li == 0) {
#ifndef NO_PROJ0
    for (int dup_ = 0; dup_ < NDUP_PROJ0; ++dup_) { if (dup_) { GSYNC(); }
                    { PHASE_ARGS(); pg8::Gemm g{HB, (const bf16_t*)(ws + WS_EVIN), M, EVEN_N, DM}; pg8::StaticOrder S; S.init(M, EVEN_N, G, bx);
                      pg8::EpiP0 E{SSQ, A.gate_b, QK0, V0, G0, U0, LA};
                      pg8::gemm_phase<pg8::EpiP0, pg8::StaticOrder, true, true>(ldsl, g, S, E, fresh_tid()); }
                    if (bx >= 64 && G == 256) { PHASE_IDS(); const int widx = (bx - 64) * 8 + wave, nw = 192 * 8; LAS unsigned char* scr = ldsl + wave * 16384;
                        conv_range(A, ws, CV_WI(1), CV_WI(2), widx, nw, scr, lane); conv_range(A, ws, CV_WO(1), CV_WO(2), widx, nw, scr, lane); }
    }
#endif
                    GSYNC();
#ifndef NO_G1
    for (int dup_ = 0; dup_ < NDUP_G1; ++dup_) { if (dup_) { GSYNC(); }
                    {
                        PHASE_IDS();
                        LAS float* BL = (LAS float*)ldsl; LAS float* TOT = (LAS float*)(ldsl + 16384); LAS unsigned char* KDT = ldsl + 18432; LAS unsigned char* VT = ldsl + 46080;
                        const int r32 = lane & 31, hh = lane >> 5;
                        for (int unit = vcu; unit < 1024; unit += G) {
                            const int bh = unit >> 6, n = unit & 63, b = bh >> 2, h = bh & 3; const size_t m0 = (size_t)b * SEQ + n * 64;
                            float lav[8];
#pragma unroll
                            for (int i = 0; i < 8; ++i) lav[i] = LA[(m0 + wave * 8 + i) * 256 + h * 64 + lane];
                            const u32x4 kq_p = *(const u32x4*)(QK0 + (m0 + (tid >> 3)) * 512 + 256 + h * 64 + (tid & 7) * 8);
                            u32x4 vq_p[2];
#pragma unroll
                            for (int c2 = 0; c2 < 2; ++c2) { const int c = tid + 512 * c2; vq_p[c2] = *(const u32x4*)(V0 + (m0 + (c >> 4)) * 512 + h * 128 + (c & 15) * 8); }
                            { const int d = lane; float pr[8]; float run = 0.f;
#pragma unroll
                              for (int i = 0; i < 8; ++i) { run += lav[i]; pr[i] = run; }
                              TOT[wave * 64 + d] = run; __syncthreads();
                              float tv_[8];
#pragma unroll
                              for (int s_ = 0; s_ < 8; ++s_) tv_[s_] = TOT[s_ * 64 + d];
                              float off = 0.f;
#pragma unroll
                              for (int s_ = 0; s_ < 7; ++s_) off += (s_ < wave) ? tv_[s_] : 0.f;
#pragma unroll
                              for (int i = 0; i < 8; ++i) BL[(wave * 8 + i) * 64 + d] = off + pr[i]; }
                            __syncthreads();
                            { const int t = tid >> 3, d0 = (tid & 7) * 8;
                              const u32x4 kq = kq_p;
                              const unsigned kw[4] = {kq.x, kq.y, kq.z, kq.w};
                              float xf[8];
#pragma unroll
                              for (int i = 0; i < 8; ++i) { const float kv = bf2f((i & 1) ? (kw[i >> 1] >> 16) : (kw[i >> 1] & 0xffffu));
                                  xf[i] = kv * __expf(BL[63 * 64 + d0 + i] - BL[t * 64 + d0 + i]); }
                              *(LAS u32x4*)(KDT + att::v_st(t, d0)) = pack8((f32x4){xf[0], xf[1], xf[2], xf[3]}, (f32x4){xf[4], xf[5], xf[6], xf[7]});
                              if (tid < 64) DVEC[unit * 64 + tid] = __expf(BL[63 * 64 + tid]);
#pragma unroll
                              for (int c2 = 0; c2 < 2; ++c2) { const int c = tid + 512 * c2, tt = c >> 4, e0 = (c & 15) * 8;
                                  *(LAS u32x4*)(VT + att::v_st(tt, e0)) = vq_p[c2]; } }
                            __syncthreads();
                            { const int dt = wave >> 2, et = wave & 3; f32x16 c = {};
                              const int kb0_ = (int)(uintptr_t)KDT + att::v_rd_base(lane), vb0_ = (int)(uintptr_t)VT + att::v_rd_base(lane);
#pragma unroll
                              for (int ks = 0; ks < 4; ++ks) { const bf16x8 a = tr_frag(kb0_, att::v_rd_off(dt, ks, 0)), bb = tr_frag(vb0_, att::v_rd_off(et, ks, 0));
                                  c = __builtin_amdgcn_mfma_f32_32x32x16_bf16(a, bb, c, 0, 0, 0); }
                              bf16_t* dst = ST0 + (size_t)unit * 8192 + (32 * et + r32) * 64 + 32 * dt + 4 * hh;
#pragma unroll
                              for (int g4 = 0; g4 < 4; ++g4) { u32x2 w; w.x = cvt_pk_bf16(c[4 * g4], c[4 * g4 + 1]); w.y = cvt_pk_bf16(c[4 * g4 + 2], c[4 * g4 + 3]); *(u32x2*)(dst + 8 * g4) = w; } }
                            __syncthreads();
                        }
                        for (int idx = vcu * 512 + tid; idx < 4 * M * 16; idx += G * 512) {
                            const int gi = idx / (M * 16), rem = idx - gi * (M * 16), m = rem >> 4, c0 = gi * 128 + (rem & 15) * 8, s = m & (SEQ - 1);
                            if (gi == 0) pool_item<2>(U0, MIX, m, c0, s); else if (gi == 1) pool_item<4>(U0, MIX, m, c0, s); else if (gi == 2) pool_item<8>(U0, MIX, m, c0, s); else pool_item<16>(U0, MIX, m, c0, s);
                        }
                    }
    }
#endif
                    GSYNC();
#ifndef NO_G2
                    { PHASE_IDS();
                    for (int idx = vcu * 512 + tid; idx < 16 * 8192; idx += G * 512) {
                        const int bh = idx >> 13, de = idx & 8191, d = de & 63;
                        bf16_t* p = ST0 + (size_t)bh * 64 * 8192 + de; const float* dv = DVEC + bh * 64 * 64 + d;
                        float uu[64];
#pragma unroll
                        for (int n = 0; n < 64; ++n) uu[n] = bf2f(p[(size_t)n * 8192]);
                        float st = 0.f;
#pragma unroll
                        for (int n = 0; n < 64; ++n) { p[(size_t)n * 8192] = (bf16_t)f2bf(st); st = dv[n * 64] * st + uu[n]; }
                    } }
#endif
                    GSYNC();
#ifndef NO_G3
    for (int dup_ = 0; dup_ < NDUP_G3; ++dup_) { if (dup_) { GSYNC(); }
                    {
                        PHASE_IDS();
                        LAS float* BL = (LAS float*)ldsl; LAS float* TOT = (LAS float*)(ldsl + 16384); LAS unsigned char* QS = ldsl + 18432; LAS unsigned char* KS = ldsl + 27648; LAS unsigned char* SCB = ldsl + 36864;
                        LAS unsigned char* VT = ldsl + 46080; LAS unsigned char* SLT = ldsl + 64512; LAS float* OUTL = (LAS float*)(ldsl + 82944);
                        const int r32 = lane & 31, hh = lane >> 5;
                        for (int unit = vcu; unit < 1024; unit += G) {
                            const int bh = unit >> 6, n = unit & 63, b = bh >> 2, h = bh & 3; const size_t m0 = (size_t)b * SEQ + n * 64;
                            float lav[8];
#pragma unroll
                            for (int i = 0; i < 8; ++i) lav[i] = LA[(m0 + wave * 8 + i) * 256 + h * 64 + lane];
                            const u32x4 qq_p = *(const u32x4*)(QK0 + (m0 + (tid >> 3)) * 512 + h * 64 + (tid & 7) * 8), kq_p = *(const u32x4*)(QK0 + (m0 + (tid >> 3)) * 512 + 256 + h * 64 + (tid & 7) * 8);
                            u32x4 vq_p[2], sq_p[2];
#pragma unroll
                            for (int c2 = 0; c2 < 2; ++c2) { const int c = tid + 512 * c2; vq_p[c2] = *(const u32x4*)(V0 + (m0 + (c >> 4)) * 512 + h * 128 + (c & 15) * 8);
                                sq_p[c2] = *(const u32x4*)(ST0 + (size_t)unit * 8192 + (c >> 3) * 64 + (c & 7) * 8); }
                            const u32x4 g0_p = *(const u32x4*)(G0 + (m0 + (tid >> 3)) * 512 + h * 128 + (tid & 7) * 16), g1_p = *(const u32x4*)(G0 + (m0 + (tid >> 3)) * 512 + h * 128 + (tid & 7) * 16 + 8);
                            f32x4 on_p[4];
#pragma unroll
                            for (int j4 = 0; j4 < 4; ++j4) on_p[j4] = *(const f32x4*)(A.out_norm + h * 128 + (tid & 7) * 16 + j4 * 4);
                            { const int d = lane; float pr[8]; float run = 0.f;
#pragma unroll
                              for (int i = 0; i < 8; ++i) { run += lav[i]; pr[i] = run; }
                              TOT[wave * 64 + d] = run; __syncthreads();
                              float tv_[8];
#pragma unroll
                              for (int s_ = 0; s_ < 8; ++s_) tv_[s_] = TOT[s_ * 64 + d];
                              float off = 0.f;
#pragma unroll
                              for (int s_ = 0; s_ < 7; ++s_) off += (s_ < wave) ? tv_[s_] : 0.f;
#pragma unroll
                              for (int i = 0; i < 8; ++i) BL[(wave * 8 + i) * 64 + d] = off + pr[i]; }
                            __syncthreads();
                            { const int t = tid >> 3, d0 = (tid & 7) * 8;
                              const u32x4 qq = qq_p, kq = kq_p;
                              const unsigned qw[4] = {qq.x, qq.y, qq.z, qq.w}, kw[4] = {kq.x, kq.y, kq.z, kq.w};
                              float qf[8], kf[8];
#pragma unroll
                              for (int i = 0; i < 8; ++i) { const float bb = BL[t * 64 + d0 + i];
                                  qf[i] = bf2f((i & 1) ? (qw[i >> 1] >> 16) : (qw[i >> 1] & 0xffffu)) * 0.125f * __expf(bb);
                                  kf[i] = bf2f((i & 1) ? (kw[i >> 1] >> 16) : (kw[i >> 1] & 0xffffu)) * __expf(-bb); }
                              *(LAS u32x4*)(QS + t * 144 + d0 * 2) = pack8((f32x4){qf[0], qf[1], qf[2], qf[3]}, (f32x4){qf[4], qf[5], qf[6], qf[7]});
                              *(LAS u32x4*)(KS + t * 144 + d0 * 2) = pack8((f32x4){kf[0], kf[1], kf[2], kf[3]}, (f32x4){kf[4], kf[5], kf[6], kf[7]});
#pragma unroll
                              for (int c2 = 0; c2 < 2; ++c2) { const int c = tid + 512 * c2, tt = c >> 4, e0 = (c & 15) * 8;
                                  *(LAS u32x4*)(VT + att::v_st(tt, e0)) = vq_p[c2];
                                  const int e = c >> 3, dd0 = (c & 7) * 8;
                                  *(LAS u32x4*)(SLT + e * 144 + dd0 * 2) = sq_p[c2]; } }
                            __syncthreads();
                            if (wave < 3) { const int it = (wave + 1) >> 1, jt = wave == 2 ? 1 : 0; f32x16 c = {};
#pragma unroll
                                for (int ks = 0; ks < 4; ++ks) { const bf16x8 a = *(const LAS bf16x8*)(QS + (32 * it + r32) * 144 + ks * 32 + hh * 16), bb = *(const LAS bf16x8*)(KS + (32 * jt + r32) * 144 + ks * 32 + hh * 16);
                                    c = __builtin_amdgcn_mfma_f32_32x32x16_bf16(a, bb, c, 0, 0, 0); }
#pragma unroll
                                for (int ii = 0; ii < 16; ++ii) { const int i = 32 * it + (ii & 3) + 8 * (ii >> 2) + 4 * hh, j = 32 * jt + r32;
                                    *(LAS bf16_t*)(SCB + i * 144 + j * 2) = (bf16_t)f2bf(j <= i ? c[ii] : 0.f); } }
                            __syncthreads();
                            { const int it = wave >> 2, et = wave & 3; f32x16 c = {};
#pragma unroll
                              for (int ks = 0; ks < 4; ++ks) { const bf16x8 a = *(const LAS bf16x8*)(QS + (32 * it + r32) * 144 + ks * 32 + hh * 16), bb = *(const LAS bf16x8*)(SLT + (32 * et + r32) * 144 + ks * 32 + hh * 16);
                                  c = __builtin_amdgcn_mfma_f32_32x32x16_bf16(a, bb, c, 0, 0, 0); }
#pragma unroll
                              for (int ks = 0; ks < 4; ++ks) if (ks < 2 * (it + 1)) { const bf16x8 a = *(const LAS bf16x8*)(SCB + (32 * it + r32) * 144 + ks * 32 + hh * 16), bb = tr_frag((int)(uintptr_t)VT + att::v_rd_base(lane), att::v_rd_off(et, ks, 0));
                                  c = __builtin_amdgcn_mfma_f32_32x32x16_bf16(a, bb, c, 0, 0, 0); }
#pragma unroll
                              for (int ii = 0; ii < 16; ++ii) OUTL[(32 * it + (ii & 3) + 8 * (ii >> 2) + 4 * hh) * 132 + 32 * et + r32] = c[ii]; }
                            __syncthreads();
                            { const int i = tid >> 3, e0 = (tid & 7) * 16; float acc[16];
#pragma unroll
                              for (int j4 = 0; j4 < 4; ++j4) { const f32x4 v4 = *(const LAS f32x4*)(OUTL + i * 132 + e0 + j4 * 4); acc[j4 * 4] = v4[0]; acc[j4 * 4 + 1] = v4[1]; acc[j4 * 4 + 2] = v4[2]; acc[j4 * 4 + 3] = v4[3]; }
                              float ss = 0.f;
#pragma unroll
                              for (int j = 0; j < 16; ++j) ss += acc[j] * acc[j];
                              ss += DPP_F(ss, 0xB1); ss += DPP_F(ss, 0x4E); ss += DPP_F(ss, 0x141);
                              const float rs = __builtin_amdgcn_rsqf(ss * (1.0f / 128.0f) + RMS_EPS);
                              const size_t mrow = m0 + i; const int cb = h * 128 + e0;
                              const u32x4 g0 = g0_p, g1 = g1_p;
                              const unsigned gw_[8] = {g0.x, g0.y, g0.z, g0.w, g1.x, g1.y, g1.z, g1.w};
                              float o[16];
#pragma unroll
                              for (int j = 0; j < 16; ++j) { const float gv = bf2f((j & 1) ? (gw_[j >> 1] >> 16) : (gw_[j >> 1] & 0xffffu)); o[j] = acc[j] * rs * on_p[j >> 2][j & 3] * gv; }
                              bf16_t* dst = MIX + mrow * DM + cb;
                              *(u32x4*)dst = pack8((f32x4){o[0], o[1], o[2], o[3]}, (f32x4){o[4], o[5], o[6], o[7]});
                              *(u32x4*)(dst + 8) = pack8((f32x4){o[8], o[9], o[10], o[11]}, (f32x4){o[12], o[13], o[14], o[15]}); }
                            __syncthreads();
                        }
                    }
    }
#endif
                    GSYNC();
                } else {
#ifndef NO_PROJ1
    for (int dup_ = 0; dup_ < NDUP_PROJ1; ++dup_) { if (dup_) { GSYNC(); }
                    { PHASE_ARGS(); pg8::Gemm g{HB, (const bf16_t*)(ws + WS_ODIN), M, ODD_N, DM}; pg8::StaticOrder S; S.init(M, ODD_N, G, bx);
                      pg8::EpiP1 E{SSQ, CS, Q1, K1, V1, QIH, QIL, KIH, KIL, WI1};
                      pg8::gemm_phase<pg8::EpiP1, pg8::StaticOrder, true, true>(ldsl, g, S, E, fresh_tid()); }
    }
#endif
                    GSYNC();
#ifndef NO_IDX
    for (int dup_ = 0; dup_ < NDUP_IDX; ++dup_) { if (dup_) { GSYNC(); }
                    {
                        PHASE_IDS();
                        LAS float* SC = (LAS float*)ldsl;
                        const int r32 = lane & 31, h2 = lane >> 5;
                        const bool scorer = wave < 4; const int sw = wave & 3;
                        LAS unsigned* histw = (LAS unsigned*)(ldsl + RING_BYTES + 2048 + sw * 1024);
                        LAS unsigned long long* wroww = (LAS unsigned long long*)(ldsl + RING_BYTES + 6144 + sw * 512);
                        int up = -1;
#pragma unroll 1
                        for (int k = 0; ; ++k) {
                            const int u = (G == 256) ? ((((k & 1) | ((k >> 2) << 1)) << 9) + ((((k + 2) >> 2) & 1) << 8) + vcu) : vcu + k * G;
                            const bool have = (G == 256) ? k < 8 : u < 2048;
                            const int bp = up >> 9, urp = up & 511; const int rgp = (urp & 256) ? 511 - (urp & 255) : (urp & 255);
                            const int t0p = rgp * 8; const int nk64p = (t0p >> 6) + 1;
                            if (scorer) {
                                __syncthreads();
                                const int b = u >> 9, ur = u & 511; const int rg = (ur & 256) ? 511 - (ur & 255) : (ur & 255);
                                const int t0 = rg * 8; const size_t mb = (size_t)b * SEQ;
                                if (have && t0 >= 256) {
                                    const int nk64 = (t0 >> 6) + 1, nkb = 2 * nk64;
                                    bf16x8 ah[4], al[4];
                                    { const size_t qrow = mb + t0 + (r32 >> 2); const int hd = r32 & 3;
#pragma unroll
                                      for (int ks = 0; ks < 4; ++ks) { ah[ks] = *(const bf16x8*)(QIH + qrow * 256 + hd * 64 + ks * 16 + h2 * 8); al[ks] = *(const bf16x8*)(QIL + qrow * 256 + hd * 64 + ks * 16 + h2 * 8); } }
                                    f32x4 wv[4];
#pragma unroll
                                    for (int g = 0; g < 4; ++g) wv[g] = *(const f32x4*)(WI1 + (mb + t0 + 2 * g + h2) * 4);
                                    const bf16_t* kt = KIH + (size_t)b * 128 * 4096 + lane * 8;
                                    bf16x8 bA[8], bB[8], bC[8];
#define IDX_LOAD(dst, kb_) do { _Pragma("unroll") for (int q = 0; q < 8; ++q) dst[q] = *(const bf16x8*)(kt + (size_t)(kb_) * 4096 + q * 512); } while (0)
#define IDX_FMA(d, a, b, c) asm("v_fma_f32 %0, %1, %2, %3" : "=v"(d) : "v"(a), "v"(b), "v"(c))
#define IDX_COMP(src, kb_) do { const int key = (kb_) * 32 + r32; f32x16 acc = {}; \
                                _Pragma("unroll") for (int ks = 0; ks < 4; ++ks) { \
                                    acc = __builtin_amdgcn_mfma_f32_32x32x16_bf16(ah[ks], src[2 * ks], acc, 0, 0, 0); \
                                    acc = __builtin_amdgcn_mfma_f32_32x32x16_bf16(ah[ks], src[2 * ks + 1], acc, 0, 0, 0); \
                                    acc = __builtin_amdgcn_mfma_f32_32x32x16_bf16(al[ks], src[2 * ks], acc, 0, 0, 0); } \
                                const bool diag_ = (kb_) * 32 + 31 > t0;            \
                                _Pragma("unroll") for (int g = 0; g < 4; ++g) { \
                                      \
                                    const float e0 = acc[4 * g + 0], e1 = acc[4 * g + 1], e2 = acc[4 * g + 2], e3 = acc[4 * g + 3];       \
                                    int r0 = __float_as_int(e0), r1 = __float_as_int(e1), r2 = __float_as_int(e2), r3 = __float_as_int(e3); \
                                    r0 = r0 > 0 ? r0 : 0; r1 = r1 > 0 ? r1 : 0; r2 = r2 > 0 ? r2 : 0; r3 = r3 > 0 ? r3 : 0; \
                                    float sc, z_ = 0.0f; IDX_FMA(sc, wv[g][0], __builtin_bit_cast(float, r0), z_);               \
                                    IDX_FMA(sc, wv[g][1], __builtin_bit_cast(float, r1), sc); IDX_FMA(sc, wv[g][2], __builtin_bit_cast(float, r2), sc); IDX_FMA(sc, wv[g][3], __builtin_bit_cast(float, r3), sc); \
                                    unsigned uu = __builtin_bit_cast(unsigned, sc); uu ^= (unsigned)((int)uu >> 31) | 0x80000000u;     \
                                    const int rl = 2 * g + h2; if (diag_ && key > t0 + rl) uu = 0u;                                      \
                                    SC[rl * 4096 + key] = __builtin_bit_cast(float, uu); } } while (0)
                                    { int kb = sw;
                                      IDX_LOAD(bA, kb);
                                      { const int k1 = kb + 4 < nkb ? kb + 4 : nkb - 1; IDX_LOAD(bB, k1); }
#pragma unroll 1
                                      for (; kb < nkb; kb += 12) {
                                          { const int k2 = kb + 8 < nkb ? kb + 8 : nkb - 1; IDX_LOAD(bC, k2); }
                                          IDX_COMP(bA, kb);
                                          { const int k3 = kb + 12 < nkb ? kb + 12 : nkb - 1; IDX_LOAD(bA, k3); }
                                          if (kb + 4 < nkb) IDX_COMP(bB, kb + 4);
                                          { const int k4 = kb + 16 < nkb ? kb + 16 : nkb - 1; IDX_LOAD(bB, k4); }
                                          if (kb + 8 < nkb) IDX_COMP(bC, kb + 8);
                                      } }
#undef IDX_LOAD
#undef IDX_COMP
#undef IDX_FMA
                                }
                                __syncthreads();
                            } else {
                                const bool selp = up >= 0 && t0p >= 256;
                                unsigned key[64], key2[64];
                                { const int nkl = selp ? nk64p : 0;
#pragma unroll
                                  for (int j = 0; j < 64; ++j) {
                                    unsigned k0 = 0u, k1 = 0u;
                                    if (j < nkl) { k0 = __builtin_bit_cast(unsigned, SC[(2 * sw) * 4096 + j * 64 + lane]); k1 = __builtin_bit_cast(unsigned, SC[(2 * sw + 1) * 4096 + j * 64 + lane]); }
                                    key[j] = k0; key2[j] = k1;
                                  } }
                                __syncthreads();
                                if (up >= 0) {
                                if (t0p < 256) {
#pragma unroll 1
                                    for (int r = 0; r < 2; ++r) { const int tp = t0p + 2 * sw + r; const int j = lane; unsigned long long w;
                                        if (64 * j + 63 <= tp) w = ~0ull; else if (64 * j > tp) w = 0ull; else w = (~0ull) >> (63 - (tp - 64 * j));
                                        MASK[((size_t)bp * 64 + lane) * SEQ + tp] = w; }
                                } else {
                                unsigned Tq0 = 0u, Tq1 = 0u, neqq0 = 0u, neqq1 = 0u; int needq0 = 256, needq1 = 256, p0q0 = 0, p0q1 = 0;
                                bool dA = false, dB = false;
                                { unsigned a0 = 0u, a1 = 0u, a2 = 0u, a3 = 0u, b0 = 0u, b1 = 0u, b2 = 0u, b3 = 0u, c0 = 0u, c1 = 0u, c2 = 0u, c3 = 0u, e0 = 0u, e1 = 0u, e2 = 0u, e3 = 0u;
                                  unsigned zp = 0x80000001u, z0 = 0x80000000u; asm volatile("" : "+s"(zp), "+s"(z0));
#pragma unroll
                                  for (int grp = 0; grp < 8; ++grp) if (grp * 8 < nk64p) {
#pragma unroll
                                      for (int q4 = 0; q4 < 2; ++q4) {
                                          cnt_ge4(a0, a1, a2, a3, key[grp * 8 + q4 * 4 + 0], key[grp * 8 + q4 * 4 + 1], key[grp * 8 + q4 * 4 + 2], key[grp * 8 + q4 * 4 + 3], zp);
                                          cnt_ge4(b0, b1, b2, b3, key2[grp * 8 + q4 * 4 + 0], key2[grp * 8 + q4 * 4 + 1], key2[grp * 8 + q4 * 4 + 2], key2[grp * 8 + q4 * 4 + 3], zp);
                                          cnt_ge4(c0, c1, c2, c3, key[grp * 8 + q4 * 4 + 0], key[grp * 8 + q4 * 4 + 1], key[grp * 8 + q4 * 4 + 2], key[grp * 8 + q4 * 4 + 3], z0);
                                          cnt_ge4(e0, e1, e2, e3, key2[grp * 8 + q4 * 4 + 0], key2[grp * 8 + q4 * 4 + 1], key2[grp * 8 + q4 * 4 + 2], key2[grp * 8 + q4 * 4 + 3], z0); } }
                                  const int posA = wave_sum_u32((a0 + a1) + (a2 + a3)), posB = wave_sum_u32((b0 + b1) + (b2 + b3)), nnA = wave_sum_u32((c0 + c1) + (c2 + c3)), nnB = wave_sum_u32((e0 + e1) + (e2 + e3));
                                  if (posA < 256 && nnA >= 256) { Tq0 = 0x80000000u; needq0 = 256 - posA; neqq0 = (unsigned)(nnA - posA); p0q0 = 4; dA = true; }
                                  else if (nnA < 256) dA = true;
                                  if (posB < 256 && nnB >= 256) { Tq1 = 0x80000000u; needq1 = 256 - posB; neqq1 = (unsigned)(nnB - posB); p0q1 = 4; dB = true; }
                                  else if (nnB < 256) dB = true; }
                                if (!(dA && dB))
                                { unsigned mxA = 0u, mxB = 0u;
#pragma unroll
                                  for (int grp = 0; grp < 8; ++grp) if (grp * 8 < nk64p) {
#pragma unroll
                                      for (int jj = 0; jj < 8; ++jj) { mxA = key[grp * 8 + jj] > mxA ? key[grp * 8 + jj] : mxA; mxB = key2[grp * 8 + jj] > mxB ? key2[grp * 8 + jj] : mxB; } }
                                  unsigned tbA = wave_max_u32(mxA) >> 24, tbB = wave_max_u32(mxB) >> 24; int abA = 0, abB = 0;
#pragma unroll 1
                                  for (int step = 0; step < 4 && !(dA && dB); ++step) {
                                      const unsigned cA = tbA << 24, cB = tbB << 24; unsigned a0 = 0u, a1 = 0u, a2 = 0u, a3 = 0u, b0 = 0u, b1 = 0u, b2 = 0u, b3 = 0u;
#pragma unroll
                                      for (int grp = 0; grp < 8; ++grp) if (grp * 8 < nk64p) {
                                          cnt_ge4(a0, a1, a2, a3, key[grp * 8 + 0], key[grp * 8 + 1], key[grp * 8 + 2], key[grp * 8 + 3], cA);
                                          cnt_ge4(b0, b1, b2, b3, key2[grp * 8 + 0], key2[grp * 8 + 1], key2[grp * 8 + 2], key2[grp * 8 + 3], cB);
                                          cnt_ge4(a0, a1, a2, a3, key[grp * 8 + 4], key[grp * 8 + 5], key[grp * 8 + 6], key[grp * 8 + 7], cA);
                                          cnt_ge4(b0, b1, b2, b3, key2[grp * 8 + 4], key2[grp * 8 + 5], key2[grp * 8 + 6], key2[grp * 8 + 7], cB); }
                                      const int cntA = wave_sum_u32((a0 + a1) + (a2 + a3)), cntB = wave_sum_u32((b0 + b1) + (b2 + b3));
                                      if (!dA) { if (cntA >= 256) { Tq0 = cA; needq0 = 256 - abA; p0q0 = 1; dA = true; } else { abA = cntA; if (tbA == 0u) dA = true; else --tbA; } }
                                      if (!dB) { if (cntB >= 256) { Tq1 = cB; needq1 = 256 - abB; p0q1 = 1; dB = true; } else { abB = cntB; if (tbB == 0u) dB = true; else --tbB; } }
                                  } }
#pragma unroll 1
                                for (int r = 0; r < 2; ++r) {
                                if (r) {
#pragma unroll
                                    for (int j = 0; j < 64; ++j) key[j] = key2[j]; }
                                const int tp = t0p + 2 * sw + r;
                                unsigned T = r ? Tq1 : Tq0; int need = r ? needq1 : needq0; unsigned neq = r ? neqq1 : neqq0; const int pass0 = r ? p0q1 : p0q0;
                                { LAS unsigned* hist = histw;
#pragma unroll 1
                                  for (int pass = pass0; pass < 4; ++pass) {
                                    const int shift = 24 - 8 * pass; const unsigned pmask = pass == 0 ? 0u : (0xFFFFFFFFu << (shift + 8));
                                    { unsigned z_ = 0u; asm volatile("" : "+v"(z_)); *(LAS u32x4*)(hist + 4 * lane) = (u32x4){z_, z_, z_, z_}; }
#pragma unroll
                                    for (int grp = 0; grp < 8; ++grp) if (grp * 8 < nk64p) {
#pragma unroll
                                        for (int jj = 0; jj < 8; ++jj) { const unsigned k = key[grp * 8 + jj];
                                            if (((k ^ T) & pmask) == 0u) atomicAdd((unsigned*)(hist + ((k >> shift) & 255u)), 1u); } }
                                    const u32x4 h = *(const LAS u32x4*)(hist + 4 * lane);
                                    const unsigned sl = (h.x + h.y) + (h.z + h.w);
                                    const unsigned P_ = wave_prefix_incl_u32(sl, lane);
                                    const unsigned S = (unsigned)__builtin_amdgcn_readlane((int)P_, 63) - P_ + sl;
                                    const unsigned C = S - sl;
                                    const unsigned long long bm = __ballot(C < (unsigned)need && (unsigned)need <= S);
                                    const int L = __builtin_amdgcn_readfirstlane((int)__builtin_ctzll(bm | (1ull << 63)));
                                    const unsigned h0 = __builtin_amdgcn_readlane(h.x, L), h1 = __builtin_amdgcn_readlane(h.y, L), h2_ = __builtin_amdgcn_readlane(h.z, L), h3 = __builtin_amdgcn_readlane(h.w, L);
                                    unsigned c = __builtin_amdgcn_readlane(C, L); int D = 3;
                                    if (c + h3 < (unsigned)need) { c += h3; D = 2; if (c + h2_ < (unsigned)need) { c += h2_; D = 1; if (c + h1 < (unsigned)need) { c += h1; D = 0; } } }
                                    need -= (int)c; T |= (unsigned)(4 * L + D) << shift;
                                    neq = (D == 3) ? h3 : (D == 2) ? h2_ : (D == 1) ? h1 : h0;
                                    if (neq == (unsigned)need) break;
                                  } }
                                if (neq == (unsigned)need) {
                                    unsigned wlo = 0u, whi = 0u; unsigned Tv = T; asm volatile("" : "+v"(Tv));
                                    if (0 < nk64p) {
                                        asm volatile("v_cmp_le_u32_e32 vcc, %2, %3\n\ts_nop 1\n\tv_writelane_b32 %0, vcc_lo, 0\n\tv_writelane_b32 %1, vcc_hi, 0" : "+v"(wlo), "+v"(whi) : "v"(Tv), "v"(key[0]) : "vcc");
                                        asm volatile("v_cmp_le_u32_e32 vcc, %2, %3\n\ts_nop 1\n\tv_writelane_b32 %0, vcc_lo, 1\n\tv_writelane_b32 %1, vcc_hi, 1" : "+v"(wlo), "+v"(whi) : "v"(Tv), "v"(key[1]) : "vcc");
                                        asm volatile("v_cmp_le_u32_e32 vcc, %2, %3\n\ts_nop 1\n\tv_writelane_b32 %0, vcc_lo, 2\n\tv_writelane_b32 %1, vcc_hi, 2" : "+v"(wlo), "+v"(whi) : "v"(Tv), "v"(key[2]) : "vcc");
                                        asm volatile("v_cmp_le_u32_e32 vcc, %2, %3\n\ts_nop 1\n\tv_writelane_b32 %0, vcc_lo, 3\n\tv_writelane_b32 %1, vcc_hi, 3" : "+v"(wlo), "+v"(whi) : "v"(Tv), "v"(key[3]) : "vcc");
                                        asm volatile("v_cmp_le_u32_e32 vcc, %2, %3\n\ts_nop 1\n\tv_writelane_b32 %0, vcc_lo, 4\n\tv_writelane_b32 %1, vcc_hi, 4" : "+v"(wlo), "+v"(whi) : "v"(Tv), "v"(key[4]) : "vcc");
                                        asm volatile("v_cmp_le_u32_e32 vcc, %2, %3\n\ts_nop 1\n\tv_writelane_b32 %0, vcc_lo, 5\n\tv_writelane_b32 %1, vcc_hi, 5" : "+v"(wlo), "+v"(whi) : "v"(Tv), "v"(key[5]) : "vcc");
                                        asm volatile("v_cmp_le_u32_e32 vcc, %2, %3\n\ts_nop 1\n\tv_writelane_b32 %0, vcc_lo, 6\n\tv_writelane_b32 %1, vcc_hi, 6" : "+v"(wlo), "+v"(whi) : "v"(Tv), "v"(key[6]) : "vcc");
                                        asm volatile("v_cmp_le_u32_e32 vcc, %2, %3\n\ts_nop 1\n\tv_writelane_b32 %0, vcc_lo, 7\n\tv_writelane_b32 %1, vcc_hi, 7" : "+v"(wlo), "+v"(whi) : "v"(Tv), "v"(key[7]) : "vcc");
                                    }
                                    if (8 < nk64p) {
                                        asm volatile("v_cmp_le_u32_e32 vcc, %2, %3\n\ts_nop 1\n\tv_writelane_b32 %0, vcc_lo, 8\n\tv_writelane_b32 %1, vcc_hi, 8" : "+v"(wlo), "+v"(whi) : "v"(Tv), "v"(key[8]) : "vcc");
                                        asm volatile("v_cmp_le_u32_e32 vcc, %2, %3\n\ts_nop 1\n\tv_writelane_b32 %0, vcc_lo, 9\n\tv_writelane_b32 %1, vcc_hi, 9" : "+v"(wlo), "+v"(whi) : "v"(Tv), "v"(key[9]) : "vcc");
                                        asm volatile("v_cmp_le_u32_e32 vcc, %2, %3\n\ts_nop 1\n\tv_writelane_b32 %0, vcc_lo, 10\n\tv_writelane_b32 %1, vcc_hi, 10" : "+v"(wlo), "+v"(whi) : "v"(Tv), "v"(key[10]) : "vcc");
                                        asm volatile("v_cmp_le_u32_e32 vcc, %2, %3\n\ts_nop 1\n\tv_writelane_b32 %0, vcc_lo, 11\n\tv_writelane_b32 %1, vcc_hi, 11" : "+v"(wlo), "+v"(whi) : "v"(Tv), "v"(key[11]) : "vcc");
                                        asm volatile("v_cmp_le_u32_e32 vcc, %2, %3\n\ts_nop 1\n\tv_writelane_b32 %0, vcc_lo, 12\n\tv_writelane_b32 %1, vcc_hi, 12" : "+v"(wlo), "+v"(whi) : "v"(Tv), "v"(key[12]) : "vcc");
                                        asm volatile("v_cmp_le_u32_e32 vcc, %2, %3\n\ts_nop 1\n\tv_writelane_b32 %0, vcc_lo, 13\n\tv_writelane_b32 %1, vcc_hi, 13" : "+v"(wlo), "+v"(whi) : "v"(Tv), "v"(key[13]) : "vcc");
                                        asm volatile("v_cmp_le_u32_e32 vcc, %2, %3\n\ts_nop 1\n\tv_writelane_b32 %0, vcc_lo, 14\n\tv_writelane_b32 %1, vcc_hi, 14" : "+v"(wlo), "+v"(whi) : "v"(Tv), "v"(key[14]) : "vcc");
                                        asm volatile("v_cmp_le_u32_e32 vcc, %2, %3\n\ts_nop 1\n\tv_writelane_b32 %0, vcc_lo, 15\n\tv_writelane_b32 %1, vcc_hi, 15" : "+v"(wlo), "+v"(whi) : "v"(Tv), "v"(key[15]) : "vcc");
                                    }
                                    if (16 < nk64p) {
                                        asm volatile("v_cmp_le_u32_e32 vcc, %2, %3\n\ts_nop 1\n\tv_writelane_b32 %0, vcc_lo, 16\n\tv_writelane_b32 %1, vcc_hi, 16" : "+v"(wlo), "+v"(whi) : "v"(Tv), "v"(key[16]) : "vcc");
                                        asm volatile("v_cmp_le_u32_e32 vcc, %2, %3\n\ts_nop 1\n\tv_writelane_b32 %0, vcc_lo, 17\n\tv_writelane_b32 %1, vcc_hi, 17" : "+v"(wlo), "+v"(whi) : "v"(Tv), "v"(key[17]) : "vcc");
                                        asm volatile("v_cmp_le_u32_e32 vcc, %2, %3\n\ts_nop 1\n\tv_writelane_b32 %0, vcc_lo, 18\n\tv_writelane_b32 %1, vcc_hi, 18" : "+v"(wlo), "+v"(whi) : "v"(Tv), "v"(key[18]) : "vcc");
                                        asm volatile("v_cmp_le_u32_e32 vcc, %2, %3\n\ts_nop 1\n\tv_writelane_b32 %0, vcc_lo, 19\n\tv_writelane_b32 %1, vcc_hi, 19" : "+v"(wlo), "+v"(whi) : "v"(Tv), "v"(key[19]) : "vcc");
                                        asm volatile("v_cmp_le_u32_e32 vcc, %2, %3\n\ts_nop 1\n\tv_writelane_b32 %0, vcc_lo, 20\n\tv_writelane_b32 %1, vcc_hi, 20" : "+v"(wlo), "+v"(whi) : "v"(Tv), "v"(key[20]) : "vcc");
                                        asm volatile("v_cmp_le_u32_e32 vcc, %2, %3\n\ts_nop 1\n\tv_writelane_b32 %0, vcc_lo, 21\n\tv_writelane_b32 %1, vcc_hi, 21" : "+v"(wlo), "+v"(whi) : "v"(Tv), "v"(key[21]) : "vcc");
                                        asm volatile("v_cmp_le_u32_e32 vcc, %2, %3\n\ts_nop 1\n\tv_writelane_b32 %0, vcc_lo, 22\n\tv_writelane_b32 %1, vcc_hi, 22" : "+v"(wlo), "+v"(whi) : "v"(Tv), "v"(key[22]) : "vcc");
                                        asm volatile("v_cmp_le_u32_e32 vcc, %2, %3\n\ts_nop 1\n\tv_writelane_b32 %0, vcc_lo, 23\n\tv_writelane_b32 %1, vcc_hi, 23" : "+v"(wlo), "+v"(whi) : "v"(Tv), "v"(key[23]) : "vcc");
                                    }
                                    if (24 < nk64p) {
                                        asm volatile("v_cmp_le_u32_e32 vcc, %2, %3\n\ts_nop 1\n\tv_writelane_b32 %0, vcc_lo, 24\n\tv_writelane_b32 %1, vcc_hi, 24" : "+v"(wlo), "+v"(whi) : "v"(Tv), "v"(key[24]) : "vcc");
                                        asm volatile("v_cmp_le_u32_e32 vcc, %2, %3\n\ts_nop 1\n\tv_writelane_b32 %0, vcc_lo, 25\n\tv_writelane_b32 %1, vcc_hi, 25" : "+v"(wlo), "+v"(whi) : "v"(Tv), "v"(key[25]) : "vcc");
                                        asm volatile("v_cmp_le_u32_e32 vcc, %2, %3\n\ts_nop 1\n\tv_writelane_b32 %0, vcc_lo, 26\n\tv_writelane_b32 %1, vcc_hi, 26" : "+v"(wlo), "+v"(whi) : "v"(Tv), "v"(key[26]) : "vcc");
                                        asm volatile("v_cmp_le_u32_e32 vcc, %2, %3\n\ts_nop 1\n\tv_writelane_b32 %0, vcc_lo, 27\n\tv_writelane_b32 %1, vcc_hi, 27" : "+v"(wlo), "+v"(whi) : "v"(Tv), "v"(key[27]) : "vcc");
                                        asm volatile("v_cmp_le_u32_e32 vcc, %2, %3\n\ts_nop 1\n\tv_writelane_b32 %0, vcc_lo, 28\n\tv_writelane_b32 %1, vcc_hi, 28" : "+v"(wlo), "+v"(whi) : "v"(Tv), "v"(key[28]) : "vcc");
                                        asm volatile("v_cmp_le_u32_e32 vcc, %2, %3\n\ts_nop 1\n\tv_writelane_b32 %0, vcc_lo, 29\n\tv_writelane_b32 %1, vcc_hi, 29" : "+v"(wlo), "+v"(whi) : "v"(Tv), "v"(key[29]) : "vcc");
                                        asm volatile("v_cmp_le_u32_e32 vcc, %2, %3\n\ts_nop 1\n\tv_writelane_b32 %0, vcc_lo, 30\n\tv_writelane_b32 %1, vcc_hi, 30" : "+v"(wlo), "+v"(whi) : "v"(Tv), "v"(key[30]) : "vcc");
                                        asm volatile("v_cmp_le_u32_e32 vcc, %2, %3\n\ts_nop 1\n\tv_writelane_b32 %0, vcc_lo, 31\n\tv_writelane_b32 %1, vcc_hi, 31" : "+v"(wlo), "+v"(whi) : "v"(Tv), "v"(key[31]) : "vcc");
                                    }
                                    if (32 < nk64p) {
                                        asm volatile("v_cmp_le_u32_e32 vcc, %2, %3\n\ts_nop 1\n\tv_writelane_b32 %0, vcc_lo, 32\n\tv_writelane_b32 %1, vcc_hi, 32" : "+v"(wlo), "+v"(whi) : "v"(Tv), "v"(key[32]) : "vcc");
                                        asm volatile("v_cmp_le_u32_e32 vcc, %2, %3\n\ts_nop 1\n\tv_writelane_b32 %0, vcc_lo, 33\n\tv_writelane_b32 %1, vcc_hi, 33" : "+v"(wlo), "+v"(whi) : "v"(Tv), "v"(key[33]) : "vcc");
                                        asm volatile("v_cmp_le_u32_e32 vcc, %2, %3\n\ts_nop 1\n\tv_writelane_b32 %0, vcc_lo, 34\n\tv_writelane_b32 %1, vcc_hi, 34" : "+v"(wlo), "+v"(whi) : "v"(Tv), "v"(key[34]) : "vcc");
                                        asm volatile("v_cmp_le_u32_e32 vcc, %2, %3\n\ts_nop 1\n\tv_writelane_b32 %0, vcc_lo, 35\n\tv_writelane_b32 %1, vcc_hi, 35" : "+v"(wlo), "+v"(whi) : "v"(Tv), "v"(key[35]) : "vcc");
                                        asm volatile("v_cmp_le_u32_e32 vcc, %2, %3\n\ts_nop 1\n\tv_writelane_b32 %0, vcc_lo, 36\n\tv_writelane_b32 %1, vcc_hi, 36" : "+v"(wlo), "+v"(whi) : "v"(Tv), "v"(key[36]) : "vcc");
                                        asm volatile("v_cmp_le_u32_e32 vcc, %2, %3\n\ts_nop 1\n\tv_writelane_b32 %0, vcc_lo, 37\n\tv_writelane_b32 %1, vcc_hi, 37" : "+v"(wlo), "+v"(whi) : "v"(Tv), "v"(key[37]) : "vcc");
                                        asm volatile("v_cmp_le_u32_e32 vcc, %2, %3\n\ts_nop 1\n\tv_writelane_b32 %0, vcc_lo, 38\n\tv_writelane_b32 %1, vcc_hi, 38" : "+v"(wlo), "+v"(whi) : "v"(Tv), "v"(key[38]) : "vcc");
                                        asm volatile("v_cmp_le_u32_e32 vcc, %2, %3\n\ts_nop 1\n\tv_writelane_b32 %0, vcc_lo, 39\n\tv_writelane_b32 %1, vcc_hi, 39" : "+v"(wlo), "+v"(whi) : "v"(Tv), "v"(key[39]) : "vcc");
                                    }
                                    if (40 < nk64p) {
                                        asm volatile("v_cmp_le_u32_e32 vcc, %2, %3\n\ts_nop 1\n\tv_writelane_b32 %0, vcc_lo, 40\n\tv_writelane_b32 %1, vcc_hi, 40" : "+v"(wlo), "+v"(whi) : "v"(Tv), "v"(key[40]) : "vcc");
                                        asm volatile("v_cmp_le_u32_e32 vcc, %2, %3\n\ts_nop 1\n\tv_writelane_b32 %0, vcc_lo, 41\n\tv_writelane_b32 %1, vcc_hi, 41" : "+v"(wlo), "+v"(whi) : "v"(Tv), "v"(key[41]) : "vcc");
                                        asm volatile("v_cmp_le_u32_e32 vcc, %2, %3\n\ts_nop 1\n\tv_writelane_b32 %0, vcc_lo, 42\n\tv_writelane_b32 %1, vcc_hi, 42" : "+v"(wlo), "+v"(whi) : "v"(Tv), "v"(key[42]) : "vcc");
                                        asm volatile("v_cmp_le_u32_e32 vcc, %2, %3\n\ts_nop 1\n\tv_writelane_b32 %0, vcc_lo, 43\n\tv_writelane_b32 %1, vcc_hi, 43" : "+v"(wlo), "+v"(whi) : "v"(Tv), "v"(key[43]) : "vcc");
                                        asm volatile("v_cmp_le_u32_e32 vcc, %2, %3\n\ts_nop 1\n\tv_writelane_b32 %0, vcc_lo, 44\n\tv_writelane_b32 %1, vcc_hi, 44" : "+v"(wlo), "+v"(whi) : "v"(Tv), "v"(key[44]) : "vcc");
                                        asm volatile("v_cmp_le_u32_e32 vcc, %2, %3\n\ts_nop 1\n\tv_writelane_b32 %0, vcc_lo, 45\n\tv_writelane_b32 %1, vcc_hi, 45" : "+v"(wlo), "+v"(whi) : "v"(Tv), "v"(key[45]) : "vcc");
                                        asm volatile("v_cmp_le_u32_e32 vcc, %2, %3\n\ts_nop 1\n\tv_writelane_b32 %0, vcc_lo, 46\n\tv_writelane_b32 %1, vcc_hi, 46" : "+v"(wlo), "+v"(whi) : "v"(Tv), "v"(key[46]) : "vcc");
                                        asm volatile("v_cmp_le_u32_e32 vcc, %2, %3\n\ts_nop 1\n\tv_writelane_b32 %0, vcc_lo, 47\n\tv_writelane_b32 %1, vcc_hi, 47" : "+v"(wlo), "+v"(whi) : "v"(Tv), "v"(key[47]) : "vcc");
                                    }
                                    if (48 < nk64p) {
                                        asm volatile("v_cmp_le_u32_e32 vcc, %2, %3\n\ts_nop 1\n\tv_writelane_b32 %0, vcc_lo, 48\n\tv_writelane_b32 %1, vcc_hi, 48" : "+v"(wlo), "+v"(whi) : "v"(Tv), "v"(key[48]) : "vcc");
                                        asm volatile("v_cmp_le_u32_e32 vcc, %2, %3\n\ts_nop 1\n\tv_writelane_b32 %0, vcc_lo, 49\n\tv_writelane_b32 %1, vcc_hi, 49" : "+v"(wlo), "+v"(whi) : "v"(Tv), "v"(key[49]) : "vcc");
                                        asm volatile("v_cmp_le_u32_e32 vcc, %2, %3\n\ts_nop 1\n\tv_writelane_b32 %0, vcc_lo, 50\n\tv_writelane_b32 %1, vcc_hi, 50" : "+v"(wlo), "+v"(whi) : "v"(Tv), "v"(key[50]) : "vcc");
                                        asm volatile("v_cmp_le_u32_e32 vcc, %2, %3\n\ts_nop 1\n\tv_writelane_b32 %0, vcc_lo, 51\n\tv_writelane_b32 %1, vcc_hi, 51" : "+v"(wlo), "+v"(whi) : "v"(Tv), "v"(key[51]) : "vcc");
                                        asm volatile("v_cmp_le_u32_e32 vcc, %2, %3\n\ts_nop 1\n\tv_writelane_b32 %0, vcc_lo, 52\n\tv_writelane_b32 %1, vcc_hi, 52" : "+v"(wlo), "+v"(whi) : "v"(Tv), "v"(key[52]) : "vcc");
                                        asm volatile("v_cmp_le_u32_e32 vcc, %2, %3\n\ts_nop 1\n\tv_writelane_b32 %0, vcc_lo, 53\n\tv_writelane_b32 %1, vcc_hi, 53" : "+v"(wlo), "+v"(whi) : "v"(Tv), "v"(key[53]) : "vcc");
                                        asm volatile("v_cmp_le_u32_e32 vcc, %2, %3\n\ts_nop 1\n\tv_writelane_b32 %0, vcc_lo, 54\n\tv_writelane_b32 %1, vcc_hi, 54" : "+v"(wlo), "+v"(whi) : "v"(Tv), "v"(key[54]) : "vcc");
                                        asm volatile("v_cmp_le_u32_e32 vcc, %2, %3\n\ts_nop 1\n\tv_writelane_b32 %0, vcc_lo, 55\n\tv_writelane_b32 %1, vcc_hi, 55" : "+v"(wlo), "+v"(whi) : "v"(Tv), "v"(key[55]) : "vcc");
                                    }
                                    if (56 < nk64p) {
                                        asm volatile("v_cmp_le_u32_e32 vcc, %2, %3\n\ts_nop 1\n\tv_writelane_b32 %0, vcc_lo, 56\n\tv_writelane_b32 %1, vcc_hi, 56" : "+v"(wlo), "+v"(whi) : "v"(Tv), "v"(key[56]) : "vcc");
                                        asm volatile("v_cmp_le_u32_e32 vcc, %2, %3\n\ts_nop 1\n\tv_writelane_b32 %0, vcc_lo, 57\n\tv_writelane_b32 %1, vcc_hi, 57" : "+v"(wlo), "+v"(whi) : "v"(Tv), "v"(key[57]) : "vcc");
                                        asm volatile("v_cmp_le_u32_e32 vcc, %2, %3\n\ts_nop 1\n\tv_writelane_b32 %0, vcc_lo, 58\n\tv_writelane_b32 %1, vcc_hi, 58" : "+v"(wlo), "+v"(whi) : "v"(Tv), "v"(key[58]) : "vcc");
                                        asm volatile("v_cmp_le_u32_e32 vcc, %2, %3\n\ts_nop 1\n\tv_writelane_b32 %0, vcc_lo, 59\n\tv_writelane_b32 %1, vcc_hi, 59" : "+v"(wlo), "+v"(whi) : "v"(Tv), "v"(key[59]) : "vcc");
                                        asm volatile("v_cmp_le_u32_e32 vcc, %2, %3\n\ts_nop 1\n\tv_writelane_b32 %0, vcc_lo, 60\n\tv_writelane_b32 %1, vcc_hi, 60" : "+v"(wlo), "+v"(whi) : "v"(Tv), "v"(key[60]) : "vcc");
                                        asm volatile("v_cmp_le_u32_e32 vcc, %2, %3\n\ts_nop 1\n\tv_writelane_b32 %0, vcc_lo, 61\n\tv_writelane_b32 %1, vcc_hi, 61" : "+v"(wlo), "+v"(whi) : "v"(Tv), "v"(key[61]) : "vcc");
                                        asm volatile("v_cmp_le_u32_e32 vcc, %2, %3\n\ts_nop 1\n\tv_writelane_b32 %0, vcc_lo, 62\n\tv_writelane_b32 %1, vcc_hi, 62" : "+v"(wlo), "+v"(whi) : "v"(Tv), "v"(key[62]) : "vcc");
                                        asm volatile("v_cmp_le_u32_e32 vcc, %2, %3\n\ts_nop 1\n\tv_writelane_b32 %0, vcc_lo, 63\n\tv_writelane_b32 %1, vcc_hi, 63" : "+v"(wlo), "+v"(whi) : "v"(Tv), "v"(key[63]) : "vcc");
                                    }
                                    MASK[((size_t)bp * 64 + lane) * SEQ + tp] = ((unsigned long long)whi << 32) | wlo;
                                } else {
                                int base = 0;
                                LAS unsigned long long* wrow = wroww;
#pragma unroll
                                for (int grp = 0; grp < 8; ++grp) if (grp * 8 < nk64p) {
#pragma unroll
                                    for (int jj = 0; jj < 8; ++jj) { const int j = grp * 8 + jj;
                                        const bool eq = key[j] == T; const unsigned long long eqm = __ballot(eq);
                                        const int rank = base + (int)__builtin_amdgcn_mbcnt_hi((unsigned)(eqm >> 32), __builtin_amdgcn_mbcnt_lo((unsigned)eqm, 0u));
                                        const bool sel = (key[j] > T) || (eq && rank < need);
                                        const unsigned long long wj = __ballot(sel);
                                        if (lane == 0) wrow[j] = wj;
                                        base += __popcll(eqm); } }
                                { const unsigned long long wv_ = wrow[lane]; const unsigned lo_ = (lane < nk64p) ? (unsigned)wv_ : 0u, hi_ = (lane < nk64p) ? (unsigned)(wv_ >> 32) : 0u;
                                  MASK[((size_t)bp * 64 + lane) * SEQ + tp] = ((unsigned long long)hi_ << 32) | lo_; }
                                }

                                }
                                }
                                }
                                __syncthreads();
                            }
                            if (!have) break;
                            up = u;
                        }
                    }
    }
#endif
                    GSYNC();
#ifndef NO_ATT
    for (int dup_ = 0; dup_ < NDUP_ATT; ++dup_) { if (dup_) { GSYNC(); }
                    {
                        PHASE_ARGS();
                        att::Seam S;
                        auto mkref = [&](int L, int pass) {
                            const int x8 = L & 7, kk = L >> 3, b = x8 >> 1, kvh = x8 & 1, head = kvh * 4 + (kk >> 3), x = kk & 7;
                            const int qb = pass ? 15 - x : x;
                            att::BlockRef r;
                            r.Q = Q1 + ((size_t)(b * 8 + head) * SEQ + qb * 256) * 128; r.K = K1 + (size_t)(b * 2 + kvh) * SEQ * 128;
                            r.O = MIX + ((size_t)b * SEQ + qb * 256) * DM + head * 128; r.MW = MASK + (size_t)b * 64 * SEQ + qb * 256; r.P0 = qb * 256;
                            return r; };
                        int L = bx;
                        if (L < 256) {
                            int pass = 0; att::BlockRef cur = mkref(L, 0);
                            const int atid = fresh_tid();
                            att::attn_prime(cur, (char*)lds, S, atid);
                            for (;;) {
                                const bool more_pass = pass == 0, more_item = L + G < 256, last = !more_pass && !more_item;
                                int passn = pass + 1, Ln = L;
                                if (!more_pass) { passn = 0; Ln = more_item ? L + G : L; }
                                const att::BlockRef nxt = last ? cur : mkref(Ln, passn);
                                att::attn_block(cur, nxt, (char*)lds, S, atid);
                                if (last) break;
                                cur = nxt; pass = passn; L = Ln;
                            }
                        }
                    }
    }
#endif
                    GSYNC();
                }
#ifndef NO_OUTP
    for (int dup_ = 0; dup_ < NDUP_OUTP; ++dup_) { if (dup_) { GSYNC(); }
                { PHASE_ARGS(); pg8::Gemm g{MIX, (const bf16_t*)(ws + (li == 0 ? WS_EVOUT : WS_ODOUT)), M, DM, DM}; pg8::StaticOrder S; S.init(M, DM, G, bx);
                  pg8::EpiRes E{HB, SSQ, dup_ ? 0.0f : 1.0f};
                  pg8::gemm_phase<pg8::EpiRes, pg8::StaticOrder, true, true>(ldsl, g, S, E, fresh_tid()); }
    }
#endif
                GSYNC();
            }
#ifndef NO_UP
    for (int dup_ = 0; dup_ < NDUP_UP; ++dup_) { if (dup_) { GSYNC(); }
            { PHASE_ARGS(); pg8::Gemm g{HB, (const bf16_t*)(ws + WS_WIT + (size_t)(li * 2 + f) * 11 * MiB), M, NFF, DM}; pg8::StaticOrder S; S.init(M, NFF, G, bx);
              pg8::EpiUp E{SSQ, HID};
              pg8::gemm_phase<pg8::EpiUp, pg8::StaticOrder, true, true>(ldsl, g, S, E, fresh_tid()); }
            if (bx >= (M / 256) * (NFF / 256) % 256 && G == 256) { PHASE_IDS(); const int widx = (bx - 128) * 8 + wave, nw = 128 * 8; LAS unsigned char* scr = ldsl + wave * 16384;
                if (li == 0 && f == 0) { conv_range(A, ws, CV_WO(0), CV_WO(1), widx, nw, scr, lane);
                              conv_range(A, ws, CV_EV, CV_OD, widx, nw, scr, lane); conv_range(A, ws, CV_EO, CV_OO, widx, nw, scr, lane); conv_extras_even(A, ws, widx, nw, lane); }
                else if (li == 0) { conv_range(A, ws, CV_WI(2), CV_WI(3), widx, nw, scr, lane); conv_range(A, ws, CV_WO(2), CV_WO(3), widx, nw, scr, lane); }
                else if (f == 0) { conv_range(A, ws, CV_OD, CV_EO, widx, nw, scr, lane); conv_range(A, ws, CV_OO, CV_END, widx, nw, scr, lane); conv_zero_pad_odd(ws, widx, nw, lane);
                              conv_range(A, ws, CV_WI(3), CV_WI(4), widx, nw, scr, lane); }
                else conv_range(A, ws, CV_WO(3), CV_WO(4), widx, nw, scr, lane); }
    }
#endif
            GSYNC();
#ifndef NO_DOWN
    for (int dup_ = 0; dup_ < NDUP_DOWN; ++dup_) { if (dup_) { GSYNC(); }
            { PHASE_ARGS(); pg8::Gemm g{HID, (const bf16_t*)(ws + WS_WOT + (size_t)(li * 2 + f) * 5632 * 1024), M, DM, DFF}; pg8::StaticOrder S; S.init(M, DM, G, bx);
              pg8::EpiRes E{HB, SSQ, dup_ ? 0.0f : 0.5f};
              pg8::gemm_phase<pg8::EpiRes, pg8::StaticOrder, true, true>(ldsl, g, S, E, fresh_tid()); }
    }
#endif
            GSYNC();
        }
    }
    { PHASE_IDS();
    const f32x4* gn = (const f32x4*)A.final_norm + lane * 2;
    const f32x4 g0 = gn[0], g1 = gn[1], g2 = gn[128], g3 = gn[129];
    auto fin_load = [&](int m0, u32x4 (&v)[4][2], f32x4 (&sq)[4][4]) {
#pragma unroll
        for (int i = 0; i < 4; ++i) { const u32x4* xr = (const u32x4*)(HB + (size_t)(m0 + i) * DM) + lane; v[i][0] = xr[0]; v[i][1] = xr[64];
            const f32x4* sp = (const f32x4*)(SSQ + (size_t)(m0 + i) * 16); sq[i][0] = sp[0]; sq[i][1] = sp[1]; sq[i][2] = sp[2]; sq[i][3] = sp[3]; } };
    u32x4 vc[4][2]; f32x4 sc_[4][4];
    int m0 = gw * 4;
    if (m0 < M) fin_load(m0, vc, sc_);
    for (; m0 < M; m0 += NGW * 4) {
        u32x4 vn[4][2]; f32x4 sn[4][4]; const int m1 = m0 + NGW * 4;
        if (m1 < M) fin_load(m1, vn, sn);
        else {
#pragma unroll
            for (int i = 0; i < 4; ++i) { vn[i][0] = vc[i][0]; vn[i][1] = vc[i][1]; sn[i][0] = sc_[i][0]; sn[i][1] = sc_[i][1]; sn[i][2] = sc_[i][2]; sn[i][3] = sc_[i][3]; } }
#pragma unroll
        for (int i = 0; i < 4; ++i) {
            const f32x4 a = sc_[i][0], b = sc_[i][1], c = sc_[i][2], d = sc_[i][3];
            const float ssum = ((a[0] + a[1]) + (a[2] + a[3])) + ((b[0] + b[1]) + (b[2] + b[3])) + ((c[0] + c[1]) + (c[2] + c[3])) + ((d[0] + d[1]) + (d[2] + d[3]));
            const float rs = __builtin_amdgcn_rsqf(ssum * (1.0f / 1024.0f) + RMS_EPS);
            f32x4* xr = (f32x4*)(A.out + (size_t)(m0 + i) * DM) + lane * 2; f32x4 a0, a1, a2, a3; unpack8(vc[i][0], a0, a1); unpack8(vc[i][1], a2, a3);
            xr[0] = a0 * rs * g0; xr[1] = a1 * rs * g1; xr[128] = a2 * rs * g2; xr[129] = a3 * rs * g3; }
#pragma unroll
        for (int i = 0; i < 4; ++i) { vc[i][0] = vn[i][0]; vc[i][1] = vn[i][1]; sc_[i][0] = sn[i][0]; sc_[i][1] = sn[i][1]; sc_[i][2] = sn[i][2]; sc_[i][3] = sn[i][3]; }
    } }
#undef GSYNC
}

extern "C" void kernel_launch(void* const* d_in, const int* in_sizes, int n_in, void* d_out, int out_size, void* d_ws, size_t ws_size, hipStream_t stream) {
    static int grid = 0;
    if (grid == 0) {
        if (n_in != 19 || in_sizes[0] != M * DM || out_size != M * DM || ws_size < WS_END) { fprintf(stderr, "kernel_launch: unexpected shapes n_in %d in0 %d out %d ws %zu\n", n_in, n_in > 0 ? in_sizes[0] : -1, out_size, ws_size); grid = -1; return; }
        int dev = 0, cus = 0, per_cu = 0;
        if (hipGetDevice(&dev) != hipSuccess || hipDeviceGetAttribute(&cus, hipDeviceAttributeMultiprocessorCount, dev) != hipSuccess) { grid = -1; return; }
        if (hipFuncSetAttribute((const void*)fwd_megakernel, hipFuncAttributeMaxDynamicSharedMemorySize, LDS_BYTES) != hipSuccess) { fprintf(stderr, "kernel_launch: hipFuncSetAttribute failed\n"); grid = -1; return; }
        if (hipOccupancyMaxActiveBlocksPerMultiprocessor(&per_cu, (const void*)fwd_megakernel, 512, LDS_BYTES) != hipSuccess || per_cu < 1) { fprintf(stderr, "kernel_launch: occupancy query gave %d\n", per_cu); (void)hipGetLastError(); grid = -1; return; }
        grid = cus;
    }
    if (grid < 0) return;
    (void)hipMemsetAsync((char*)d_ws + WS_CTL + 16384, 0, 16384, stream);
    KArgs a{};
    a.x = (const float*)d_in[0]; a.pos = (const int*)d_in[1]; a.ffn1_norm = (const float*)d_in[2]; a.ffn1_wi = (const float*)d_in[3]; a.ffn1_wo = (const float*)d_in[4];
    a.mix_norm = (const float*)d_in[5]; a.ffn2_norm = (const float*)d_in[6]; a.ffn2_wi = (const float*)d_in[7]; a.ffn2_wo = (const float*)d_in[8];
    a.even_w_in = (const float*)d_in[9]; a.gate_w = (const float*)d_in[10]; a.gate_b = (const float*)d_in[11]; a.out_norm = (const float*)d_in[12];
    a.pool_w = (const float*)d_in[13]; a.pool_scale = (const float*)d_in[14]; a.even_w_out = (const float*)d_in[15]; a.odd_w_in = (const float*)d_in[16];
    a.odd_w_out = (const float*)d_in[17]; a.final_norm = (const float*)d_in[18];
    a.out = (float*)d_out; a.ws = (unsigned char*)d_ws;
    void* args[] = {&a};
    hipError_t e = hipLaunchCooperativeKernel((const void*)fwd_megakernel, dim3(grid), dim3(512), args, LDS_BYTES, stream);
    if (e != hipSuccess) fprintf(stderr, "cooperative launch failed: %s (grid %d)\n", hipGetErrorString(e), grid);
}
```

```cpp
#include <hip/hip_runtime.h>
#include <hip/hip_cooperative_groups.h>
#include <cstdio>
#include <cstdint>
namespace cg = cooperative_groups;

#ifndef NDUP_P0
#define NDUP_P0 1
#endif
#ifndef NDUP_PROJ0
#define NDUP_PROJ0 1
#endif
#ifndef NDUP_G1
#define NDUP_G1 1
#endif
#ifndef NDUP_G3
#define NDUP_G3 1
#endif
#ifndef NDUP_PROJ1
#define NDUP_PROJ1 1
#endif
#ifndef NDUP_IDX
#define NDUP_IDX 1
#endif
#ifndef NDUP_ATT
#define NDUP_ATT 1
#endif
#ifndef NDUP_UP
#define NDUP_UP 1
#endif
#ifndef NDUP_DOWN
#define NDUP_DOWN 1
#endif
#ifndef NDUP_OUTP
#define NDUP_OUTP 1
#endif
constexpr int BATCH = 4, SEQ = 4096, DM = 1024, M = BATCH * SEQ, DFF = 2816, NFF = 2 * DFF;
constexpr int EVEN_IN = 2064, EVEN_N = 2304, ODD_IN = 1860, ODD_N = 2048;
constexpr float RMS_EPS = 1e-6f;
constexpr float QSCALE = 0.08838834764831845f * 1.4426950408889634f;

#define LAS __attribute__((address_space(3)))
typedef unsigned short bf16_t;
typedef short bf16x8 __attribute__((ext_vector_type(8)));
typedef short s16x4 __attribute__((ext_vector_type(4)));
typedef float f32x4 __attribute__((ext_vector_type(4)));
typedef float f32x2 __attribute__((ext_vector_type(2)));
typedef float f32x16 __attribute__((ext_vector_type(16)));
typedef unsigned u32x4 __attribute__((ext_vector_type(4)));
typedef unsigned u32x2 __attribute__((ext_vector_type(2)));

typedef __bf16 bf16x2_t __attribute__((ext_vector_type(2)));
__device__ __forceinline__ unsigned cvt_pk_bf16(float lo, float hi) { f32x2 v = {lo, hi}; bf16x2_t b = __builtin_convertvector(v, bf16x2_t); return __builtin_bit_cast(unsigned, b); }
__device__ __forceinline__ unsigned f2bf(float f) { unsigned u = __builtin_bit_cast(unsigned, f); return (u + 0x7fffu + ((u >> 16) & 1u)) >> 16; }
__device__ __forceinline__ float bf2f(unsigned h) { return __builtin_bit_cast(float, h << 16); }
__device__ __forceinline__ float rows_sum(float x) {
    { auto r = __builtin_amdgcn_permlane16_swap(__float_as_uint(x), __float_as_uint(x), false, false); x = __uint_as_float(r[0]) + __uint_as_float(r[1]); }
    { auto r = __builtin_amdgcn_permlane32_swap(__float_as_uint(x), __float_as_uint(x), false, false); x = __uint_as_float(r[0]) + __uint_as_float(r[1]); }
    return x; }
#define DPP_F(v, ctrl) __builtin_bit_cast(float, __builtin_amdgcn_update_dpp(0, __builtin_bit_cast(int, (float)(v)), (ctrl), 0xf, 0xf, true))
__device__ __forceinline__ void unpack8(const u32x4 w, f32x4& a, f32x4& b) {
    a[0] = __uint_as_float(w[0] << 16); a[1] = __uint_as_float(w[0] & 0xffff0000u); a[2] = __uint_as_float(w[1] << 16); a[3] = __uint_as_float(w[1] & 0xffff0000u);
    b[0] = __uint_as_float(w[2] << 16); b[1] = __uint_as_float(w[2] & 0xffff0000u); b[2] = __uint_as_float(w[3] << 16); b[3] = __uint_as_float(w[3] & 0xffff0000u); }
__device__ __forceinline__ u32x4 pack8(f32x4 a, f32x4 b) { u32x4 w; w.x = cvt_pk_bf16(a[0], a[1]); w.y = cvt_pk_bf16(a[2], a[3]); w.z = cvt_pk_bf16(b[0], b[1]); w.w = cvt_pk_bf16(b[2], b[3]); return w; }

constexpr size_t MiB = 1u << 20;
constexpr size_t WS_CTL = 0;
constexpr size_t WS_SSQ = 1 * MiB;
constexpr size_t WS_DVEC = 2 * MiB;
constexpr size_t WS_WI1 = 2 * MiB + 256 * 1024;
constexpr size_t WS_W = 3 * MiB;
constexpr size_t WS_WIT = WS_W;
constexpr size_t WS_WOT = WS_W + 44 * MiB;
constexpr size_t WS_EVIN = WS_W + 66 * MiB;
constexpr size_t WS_ODIN = WS_EVIN + 4608 * 1024;
constexpr size_t WS_EVOUT = WS_ODIN + 4 * MiB;
constexpr size_t WS_ODOUT = WS_EVOUT + 2 * MiB;
constexpr size_t WS_CS = 82 * MiB;
constexpr size_t WS_HB = 94 * MiB;
constexpr size_t WS_R = 126 * MiB;
constexpr size_t WS_HID = WS_R;
constexpr size_t WS_QK0 = WS_R, WS_V0 = WS_R + 16 * MiB, WS_G0 = WS_R + 32 * MiB, WS_U0 = WS_R + 48 * MiB, WS_LA = WS_R + 64 * MiB, WS_ST0 = WS_R + 80 * MiB;
constexpr size_t WS_MIX = WS_R + 96 * MiB;
constexpr size_t WS_Q1 = WS_R, WS_K1 = WS_R + 32 * MiB, WS_V1 = WS_R + 40 * MiB, WS_QIH = WS_R + 48 * MiB, WS_QIL = WS_R + 56 * MiB, WS_KIH = WS_R + 64 * MiB, WS_KIL = WS_R + 66 * MiB, WS_MASK = WS_R + 68 * MiB;
constexpr size_t WS_END = 256 * MiB;
static_assert(WS_V1 - WS_K1 == 8 * MiB, "att::VOFF");
static_assert(WS_MIX + 32 * MiB <= WS_END && WS_ODOUT + 2 * MiB <= WS_CS && WS_CS + 8 * MiB <= WS_HB + 4 * MiB && WS_HB + 32 * MiB <= WS_R, "ws map");

constexpr int RING_BYTES = 131072, LDS_BYTES = 147456;

struct KArgs {
    const float* x; const int* pos; const float* ffn1_norm; const float* ffn1_wi; const float* ffn1_wo; const float* mix_norm;
    const float* ffn2_norm; const float* ffn2_wi; const float* ffn2_wo; const float* even_w_in; const float* gate_w; const float* gate_b;
    const float* out_norm; const float* pool_w; const float* pool_scale; const float* even_w_out; const float* odd_w_in; const float* odd_w_out; const float* final_norm;
    float* out; unsigned char* ws;
};

namespace pg8 {
#define PG8_LAS __attribute__((address_space(3)))
constexpr int BM = 256, BK = 64, HALF = 128, HTB = HALF * BK * 2, STAGE_BYTES = 8 * HTB, NXCD = 8, WGM = 8;
__host__ __device__ __forceinline__ int lds_byte(int r, int c) { const int st = (r >> 4) * 2 + (c >> 5), rr = r & 15, cc = c & 31, ob = rr * 64 + cc * 2; return st * 1024 + (ob ^ (((ob >> 9) & 1) << 5)); }
__host__ __device__ __forceinline__ void stage_rc(int b, int& R, int& C) { const int st = b / 1024, sb = b % 1024, swz = sb ^ (((sb >> 9) & 1) << 5); R = (st >> 1) * 16 + swz / 64; C = (st & 1) * 32 + (swz % 64) / 2; }
__host__ __device__ __forceinline__ int perm32(int rho) { const int n = rho >> 4, i = rho & 15; return 8 * (i >> 2) + 4 * n + (i & 3); }
struct Unit { int pm, pn; };
struct Gemm { const bf16_t* A; const bf16_t* Bt; int M, N, K; };
struct StaticOrder {
    int nM, nN, nwg, G, c;
    __host__ __device__ void init(int M_, int N_, int G_, int c_) { nM = M_ / BM; nN = N_ / BM; nwg = nM * nN; G = G_; c = c_; }
    __host__ __device__ bool next(int i, Unit& u) const {
        const long L = (long)i * G + c; if (L >= nwg) return false;
        int wgid = (int)L; { const int q = nwg / NXCD, r = nwg % NXCD, xcd = wgid % NXCD, off = wgid / NXCD; wgid = (xcd < r ? xcd * (q + 1) : r * (q + 1) + (xcd - r) * q) + off; }
        const int nig = WGM * nN, gid = wgid / nig, fm = gid * WGM, gsz = (nM - fm) < WGM ? (nM - fm) : WGM;
        u.pm = fm + ((wgid % nig) % gsz); u.pn = (wgid % nig) / gsz; return true;
    }
    __device__ __forceinline__ void a_ready(const Unit&) const {}
    __device__ __forceinline__ void done(const Unit&) const {}
};

__device__ __forceinline__ float row_rs(const float* ssq, int row) {
    const f32x4* p = (const f32x4*)(ssq + (size_t)row * 16);
    const f32x4 a = p[0], b = p[1], c = p[2], d = p[3];
    const float s = ((a[0] + a[1]) + (a[2] + a[3])) + ((b[0] + b[1]) + (b[2] + b[3])) + ((c[0] + c[1]) + (c[2] + c[3])) + ((d[0] + d[1]) + (d[2] + d[3]));
    return __builtin_amdgcn_rsqf(s * (1.0f / 1024.0f) + RMS_EPS);
}
__device__ __forceinline__ float silu_f(float g) { return g * __builtin_amdgcn_rcpf(1.0f + __expf(-g)); }

__device__ __forceinline__ void rs8(const float* ssq, int row0, int fq, float (&rs)[2][4]) {
    f32x4 p[2][4];
#pragma unroll
    for (int ai = 0; ai < 2; ++ai)
#pragma unroll
        for (int m = 0; m < 4; ++m) p[ai][m] = *(const f32x4*)(ssq + (size_t)(row0 + ai * HALF + m * 16) * 16 + fq * 4);
#pragma unroll
    for (int ai = 0; ai < 2; ++ai)
#pragma unroll
        for (int m = 0; m < 4; ++m) { float t = (p[ai][m][0] + p[ai][m][1]) + (p[ai][m][2] + p[ai][m][3]); t = rows_sum(t);
            rs[ai][m] = __builtin_amdgcn_rsqf(t * (1.0f / 1024.0f) + RMS_EPS); }
}
__device__ __forceinline__ void rs4(const float* ssq, int row0, int fq, float (&rs)[4]) {
    f32x4 p[4];
#pragma unroll
    for (int m = 0; m < 4; ++m) p[m] = *(const f32x4*)(ssq + (size_t)(row0 + m * 16) * 16 + fq * 4);
#pragma unroll
    for (int m = 0; m < 4; ++m) { float t = (p[m][0] + p[m][1]) + (p[m][2] + p[m][3]); t = rows_sum(t); rs[m] = __builtin_amdgcn_rsqf(t * (1.0f / 1024.0f) + RMS_EPS); }
}
constexpr int RSB_OFF = 131072 + 10240;
__device__ __forceinline__ void rs_issue(const float* ssq, int pm, int tid, f32x4& p0, f32x4& p1) {
    const float* sp = ssq + ((size_t)pm * BM + (tid >> 1)) * 16 + (tid & 1) * 8; p0 = *(const f32x4*)sp; p1 = *(const f32x4*)(sp + 4); }
__device__ __forceinline__ void rs_commit(PG8_LAS unsigned char* lds, int parity, int tid, const f32x4 p0, const f32x4 p1) {
    float t = ((p0[0] + p0[1]) + (p0[2] + p0[3])) + ((p1[0] + p1[1]) + (p1[2] + p1[3]));
    t += __builtin_bit_cast(float, __builtin_amdgcn_update_dpp(0, __builtin_bit_cast(int, t), 0xB1, 0xF, 0xF, true));
    const float r = __builtin_amdgcn_rsqf(t * (1.0f / 1024.0f) + RMS_EPS);
    if ((tid & 1) == 0) *(PG8_LAS float*)(lds + RSB_OFF + parity * 1024 + (tid >> 1) * 4) = r; }
__device__ __forceinline__ void rs_read(const PG8_LAS float* rsb, int wr, int fr, float (&rs)[2][4]) {
    const PG8_LAS float* b = rsb + wr * 64 + fr;
#pragma unroll
    for (int ai = 0; ai < 2; ++ai)
#pragma unroll
        for (int m = 0; m < 4; ++m) rs[ai][m] = b[ai * HALF + m * 16]; }
struct EpiUp {
    static constexpr bool PERM = true, AFTER_DRAIN = false, IDEMPOTENT = true, USES_RS = true, RS_EARLY = true;
    const float* ssq; bf16_t* hid;
    __device__ __forceinline__ void operator()(const f32x4 (&acc)[2][2][4][2], const Unit& u, int wr, int wc, int fr, int fq, const PG8_LAS float* rsb) const {
        const int col0 = u.pn * 128 + wc * 32 + 8 * fq, row0 = u.pm * BM + wr * 64 + fr;
        float rs[2][4]; rs_read(rsb, wr, fr, rs);
#pragma unroll
        for (int ai = 0; ai < 2; ++ai)
#pragma unroll
            for (int m = 0; m < 4; ++m) {
                const int row = row0 + ai * HALF + m * 16; const float r = rs[ai][m], nr = r * -1.4426950408889634f, r2 = r * r;
                f32x4 o0, o1;
#pragma unroll
                for (int e = 0; e < 4; ++e) {
                    const float g0 = acc[ai][0][m][0][e], u0 = acc[ai][1][m][0][e], g1 = acc[ai][0][m][1][e], u1 = acc[ai][1][m][1][e];
                    o0[e] = (g0 * u0) * r2 * __builtin_amdgcn_rcpf(1.0f + __builtin_amdgcn_exp2f(g0 * nr));
                    o1[e] = (g1 * u1) * r2 * __builtin_amdgcn_rcpf(1.0f + __builtin_amdgcn_exp2f(g1 * nr)); }
                *(u32x4*)(hid + (size_t)row * DFF + col0) = pack8(o0, o1);
            }
    }
};
struct EpiRes {
    static constexpr bool PERM = true, AFTER_DRAIN = false, IDEMPOTENT = false, USES_RS = false, RS_EARLY = false;
    bf16_t* hb; float* ssq; float scale;
    __device__ __forceinline__ void operator()(const f32x4 (&acc)[2][2][4][2], const Unit& u, int wr, int wc, int fr, int fq, const PG8_LAS float*) const {
        const int col0 = u.pn * BM + wc * 32 + 8 * fq, row0 = u.pm * BM + wr * 64 + fr;
        u32x4 pre[2][4][2];
#pragma unroll
        for (int ai = 0; ai < 2; ++ai)
#pragma unroll
            for (int m = 0; m < 4; ++m)
#pragma unroll
                for (int bj = 0; bj < 2; ++bj) pre[ai][m][bj] = *(const u32x4*)(hb + (size_t)(row0 + ai * HALF + m * 16) * DM + col0 + bj * HALF);
#pragma unroll
        for (int ai = 0; ai < 2; ++ai) {
#pragma unroll
            for (int m = 0; m < 4; ++m) {
                const int row = row0 + ai * HALF + m * 16;
                float ss = 0.f;
#pragma unroll
                for (int bj = 0; bj < 2; ++bj) {
                    const size_t off = (size_t)row * DM + col0 + bj * HALF;
                    f32x4 b0, b1; unpack8(pre[ai][m][bj], b0, b1);
                    const f32x4 o0 = b0 + acc[ai][bj][m][0] * scale, o1 = b1 + acc[ai][bj][m][1] * scale;
                    *(u32x4*)(hb + off) = pack8(o0, o1);
                    ss += (o0[0] * o0[0] + o0[1] * o0[1]) + (o0[2] * o0[2] + o0[3] * o0[3]) + (o1[0] * o1[0] + o1[1] * o1[1]) + (o1[2] * o1[2] + o1[3] * o1[3]);
                }
                ss = rows_sum(ss);
                if (fq == 0) ssq[(size_t)row * 16 + u.pn * 4 + wc] = ss;
            }
        }
    }
};
struct EpiP0 {
    static constexpr bool PERM = true, AFTER_DRAIN = false, IDEMPOTENT = true, USES_RS = true, RS_EARLY = true;
    const float* ssq; const float* gate_b; bf16_t* qk; bf16_t* v; bf16_t* g; bf16_t* uo; float* la;
    __device__ __forceinline__ void operator()(const f32x4 (&acc)[2][2][4][2], const Unit& u, int wr, int wc, int fr, int fq, const PG8_LAS float* rsb) const {
        const int pn = u.pn, lc = wc * 32 + 8 * fq, row0 = u.pm * BM + wr * 64 + fr;
        float rs[2][4]; rs_read(rsb, wr, fr, rs);
        f32x4 gb[2][2] = {};
        if (pn == 6) {
#pragma unroll
            for (int bj = 0; bj < 2; ++bj) { gb[bj][0] = *(const f32x4*)(gate_b + lc + bj * HALF); gb[bj][1] = *(const f32x4*)(gate_b + lc + bj * HALF + 4); } }
#pragma unroll
        for (int ai = 0; ai < 2; ++ai)
#pragma unroll
            for (int m = 0; m < 4; ++m) {
                const int row = row0 + ai * HALF + m * 16; const float r = rs[ai][m];
#pragma unroll
                for (int bj = 0; bj < 2; ++bj) {
                    f32x4 a0 = acc[ai][bj][m][0] * r, a1 = acc[ai][bj][m][1] * r;
                    const int c = lc + bj * HALF;
                    if (pn < 2) { *(u32x4*)(qk + (size_t)row * 512 + pn * 256 + c) = pack8(a0, a1); }
                    else if (pn < 4) { *(u32x4*)(v + (size_t)row * 512 + (pn - 2) * 256 + c) = pack8(a0, a1); }
                    else if (pn < 6) {
#pragma unroll
                        for (int e = 0; e < 4; ++e) { a0[e] = silu_f(a0[e]); a1[e] = silu_f(a1[e]); }
                        *(u32x4*)(g + (size_t)row * 512 + (pn - 4) * 256 + c) = pack8(a0, a1); }
                    else if (pn == 6) {
#pragma unroll
                        for (int e = 0; e < 4; ++e) {
                            float x0 = a0[e] + gb[bj][0][e], x1 = a1[e] + gb[bj][1][e];
                            a0[e] = (fminf(x0, 0.f) - logf(1.0f + __expf(-fabsf(x0)))) * (1.0f / 16.0f);
                            a1[e] = (fminf(x1, 0.f) - logf(1.0f + __expf(-fabsf(x1)))) * (1.0f / 16.0f); }
                        *(f32x4*)(la + (size_t)row * 256 + c) = a0; *(f32x4*)(la + (size_t)row * 256 + c + 4) = a1; }
                    else { *(u32x4*)(uo + (size_t)row * 512 + (pn - 7) * 256 + c) = pack8(a0, a1); }
                }
            }
    }
};
struct EpiP1 {
    static constexpr bool PERM = true, AFTER_DRAIN = false, IDEMPOTENT = true, USES_RS = true, RS_EARLY = false;
    const float* ssq; const float* cs; bf16_t* q; bf16_t* k; bf16_t* v; bf16_t* qih; bf16_t* qil; bf16_t* kih; bf16_t* kil; float* wi;
    __device__ __forceinline__ void rope8(f32x4& a0, f32x4& a1, const f32x4 c0, const f32x4 c1) const {
        const float x0 = a0[0], x1 = a0[1], x2 = a0[2], x3 = a0[3], y0 = a1[0], y1 = a1[1], y2 = a1[2], y3 = a1[3];
        a0[0] = x0 * c0[0] - x1 * c0[1]; a0[1] = x1 * c0[0] + x0 * c0[1];
        a0[2] = x2 * c0[2] - x3 * c0[3]; a0[3] = x3 * c0[2] + x2 * c0[3];
        a1[0] = y0 * c1[0] - y1 * c1[1]; a1[1] = y1 * c1[0] + y0 * c1[1];
        a1[2] = y2 * c1[2] - y3 * c1[3]; a1[3] = y3 * c1[2] + y2 * c1[3];
    }
    __device__ __forceinline__ void split_store(bf16_t* ph, bf16_t* pl, f32x4 a0, f32x4 a1) const {
        const u32x4 h = pack8(a0, a1);
        f32x4 r0, r1;
        r0[0] = a0[0] - bf2f(h.x & 0xffffu); r0[1] = a0[1] - bf2f(h.x >> 16); r0[2] = a0[2] - bf2f(h.y & 0xffffu); r0[3] = a0[3] - bf2f(h.y >> 16);
        r1[0] = a1[0] - bf2f(h.z & 0xffffu); r1[1] = a1[1] - bf2f(h.z >> 16); r1[2] = a1[2] - bf2f(h.w & 0xffffu); r1[3] = a1[3] - bf2f(h.w >> 16);
        *(u32x4*)ph = h; *(u32x4*)pl = pack8(r0, r1);
    }
    __device__ __forceinline__ void operator()(const f32x4 (&acc)[2][2][4][2], const Unit& u, int wr, int wc, int fr, int fq, const PG8_LAS float* rsb) const {
        const int pn = u.pn, lc = wc * 32 + 8 * fq, row0 = u.pm * BM + wr * 64 + fr;
        const bool r128 = pn < 5, r64 = pn == 6 || (pn == 7 && wc < 2);
#pragma unroll
        for (int ai = 0; ai < 2; ++ai) {
            f32x4 cA[4], cB[4]; float rs[4];
#pragma unroll
            for (int m = 0; m < 4; ++m) rs[m] = rsb[wr * 64 + fr + ai * HALF + m * 16];
#pragma unroll
            for (int m = 0; m < 4; ++m) { const int row = row0 + ai * HALF + m * 16;
                if (r128 && pn != 5) { const float* cp = cs + ((size_t)row * 64 + (lc >> 1)) * 2; cA[m] = *(const f32x4*)cp; cB[m] = *(const f32x4*)(cp + 4); }
                else if (r64) { const float* cp = cs + ((size_t)row * 64 + (lc & 63)) * 2;
                    const f32x2 e0 = *(const f32x2*)(cp), e1 = *(const f32x2*)(cp + 4), e2 = *(const f32x2*)(cp + 8), e3 = *(const f32x2*)(cp + 12);
                    cA[m] = (f32x4){e0[0], e0[1], e1[0], e1[1]}; cB[m] = (f32x4){e2[0], e2[1], e3[0], e3[1]}; } }
#pragma unroll
            for (int m = 0; m < 4; ++m) {
                const int row = row0 + ai * HALF + m * 16;
                const int b = row >> 12, s = row & 4095; const float r = rs[m];
#pragma unroll
                for (int bj = 0; bj < 2; ++bj) {
                    f32x4 a0 = acc[ai][bj][m][0] * r, a1 = acc[ai][bj][m][1] * r;
                    if (pn < 4) { rope8(a0, a1, cA[m], cB[m]); a0 = a0 * QSCALE; a1 = a1 * QSCALE;
                        *(u32x4*)(q + ((size_t)(b * 8 + pn * 2 + bj) * SEQ + s) * 128 + lc) = pack8(a0, a1); }
                    else if (pn == 4) { rope8(a0, a1, cA[m], cB[m]);
                        *(u32x4*)(k + ((size_t)(b * 2 + bj) * SEQ + s) * 128 + lc) = pack8(a0, a1); }
                    else if (pn == 5) { *(u32x4*)(v + ((size_t)(b * 2 + bj) * SEQ + s) * 128 + lc) = pack8(a0, a1); }
                    else if (pn == 6) { const int ct = bj * HALF + lc; rope8(a0, a1, cA[m], cB[m]);
                        split_store(qih + (size_t)row * 256 + ct, qil + (size_t)row * 256 + ct, a0, a1); }
                    else if (bj == 0) {
                        if (wc < 2) { const int c64 = lc; rope8(a0, a1, cA[m], cB[m]);
                            const int q8 = c64 >> 3; const size_t tb = ((size_t)(b * 128 + (s >> 5)) * 4096) + (size_t)(((q8 >> 1) * 4 + (q8 & 1)) * 256 + (s & 31) * 8);
                            split_store(kih + tb, kih + tb + 512, a0, a1); }
                        else if (wc == 2 && fq == 0) { *(f32x4*)(wi + (size_t)row * 4) = a0; }
                    }
                }
            }
        }
    }
};

template <class Epi, class Sched, bool ALIGN_EPI = false, bool SP2 = false>
__device__ __forceinline__ void gemm_phase(PG8_LAS unsigned char* lds, const Gemm g, const Sched& S, const Epi& E, const int tid) {
    const int wid = __builtin_amdgcn_readfirstlane(tid >> 6), lane = tid & 63, wr = wid >> 2, wc = wid & 3, fr = lane & 15, fq = lane >> 4;
    const int K = g.K, nt = K / BK;
    unsigned voffA[2], voffB[2];
#pragma unroll
    for (int i = 0; i < 2; ++i) { int R, C; stage_rc(tid * 16 + i * 8192, R, C); const int Rb = Epi::PERM ? ((R & ~31) + perm32(R & 31)) : R;
        voffA[i] = (unsigned)(R * K + C) * 2u; voffB[i] = (unsigned)(Rb * K + C) * 2u; }
    const size_t kstep = (size_t)(BK * 2);
    const size_t hstep = (size_t)HALF * K * 2;
    const size_t tstep = 2 * hstep;
    const unsigned ldsw = (unsigned)wid * 1024u;
    const int aoff = lds_byte(wr * 64 + fr, fq * 8), boff = lds_byte(wc * 32 + fr, fq * 8);
#define PG8_SA(b, h) (((b) * 2 + (h)) * HTB)
#define PG8_SB(b, h) ((4 + (b) * 2 + (h)) * HTB)
#define PG8_STAGE(bufoff, gbase, voff) do { _Pragma("unroll") for (int _i = 0; _i < 2; ++_i) \
        __builtin_amdgcn_global_load_lds((const unsigned*)((const char*)(gbase) + (voff)[_i]), (PG8_LAS unsigned*)(lds + (bufoff) + ldsw + _i * 8192), 16, 0, 0); } while (0)
#define PG8_LDA(dst, b, h) do { _Pragma("unroll") for (int m = 0; m < 4; ++m) _Pragma("unroll") for (int k = 0; k < 2; ++k) dst[m][k] = *(const PG8_LAS bf16x8*)(lds + PG8_SA(b, h) + aoff + m * 2048 + k * 1024); } while (0)
#define PG8_LDB(dst, b, h) do { _Pragma("unroll") for (int n = 0; n < 2; ++n) _Pragma("unroll") for (int k = 0; k < 2; ++k) dst[n][k] = *(const PG8_LAS bf16x8*)(lds + PG8_SB(b, h) + boff + n * 2048 + k * 1024); } while (0)
#define PG8_MMA(ai, bj, At, Bt) do { __builtin_amdgcn_s_setprio(1); _Pragma("unroll") for (int m = 0; m < 4; ++m) _Pragma("unroll") for (int n = 0; n < 2; ++n) _Pragma("unroll") for (int k = 0; k < 2; ++k) \
        acc[ai][bj][m][n] = __builtin_amdgcn_mfma_f32_16x16x32_bf16(Bt[n][k], At[m][k], acc[ai][bj][m][n], 0, 0, 0); __builtin_amdgcn_s_setprio(0); } while (0)
#define PG8_WAIT_V(n) asm volatile("s_waitcnt vmcnt(" #n ")" ::: "memory")
#define PG8_WAIT_L(n) asm volatile("s_waitcnt lgkmcnt(" #n ")" ::: "memory")
#define PG8_BAR __builtin_amdgcn_s_barrier()
#define PG8_SCHED __builtin_amdgcn_sched_barrier(0)
    Unit cur, nxt; int ui = 0;
    if (!S.next(0, cur)) return;
    f32x4 acc[2][2][4][2];
#pragma unroll
    for (int a = 0; a < 2; ++a)
#pragma unroll
        for (int b = 0; b < 2; ++b)
#pragma unroll
            for (int m = 0; m < 4; ++m)
#pragma unroll
                for (int n = 0; n < 2; ++n) acc[a][b][m][n] = (f32x4){0.f, 0.f, 0.f, 0.f};
    bf16x8 At[4][2], B0[2][2], B1[2][2];
    const char* cA = (const char*)g.A + (size_t)cur.pm * tstep; const char* cB = (const char*)g.Bt + (size_t)cur.pn * tstep;
    S.a_ready(cur);
    f32x4 rf0, rf1;
    if constexpr (Epi::USES_RS) rs_issue(E.ssq, cur.pm, tid, rf0, rf1);
    if constexpr (SP2) {
        PG8_STAGE(PG8_SB(0, 0), cB, voffB); PG8_STAGE(PG8_SB(0, 1), cB + hstep, voffB); PG8_STAGE(PG8_SA(0, 0), cA, voffA); PG8_STAGE(PG8_SA(0, 1), cA + hstep, voffA);
        if (wr == 1) PG8_BAR;
        PG8_WAIT_V(2); PG8_BAR;
        PG8_STAGE(PG8_SB(1, 0), cB + kstep, voffB); PG8_STAGE(PG8_SA(1, 0), cA + kstep, voffA); PG8_STAGE(PG8_SB(1, 1), cB + hstep + kstep, voffB);
        PG8_WAIT_V(6); PG8_BAR;
    } else {
        PG8_STAGE(PG8_SB(0, 0), cB, voffB); PG8_STAGE(PG8_SA(0, 0), cA, voffA); PG8_STAGE(PG8_SB(0, 1), cB + hstep, voffB); PG8_STAGE(PG8_SA(0, 1), cA + hstep, voffA);
        if (wr == 1) PG8_BAR;
        PG8_WAIT_V(4); PG8_BAR;
        PG8_STAGE(PG8_SB(1, 0), cB + kstep, voffB); PG8_STAGE(PG8_SA(1, 0), cA + kstep, voffA); PG8_STAGE(PG8_SB(1, 1), cB + hstep + kstep, voffB);
        PG8_WAIT_V(6); PG8_BAR;
    }
    if constexpr (Epi::USES_RS) rs_commit(lds, 0, tid, rf0, rf1);
    for (;;) {
        const bool has_next = S.next(ui + 1, nxt);
        const char* nA = has_next ? (const char*)g.A + (size_t)nxt.pm * tstep : cA; const char* nB = has_next ? (const char*)g.Bt + (size_t)nxt.pn * tstep : cB;
        for (int t = 0; t < nt; t += 2) {
            const bool last = (t == nt - 2);
            const char* a1 = cA + (size_t)(t + 1) * kstep;
            const char* a2 = last ? nA : cA + (size_t)(t + 2) * kstep; const char* b2 = last ? nB : cB + (size_t)(t + 2) * kstep;
            const char* a3 = a2 + kstep; const char* b3 = b2 + kstep;
            if (last && has_next) S.a_ready(nxt);
            if constexpr (SP2) {
            PG8_LDB(B0, 0, 0); PG8_LDB(B1, 0, 1); PG8_SCHED; PG8_LDA(At, 0, 0); PG8_STAGE(PG8_SA(1, 1), a1 + hstep, voffA);
            PG8_WAIT_V(8); PG8_WAIT_L(0); PG8_BAR; PG8_MMA(0, 0, At, B0); PG8_MMA(0, 1, At, B1); PG8_BAR; PG8_SCHED;
            PG8_LDA(At, 0, 1); PG8_STAGE(PG8_SB(0, 0), b2, voffB); PG8_STAGE(PG8_SB(0, 1), b2 + hstep, voffB); PG8_STAGE(PG8_SA(0, 0), a2, voffA);
            PG8_WAIT_V(8); PG8_WAIT_L(0); PG8_BAR; PG8_MMA(1, 0, At, B0); PG8_MMA(1, 1, At, B1); PG8_BAR; PG8_SCHED;
            PG8_LDB(B0, 1, 0); PG8_LDB(B1, 1, 1); PG8_SCHED; PG8_LDA(At, 1, 0); PG8_STAGE(PG8_SA(0, 1), a2 + hstep, voffA);
            PG8_WAIT_V(8); PG8_WAIT_L(0); PG8_BAR; PG8_MMA(0, 0, At, B0); PG8_MMA(0, 1, At, B1); PG8_BAR; PG8_SCHED;
            PG8_LDA(At, 1, 1); PG8_STAGE(PG8_SB(1, 0), b3, voffB); PG8_STAGE(PG8_SB(1, 1), b3 + hstep, voffB); PG8_STAGE(PG8_SA(1, 0), a3, voffA);
            PG8_WAIT_V(8); PG8_WAIT_L(0); PG8_BAR; PG8_MMA(1, 0, At, B0); PG8_MMA(1, 1, At, B1); PG8_BAR; PG8_SCHED;
            } else {
            PG8_LDB(B0, 0, 0); PG8_SCHED; PG8_LDA(At, 0, 0); PG8_STAGE(PG8_SA(1, 1), a1 + hstep, voffA);
            PG8_WAIT_L(8); PG8_BAR; PG8_WAIT_L(0); PG8_MMA(0, 0, At, B0); PG8_BAR; PG8_SCHED;
            PG8_LDB(B1, 0, 1); PG8_STAGE(PG8_SB(0, 0), b2, voffB);
            PG8_BAR; PG8_WAIT_L(0); PG8_MMA(0, 1, At, B1); PG8_BAR;
            PG8_LDA(At, 0, 1); PG8_STAGE(PG8_SA(0, 0), a2, voffA);
            PG8_BAR; PG8_WAIT_L(0); PG8_MMA(1, 0, At, B0); PG8_BAR; PG8_SCHED;
            PG8_STAGE(PG8_SB(0, 1), b2 + hstep, voffB);
            PG8_WAIT_V(6); PG8_BAR; PG8_MMA(1, 1, At, B1); PG8_BAR;
            PG8_LDB(B0, 1, 0); PG8_SCHED; PG8_LDA(At, 1, 0); PG8_STAGE(PG8_SA(0, 1), a2 + hstep, voffA);
            PG8_WAIT_L(8); PG8_BAR; PG8_WAIT_L(0); PG8_MMA(0, 0, At, B0); PG8_BAR; PG8_SCHED;
            PG8_LDB(B1, 1, 1); PG8_STAGE(PG8_SB(1, 0), b3, voffB);
            PG8_BAR; PG8_WAIT_L(0); PG8_MMA(0, 1, At, B1); PG8_BAR;
            PG8_LDA(At, 1, 1); PG8_STAGE(PG8_SA(1, 0), a3, voffA);
            PG8_BAR; PG8_WAIT_L(0); PG8_MMA(1, 0, At, B0); PG8_BAR; PG8_SCHED;
            PG8_STAGE(PG8_SB(1, 1), b3 + hstep, voffB);
            PG8_WAIT_V(6); PG8_BAR; PG8_MMA(1, 1, At, B1); PG8_BAR;
            }
        }
        if constexpr (ALIGN_EPI) { if (wr == 0) PG8_BAR; }
        if constexpr (!Epi::AFTER_DRAIN) { int fr_ = fr, fq_ = fq; asm volatile("" : "+v"(fr_), "+v"(fq_));
            if constexpr (Epi::USES_RS) { int t_ = tid; asm volatile("" : "+v"(t_)); f32x4 rp0, rp1;
                const int npm = has_next ? nxt.pm : cur.pm;
                if constexpr (Epi::RS_EARLY) rs_issue(E.ssq, npm, t_, rp0, rp1);
                E(acc, cur, wr, wc, fr_, fq_, (const PG8_LAS float*)(lds + RSB_OFF + (ui & 1) * 1024));
                if constexpr (!Epi::RS_EARLY) rs_issue(E.ssq, npm, t_, rp0, rp1);
                rs_commit(lds, (ui + 1) & 1, t_, rp0, rp1); }
            else E(acc, cur, wr, wc, fr_, fq_, (const PG8_LAS float*)nullptr);
            S.done(cur); }
        if (!has_next) break;
#pragma unroll
        for (int a = 0; a < 2; ++a)
#pragma unroll
            for (int b = 0; b < 2; ++b)
#pragma unroll
                for (int m = 0; m < 4; ++m)
#pragma unroll
                    for (int n = 0; n < 2; ++n) acc[a][b][m][n] = (f32x4){0.f, 0.f, 0.f, 0.f};
        cur = nxt; cA = nA; cB = nB; ++ui;
        if constexpr (ALIGN_EPI) { if (wr == 1) PG8_BAR; }
    }
    PG8_WAIT_V(0);
    if constexpr (!ALIGN_EPI) { if (wr == 0) PG8_BAR; }
    PG8_BAR;
#undef PG8_SA
#undef PG8_SB
#undef PG8_STAGE
#undef PG8_LDA
#undef PG8_LDB
#undef PG8_MMA
#undef PG8_WAIT_V
#undef PG8_WAIT_L
#undef PG8_BAR
#undef PG8_SCHED
}
}

namespace att {
constexpr int D = 128, NW = 8, QBLK = 32, KVBLK = 64, QB = NW * QBLK, OSTRIDE = 1024;
constexpr float SCALE = 0.08838834764831845f, THR = 8.f;
constexpr int SHM_V = KVBLK * D * 2, SHM_K = KVBLK * D * 2;
constexpr int LDS_BYTES = 2 * SHM_V + 2 * SHM_K + NW * 64 * 4;
#define KSWZ(row, colB) ((row) * 256 + ((colB) ^ (((row) & 7) << 4)))
#define SBAR() __builtin_amdgcn_sched_barrier(0)
__device__ __forceinline__ int v_st(int k, int c) { const int kk = (k & ~0xC) | ((k & 4) << 1) | ((k & 8) >> 1); return ((kk >> 3) * 4 + (c >> 5)) * 512 + ((kk & 7) * 32 + (c & 31)) * 2; }
__device__ __forceinline__ int v_rd_base(int lane) { return ((lane & 3) << 3) | (((lane >> 2) & 3) << 6) | (((lane >> 4) & 1) << 5) | (((lane >> 5) & 1) << 8); }
constexpr int v_rd_off(int d0, int ks, int half) { return d0 * 512 + ks * 4096 + half * 2048; }
__device__ __forceinline__ int crow(int r, int hi) { return (r & 3) + 8 * (r >> 2) + 4 * hi; }
__device__ __forceinline__ unsigned cvtpk(float lo, float hi) { unsigned r; asm volatile("v_cvt_pk_bf16_f32 %0, %1, %2" : "=v"(r) : "v"(lo), "v"(hi)); return r; }
__device__ __forceinline__ bf16x8 load8(const bf16_t* p) { return *reinterpret_cast<const bf16x8*>(p); }
__device__ __forceinline__ void mask_bits(f32x16& p0, f32x16& p1, unsigned long long w, int hi) {
    const float NEG = -__builtin_inff();
    const unsigned lo = (unsigned)w >> (4 * hi), hw = (unsigned)(w >> 32) >> (4 * hi);
#pragma unroll
    for (int r = 0; r < 16; ++r) {
        const int c = (r & 3) + 8 * (r >> 2);
        if (!((lo >> c) & 1u)) p0[r] = NEG;
        if (!((hw >> c) & 1u)) p1[r] = NEG;
    }
}
__device__ __forceinline__ void partialSM(f32x16& p0, f32x16& p1, float& m_reg, float& mn, float& alpha) {
    float pmax = p0[0]; for (int r = 1; r < 16; ++r) pmax = fmaxf(pmax, p0[r]); for (int r = 0; r < 16; ++r) pmax = fmaxf(pmax, p1[r]);
    { auto rr = __builtin_amdgcn_permlane32_swap(__float_as_uint(pmax), __float_as_uint(pmax), false, false);
      pmax = fmaxf(__uint_as_float(rr[0]), __uint_as_float(rr[1])); }
    constexpr float THR2 = THR * 1.4426950408889634f;
    if (__builtin_expect(__all(pmax <= THR2), 1)) { alpha = 1.f; }
    else { const float dl = fmaxf(pmax, 0.f); m_reg += dl; alpha = __builtin_amdgcn_exp2f(-dl);
        for (int r = 0; r < 16; ++r) { p0[r] -= dl; p1[r] -= dl; } }
    mn = m_reg;
    for (int r = 0; r < 16; ++r) p0[r] = __builtin_amdgcn_exp2f(p0[r]);
}
__device__ __forceinline__ void finishSM(f32x16& p0, f32x16& p1, float alpha, float& l_reg, bf16x8& pa0, bf16x8& pa1, bf16x8& pa2, bf16x8& pa3) {
    for (int r = 0; r < 16; ++r) p1[r] = __builtin_amdgcn_exp2f(p1[r]);
    float ps = 0; for (int r = 0; r < 16; ++r) ps += p0[r]; for (int r = 0; r < 16; ++r) ps += p1[r];
    { auto rr = __builtin_amdgcn_permlane32_swap(__float_as_uint(ps), __float_as_uint(ps), false, false);
      ps = __uint_as_float(rr[0]) + __uint_as_float(rr[1]); }
    l_reg = l_reg * alpha + ps;
#define PK4(P, B_, OUT) do { unsigned a0 = cvtpk(P[B_+0], P[B_+1]), a1 = cvtpk(P[B_+2], P[B_+3]);                          \
        unsigned b0 = cvtpk(P[B_+4], P[B_+5]), b1 = cvtpk(P[B_+6], P[B_+7]);                                             \
        auto r0 = __builtin_amdgcn_permlane32_swap(a0, b0, false, false); auto r1 = __builtin_amdgcn_permlane32_swap(a1, b1, false, false); \
        u32x4 w = {r0[0], r1[0], r0[1], r1[1]}; OUT = *reinterpret_cast<bf16x8*>(&w); } while (0)
    PK4(p0, 0, pa0); PK4(p0, 8, pa1); PK4(p1, 0, pa2); PK4(p1, 8, pa3);
#undef PK4
}
template <int KB>
__device__ __forceinline__ void qkt(f32x16& p0, f32x16& p1, const char* K_lds, int r32_, int hi_, const bf16x8* qr, unsigned long long mw, float negm) {
    const int r32 = r32_, hi = hi_;
    { const int nlo = (int)~((unsigned)mw >> (4 * hi)), nhw = (int)~((unsigned)(mw >> 32) >> (4 * hi));
      const int nb = __builtin_bit_cast(int, negm);
#pragma unroll
      for (int r = 0; r < 16; ++r) { const int c = (r & 3) + 8 * (r >> 2);
          int m0 = __builtin_amdgcn_sbfe(nlo, c, 1), m1 = __builtin_amdgcn_sbfe(nhw, c, 1);
          asm("" : "+v"(m0), "+v"(m1));
          p0[r] = __builtin_bit_cast(float, (m0 & (int)0xFF800000) | (~m0 & nb));
          p1[r] = __builtin_bit_cast(float, (m1 & (int)0xFF800000) | (~m1 & nb)); } }
    const char* kb[4];
#pragma unroll
    for (int dd = 0; dd < 4; ++dd) kb[dd] = K_lds + KB * SHM_K + KSWZ(r32, (dd * 16 + hi * 8) * 2);
    bf16x8 b0 = *reinterpret_cast<const bf16x8*>(kb[0]), b1 = *reinterpret_cast<const bf16x8*>(kb[0] + 32 * 256);
#pragma unroll
    for (int d0 = 0; d0 < 8; ++d0) {
        bf16x8 n0 = b0, n1 = b1;
        if (d0 < 7) { const char* a = kb[(d0 + 1) & 3] + ((d0 + 1) >> 2) * 128; n0 = *reinterpret_cast<const bf16x8*>(a); n1 = *reinterpret_cast<const bf16x8*>(a + 32 * 256); }
        __builtin_amdgcn_sched_barrier(0);
        p0 = __builtin_amdgcn_mfma_f32_32x32x16_bf16(b0, qr[d0], p0, 0, 0, 0);
        p1 = __builtin_amdgcn_mfma_f32_32x32x16_bf16(b1, qr[d0], p1, 0, 0, 0);
        __builtin_amdgcn_sched_barrier(0);
        b0 = n0; b1 = n1; }
}
template <int VB>
__device__ __forceinline__ void pv_tile(f32x16* o, int vbase, int lane_, bf16x8 pa0, bf16x8 pa1, bf16x8 pa2, bf16x8 pa3) {
    const int vb0 = vbase + v_rd_base(lane_);
#define TRRD(dst, off) asm volatile("ds_read_b64_tr_b16 %0, %1 offset:%2" : "=&v"(dst) : "v"(vb0), "i"(off) : "memory")
#define PV_D0(d0) do { s16x4 l0, l1, l2, l3, h0, h1, h2, h3; constexpr int b_ = VB * SHM_V + v_rd_off(d0, 0, 0); \
        TRRD(l0, b_); TRRD(h0, b_ + 2048); TRRD(l1, b_ + 4096); TRRD(h1, b_ + 6144); TRRD(l2, b_ + 8192); TRRD(h2, b_ + 10240); TRRD(l3, b_ + 12288); TRRD(h3, b_ + 14336); \
        asm volatile("s_waitcnt lgkmcnt(0)" ::: "memory"); SBAR();   \
        o[d0] = __builtin_amdgcn_mfma_f32_32x32x16_bf16(pa0, (bf16x8){l0[0], l0[1], l0[2], l0[3], h0[0], h0[1], h0[2], h0[3]}, o[d0], 0, 0, 0);   \
        o[d0] = __builtin_amdgcn_mfma_f32_32x32x16_bf16(pa1, (bf16x8){l1[0], l1[1], l1[2], l1[3], h1[0], h1[1], h1[2], h1[3]}, o[d0], 0, 0, 0);   \
        o[d0] = __builtin_amdgcn_mfma_f32_32x32x16_bf16(pa2, (bf16x8){l2[0], l2[1], l2[2], l2[3], h2[0], h2[1], h2[2], h2[3]}, o[d0], 0, 0, 0);   \
        o[d0] = __builtin_amdgcn_mfma_f32_32x32x16_bf16(pa3, (bf16x8){l3[0], l3[1], l3[2], l3[3], h3[0], h3[1], h3[2], h3[3]}, o[d0], 0, 0, 0); } while (0)
    PV_D0(0); PV_D0(1); PV_D0(2); PV_D0(3);
#undef PV_D0
#undef TRRD
}
constexpr size_t VOFF = (size_t)4 * 1024 * 1024;
struct BlockRef { const bf16_t* Q; const bf16_t* K; bf16_t* O; const unsigned long long* MW; int P0; };
struct Seam { bf16x8 qr[8]; bf16x8 st_v0, st_v1, st_k0, st_k1; };
#define ROW(p, k0, rr) ((p) + (unsigned)(((k0) + (rr)) * D + sc))
#define VMW() asm volatile("s_waitcnt vmcnt(0)" ::: "memory")
#define VMWN(n) asm volatile("s_waitcnt vmcnt(%0)" :: "i"(n) : "memory")
#define SLOAD_H(Kp, Vp, k0) do { S.st_v0 = load8(ROW(Vp, k0, sr)); S.st_v1 = load8(ROW(Vp, k0, 32 + sr));              \
                         S.st_k0 = load8(ROW(Kp, k0, sr)); S.st_k1 = load8(ROW(Kp, k0, 32 + sr)); } while (0)
#define SWOFF() int t_ = tid; asm volatile("" : "+v"(t_)); const int sr_ = t_ >> 4, sc_ = (t_ & 15) * 8
#define SWRITE_HK(bf) do { SWOFF(); const int kws_ = KSWZ(sr_, sc_ * 2); *(bf16x8*)(K_lds + (bf) * SHM_K + kws_) = S.st_k0; *(bf16x8*)(K_lds + (bf) * SHM_K + kws_ + 32 * 256) = S.st_k1; } while (0)
#define SWRITE_HV(bf) do { SWOFF(); *(bf16x8*)(V_lds + (bf) * SHM_V + v_st(sr_, sc_)) = S.st_v0; *(bf16x8*)(V_lds + (bf) * SHM_V + v_st(32 + sr_, sc_)) = S.st_v1; } while (0)
#define SWRITE_H(bf) do { SWRITE_HV(bf); SWRITE_HK(bf); } while (0)
__device__ __forceinline__ void attn_prime(const BlockRef& cur, char* lds, Seam& S, const int tid) {
    const int wid = __builtin_amdgcn_readfirstlane(tid >> 6), lane = tid & 63, r32 = lane & 31, hi = lane >> 5;
    const int sr = tid >> 4, sc = (tid & 15) * 8; char* K_lds = lds + 2 * SHM_V;
#pragma unroll
    for (int d0 = 0; d0 < 8; ++d0) S.qr[d0] = load8(cur.Q + (unsigned)((wid * QBLK + r32) * D + d0 * 16 + hi * 8));
    SLOAD_H(cur.K, cur.K + VOFF, 0); VMW(); SWRITE_HK(0);
    __syncthreads();
}
__device__ __forceinline__ void attn_block(const BlockRef& cur, const BlockRef& nxt, char* lds, Seam& S, const int tid) {
    const int wid = __builtin_amdgcn_readfirstlane(tid >> 6), lane = tid & 63, r32 = lane & 31, hi = lane >> 5;
    const int NT = (cur.P0 + QB - 1) / KVBLK + 1;
    const int mro = wid * QBLK + r32;
    char* V_lds = lds; char* K_lds = lds + 2 * SHM_V;
    float* ws = (float*)(lds + 2 * SHM_V + 2 * SHM_K) + wid * 64; float* li_l = ws, * al_l = ws + 32;
    float m_reg = 0.f, l_reg = 0; f32x16 o[4] = {};
    const int sr = tid >> 4, sc = (tid & 15) * 8;
    const int vbase = (int)(uintptr_t)V_lds;
    const bf16_t* Kh = cur.K; const bf16_t* Vh = cur.K + VOFF;
#define RESC(a) do { if (__any((a) < 1.f)) { if (hi == 0) al_l[r32] = (a); asm volatile("s_waitcnt lgkmcnt(0)" ::: "memory");              \
                     for (int d_ = 0; d_ < 4; ++d_) for (int r = 0; r < 16; ++r) o[d_][r] *= al_l[crow(r, hi)]; } } while (0)
#define KBASE(t) ((t) * KVBLK)
    f32x16 pA0, pA1, pB0, pB1; float mnA, mnB, alA, alB; bf16x8 pa0, pa1, pa2, pa3; unsigned long long mwA, mwB;
    mwA = cur.MW[mro]; mwB = cur.MW[mro + (NT > 1 ? SEQ : 0)];
    const int swk_ = KSWZ(sr, sc * 2), swv0_ = v_st(sr, sc), swv1_ = v_st(32 + sr, sc);
#define SWRITE_HK2(bf) do { *(bf16x8*)(K_lds + (bf) * SHM_K + swk_) = S.st_k0; *(bf16x8*)(K_lds + (bf) * SHM_K + swk_ + 32 * 256) = S.st_k1; } while (0)
#define SWRITE_HV2(bf) do { *(bf16x8*)(V_lds + (bf) * SHM_V + swv0_) = S.st_v0; *(bf16x8*)(V_lds + (bf) * SHM_V + swv1_) = S.st_v1; } while (0)
#define SWRITE_H2(bf) do { SWRITE_HV2(bf); SWRITE_HK2(bf); } while (0)
    SWRITE_HV2(0); SBAR();
    if (NT > 1) { SLOAD_H(Kh, Vh, KBASE(1)); }
    SBAR(); qkt<0>(pA0, pA1, K_lds, r32, hi, S.qr, mwA, -m_reg);
    partialSM(pA0, pA1, m_reg, mnA, alA);
    if (NT > 1) { VMW(); SWRITE_H2(1); }
    __syncthreads();
#define HALF_STEP(PX0, PX1, mnX, alX, mwX, mwY, PY0, PY1, alY, t, KB, VB, SB) do {                                            \
        SBAR();                                                                                                               \
          \
          \
        if (wid < 4) { qkt<KB>(PX0, PX1, K_lds, r32, hi, S.qr, mwX, -m_reg);                                                  \
            mwY = cur.MW[mro + ((t) + 1 < NT ? (t) + 1 : (t)) * SEQ];    \
            finishSM(PY0, PY1, alY, l_reg, pa0, pa1, pa2, pa3); }                                                             \
        else { mwY = cur.MW[mro + ((t) + 1 < NT ? (t) + 1 : (t)) * SEQ];                                                      \
            finishSM(PY0, PY1, alY, l_reg, pa0, pa1, pa2, pa3); SBAR();                                                       \
            qkt<KB>(PX0, PX1, K_lds, r32, hi, S.qr, mwX, -m_reg); }                                                           \
        SBAR();                                                                                                               \
        if ((t) + 1 < NT) { SLOAD_H(Kh, Vh, KBASE((t) + 1)); SBAR(); }                                               \
        pv_tile<VB>(o, vbase, lane, pa0, pa1, pa2, pa3); partialSM(PX0, PX1, m_reg, mnX, alX);                                        \
        __syncthreads();                                                                                                      \
        if ((t) + 1 < NT) { VMW(); SWRITE_H2(SB); }                                                                         \
        RESC(alX); __syncthreads(); } while (0)
    for (int t = 1; t + 1 < NT; t += 2) {
        HALF_STEP(pB0, pB1, mnB, alB, mwB, mwA, pA0, pA1, alA, t, 1, 0, 0);
        HALF_STEP(pA0, pA1, mnA, alA, mwA, mwB, pB0, pB1, alB, t + 1, 0, 1, 1);
    }
    const bool even = (NT & 1) == 0;
    if (even) { SBAR(); qkt<1>(pB0, pB1, K_lds, r32, hi, S.qr, mwB, -m_reg); SBAR(); }
    SLOAD_H(nxt.K, nxt.K + VOFF, 0); SBAR();
#pragma unroll
    for (int d0 = 0; d0 < 8; ++d0) S.qr[d0] = load8(nxt.Q + (unsigned)((wid * QBLK + r32) * D + d0 * 16 + hi * 8));
    SBAR();
    finishSM(pA0, pA1, alA, l_reg, pa0, pa1, pa2, pa3); SBAR();
    pv_tile<0>(o, vbase, lane, pa0, pa1, pa2, pa3);
    if (even) { partialSM(pB0, pB1, m_reg, mnB, alB); __syncthreads(); RESC(alB);
        finishSM(pB0, pB1, alB, l_reg, pa0, pa1, pa2, pa3); SBAR(); pv_tile<1>(o, vbase, lane, pa0, pa1, pa2, pa3); }
    SBAR(); VMWN(8); SWRITE_HK2(0); SBAR();
    if (hi == 0) li_l[r32] = l_reg; asm volatile("s_waitcnt lgkmcnt(0)" ::: "memory");
    float rli[16];
#pragma unroll
    for (int r = 0; r < 16; ++r) rli[r] = __builtin_amdgcn_rcpf(li_l[crow(r, hi)]);
    bf16_t* Ow = cur.O + (unsigned)(wid * QBLK * OSTRIDE);
    int le = lane; asm volatile("" : "+v"(le)); const int r32e = le & 31, hie = le >> 5;
#pragma unroll
    for (int r = 0; r < 16; ++r) { const int orow = crow(r, hie);
#pragma unroll
        for (int d0 = 0; d0 < 4; ++d0) { const float v = o[d0][r] * rli[r];
            const float vn = DPP_F(v, 0xB1);
            if ((r32e & 1) == 0) *(unsigned*)(Ow + (unsigned)(orow * OSTRIDE + d0 * 32 + r32e)) = cvtpk(v, vn); } }
    __syncthreads();
#undef RESC
#undef KBASE
#undef HALF_STEP
#undef SWRITE_HK2
#undef SWRITE_HV2
#undef SWRITE_H2
}
#undef ROW
#undef VMW
#undef VMWN
#undef SLOAD_H
#undef SWRITE_HK
#undef SWOFF
#undef SWRITE_HV
#undef SWRITE_H
#undef SBAR
#undef KSWZ
}

__device__ __forceinline__ bf16x8 tr_frag(int base, int off) {
    const s16x4 l = __builtin_amdgcn_ds_read_tr16_b64_v4i16((__attribute__((address_space(3))) s16x4*)(base + off)), h = __builtin_amdgcn_ds_read_tr16_b64_v4i16((__attribute__((address_space(3))) s16x4*)(base + off + 2048));
    return (bf16x8){l[0], l[1], l[2], l[3], h[0], h[1], h[2], h[3]}; }
typedef const __attribute__((address_space(4))) KArgs* KArgsCP;
__device__ __forceinline__ KArgsCP kargs() { KArgsCP p = (KArgsCP)__builtin_amdgcn_kernarg_segment_ptr(); asm volatile("" : "+s"(p)); return p; }
__device__ __forceinline__ KArgs load_kargs() { KArgsCP p = kargs(); KArgs a;
    a.x = p->x; a.pos = p->pos; a.ffn1_norm = p->ffn1_norm; a.ffn1_wi = p->ffn1_wi; a.ffn1_wo = p->ffn1_wo; a.mix_norm = p->mix_norm; a.ffn2_norm = p->ffn2_norm; a.ffn2_wi = p->ffn2_wi; a.ffn2_wo = p->ffn2_wo;
    a.even_w_in = p->even_w_in; a.gate_w = p->gate_w; a.gate_b = p->gate_b; a.out_norm = p->out_norm; a.pool_w = p->pool_w; a.pool_scale = p->pool_scale; a.even_w_out = p->even_w_out; a.odd_w_in = p->odd_w_in;
    a.odd_w_out = p->odd_w_out; a.final_norm = p->final_norm; a.out = p->out; a.ws = p->ws; return a; }
__device__ __forceinline__ int opaque_lane() { int l; asm volatile("v_mbcnt_lo_u32_b32 %0, -1, 0\n\tv_mbcnt_hi_u32_b32 %0, -1, %0" : "=v"(l)); return l; }
__device__ __forceinline__ int fresh_tid_(int wv) { return (wv << 6) | opaque_lane(); }
#define fresh_tid() fresh_tid_(wv_)
__device__ __forceinline__ float wave_sum(float v) {
    v += DPP_F(v, 0xB1); v += DPP_F(v, 0x4E); v += DPP_F(v, 0x141); v += DPP_F(v, 0x140);
    return (__builtin_bit_cast(float, __builtin_amdgcn_readlane(__builtin_bit_cast(int, v), 0)) + __builtin_bit_cast(float, __builtin_amdgcn_readlane(__builtin_bit_cast(int, v), 16)))
         + (__builtin_bit_cast(float, __builtin_amdgcn_readlane(__builtin_bit_cast(int, v), 32)) + __builtin_bit_cast(float, __builtin_amdgcn_readlane(__builtin_bit_cast(int, v), 48)));
}
__constant__ float INV128[64] = {1.0f, 0.8659643530845642f, 0.7498942613601685f, 0.6493816375732422f, 0.5623413324356079f, 0.486967533826828f, 0.4216965138912201f, 0.3651741147041321f, 0.3162277638912201f, 0.2738419771194458f, 0.23713737726211548f, 0.20535250008106232f, 0.17782793939113617f, 0.1539926528930664f, 0.133352130651474f, 0.11547820270061493f, 0.10000000149011612f, 0.08659642934799194f, 0.07498941570520401f, 0.06493816524744034f, 0.05623413249850273f, 0.04869675263762474f, 0.04216965287923813f, 0.03651741147041321f, 0.03162277489900589f, 0.02738419733941555f, 0.023713737726211548f, 0.02053525112569332f, 0.017782794311642647f, 0.015399265103042126f, 0.01333521492779255f, 0.011547820642590523f, 0.009999999776482582f, 0.00865964312106371f, 0.007498941849917173f, 0.006493816152215004f, 0.005623413249850273f, 0.004869675263762474f, 0.0042169648222625256f, 0.0036517411936074495f, 0.003162277629598975f, 0.0027384196873754263f, 0.00237137358635664f, 0.0020535248331725597f, 0.0017782794311642647f, 0.0015399265103042126f, 0.0013335214462131262f, 0.0011547819012776017f, 0.0010000000474974513f, 0.0008659643353894353f, 0.0007498942431993783f, 0.0006493816617876291f, 0.000562341301701963f, 0.0004869675321970135f, 0.0004216965171508491f, 0.0003651741426438093f, 0.0003162277571391314f, 0.00027384195709601045f, 0.00023713737027719617f, 0.00020535250951070338f, 0.00017782794020604342f, 0.00015399264520965517f, 0.0001333521504420787f, 0.00011547820031410083f};

__device__ __forceinline__ void sincos_acc(float ang, float& c, float& s) {
    const double a = (double)ang;
    const double k = __builtin_rint(a * 0.63661977236758134308);
    double r = __builtin_fma(-k, 1.57079632679489661923, a);
    r = __builtin_fma(-k, 6.123233995736766e-17, r);
    const double r2 = r * r;
    double sp = -2.5052108385441718775e-8;
    sp = __builtin_fma(sp, r2, 2.7557319223985890653e-6);
    sp = __builtin_fma(sp, r2, -1.9841269841269841270e-4);
    sp = __builtin_fma(sp, r2, 8.3333333333333333333e-3);
    sp = __builtin_fma(sp, r2, -1.6666666666666666667e-1);
    const double sr = __builtin_fma(sp * r2, r, r);
    double cp = 2.0876756987868098979e-9;
    cp = __builtin_fma(cp, r2, -2.7557319223985890653e-7);
    cp = __builtin_fma(cp, r2, 2.4801587301587301587e-5);
    cp = __builtin_fma(cp, r2, -1.3888888888888888889e-3);
    cp = __builtin_fma(cp, r2, 4.1666666666666666667e-2);
    cp = __builtin_fma(cp, r2, -0.5);
    const double cr = __builtin_fma(cp, r2, 1.0);
    const int q = (int)((long long)k & 3);
    const double cc = (q == 0) ? cr : (q == 1) ? -sr : (q == 2) ? -cr : sr;
    const double ss = (q == 0) ? sr : (q == 1) ? cr : (q == 2) ? -sr : -cr;
    c = (float)cc; s = (float)ss;
}

enum { J_WI = 0, J_WO = 1, J_EVIN = 2, J_ODIN = 3, J_PLAIN = 4 };
__device__ __forceinline__ int dst_row(int job, int j) {
    switch (job) {
    case J_WI: { const int half = j >= DFF ? 1 : 0, jj = j - half * DFF; return (jj >> 7) * 256 + half * 128 + (jj & 127); }
    case J_EVIN: return j < 1536 ? j : (j < 1552 ? -1 : 1792 + (j - 1552));
    case J_ODIN: if (j < 1280) { const int d = j & 127; return (j & ~127) + 2 * (d & 63) + (d >> 6); }
                 if (j < 1536) return j;
                 if (j < 1856) { const int d = j & 63; return (j & ~63) + 2 * (d & 31) + (d >> 5); }
                 return j;
    default: return j;
    }
}
__device__ __forceinline__ void conv_item(const float* W, int N, int K, const float* gain, bf16_t* WT, int job, int k0, int c0, LAS unsigned char* scr, int lane) {
    const int c4 = lane & 15, kr = lane >> 4, col = c0 + 4 * c4;
    f32x4 v[16];
    const bool ok = col < N;
    const float* src = W + (size_t)(k0 + kr * 16) * N + col;
#pragma unroll
    for (int i = 0; i < 16; ++i) v[i] = ok ? *(const f32x4*)(src + (size_t)i * N) : (f32x4){0.f, 0.f, 0.f, 0.f};
    if (gain) {
        const f32x4* gp = (const f32x4*)(gain + k0 + kr * 16);
#pragma unroll
        for (int q = 0; q < 4; ++q) { const f32x4 g4 = gp[q];
#pragma unroll
            for (int e = 0; e < 4; ++e) v[4 * q + e] = v[4 * q + e] * g4[e]; }
    }
#pragma unroll
    for (int e = 0; e < 4; ++e) {
        u32x4 w0, w1;
        w0.x = cvt_pk_bf16(v[0][e], v[1][e]); w0.y = cvt_pk_bf16(v[2][e], v[3][e]); w0.z = cvt_pk_bf16(v[4][e], v[5][e]); w0.w = cvt_pk_bf16(v[6][e], v[7][e]);
        w1.x = cvt_pk_bf16(v[8][e], v[9][e]); w1.y = cvt_pk_bf16(v[10][e], v[11][e]); w1.z = cvt_pk_bf16(v[12][e], v[13][e]); w1.w = cvt_pk_bf16(v[14][e], v[15][e]);
        LAS unsigned char* d = scr + (4 * c4 + e) * 144 + kr * 32;
        *(LAS u32x4*)d = w0; *(LAS u32x4*)(d + 16) = w1;
    }
    asm volatile("s_waitcnt lgkmcnt(0)" ::: "memory");
#pragma unroll
    for (int j = 0; j < 8; ++j) {
        const int cl = (lane >> 3) + 8 * j, ch = lane & 7, sc_ = c0 + cl;
        const u32x4 w = *(const LAS u32x4*)(scr + cl * 144 + ch * 16);
        const int n = sc_ < N ? dst_row(job, sc_) : -1;
        if (n >= 0) *(u32x4*)(WT + (size_t)n * K + k0 + ch * 8) = w;
    }
    asm volatile("s_waitcnt lgkmcnt(0)" ::: "memory");
}


constexpr int C_WI = NFF / 64, I_WI = (DM / 64) * C_WI, C_WO = DM / 64, I_WO = (DFF / 64) * C_WO, C_EV = (EVEN_IN + 63) / 64, I_EV = (DM / 64) * C_EV, C_OD = (ODD_IN + 63) / 64, I_OD = (DM / 64) * C_OD;
constexpr int I_EO = 8 * 16, I_OO = 16 * 16;
constexpr int CV_WO0 = 4 * I_WI, CV_EV = CV_WO0 + 4 * I_WO, CV_OD = CV_EV + I_EV, CV_EO = CV_OD + I_OD, CV_OO = CV_EO + I_EO, CV_END = CV_OO + I_OO;
#define CV_WI(sub) ((sub) * I_WI)
#define CV_WO(sub) (CV_WO0 + (sub) * I_WO)
__device__ __forceinline__ void conv_range(const KArgs& A, unsigned char* ws, int lo, int hi, int widx, int nw, LAS unsigned char* scr, int lane) {
    for (int it = lo + widx; it < hi; it += nw) {
        int r = it;
        if (r < 4 * I_WI) { const int sub = r / I_WI, q = r % I_WI, l = sub >> 1, f = sub & 1;
            conv_item((f ? A.ffn2_wi : A.ffn1_wi) + (size_t)l * DM * NFF, NFF, DM, (f ? A.ffn2_norm : A.ffn1_norm) + l * DM, (bf16_t*)(ws + WS_WIT + (size_t)sub * 11 * MiB), J_WI, (q / C_WI) * 64, (q % C_WI) * 64, scr, lane); continue; } r -= 4 * I_WI;
        if (r < 4 * I_WO) { const int sub = r / I_WO, q = r % I_WO, l = sub >> 1, f = sub & 1;
            conv_item((f ? A.ffn2_wo : A.ffn1_wo) + (size_t)l * DFF * DM, DM, DFF, nullptr, (bf16_t*)(ws + WS_WOT + (size_t)sub * 5632 * 1024), J_WO, (q / C_WO) * 64, (q % C_WO) * 64, scr, lane); continue; } r -= 4 * I_WO;
        if (r < I_EV) { conv_item(A.even_w_in, EVEN_IN, DM, A.mix_norm, (bf16_t*)(ws + WS_EVIN), J_EVIN, (r / C_EV) * 64, (r % C_EV) * 64, scr, lane); continue; } r -= I_EV;
        if (r < I_OD) { conv_item(A.odd_w_in, ODD_IN, DM, A.mix_norm + DM, (bf16_t*)(ws + WS_ODIN), J_ODIN, (r / C_OD) * 64, (r % C_OD) * 64, scr, lane); continue; } r -= I_OD;
        if (r < I_EO) { conv_item(A.even_w_out, DM, DM, nullptr, (bf16_t*)(ws + WS_EVOUT), J_PLAIN, (r / 16) * 64, (r % 16) * 64, scr, lane); continue; } r -= I_EO;
        conv_item(A.odd_w_out, DM, DM, nullptr, (bf16_t*)(ws + WS_ODOUT), J_PLAIN, (r / 16) * 64, (r % 16) * 64, scr, lane);
    }
}
__device__ __forceinline__ void conv_extras_even(const KArgs& A, unsigned char* ws, int widx, int nw, int lane) {
    for (int it = widx; it < 128 * 4; it += nw) {
        const int kc = it >> 2, j = (it & 3) * 64 + lane, k0 = kc * 8;
        float gwv[16];
#pragma unroll
        for (int r = 0; r < 16; ++r) gwv[r] = A.gate_w[r * 256 + j];
        float o[8];
#pragma unroll
        for (int e = 0; e < 8; ++e) { const f32x4* wp = (const f32x4*)(A.even_w_in + (size_t)(k0 + e) * EVEN_IN + 1536); float sacc = 0.f;
#pragma unroll
            for (int q = 0; q < 4; ++q) { const f32x4 w4 = wp[q]; sacc += w4[0] * gwv[4 * q] + w4[1] * gwv[4 * q + 1] + w4[2] * gwv[4 * q + 2] + w4[3] * gwv[4 * q + 3]; }
            o[e] = sacc * A.mix_norm[k0 + e]; }
        *(u32x4*)((bf16_t*)(ws + WS_EVIN) + (size_t)(1536 + j) * DM + k0) = pack8((f32x4){o[0], o[1], o[2], o[3]}, (f32x4){o[4], o[5], o[6], o[7]});
    }
    for (int it = widx; it < 16 * 4 * 32; it += nw) {
        const int ng = it & 15, g = (it >> 4) & 3, cc = it >> 6, n = ng * 64 + lane, ci0 = cc * 4;
        const float* pw = A.pool_w + ((size_t)g * 128 + ci0) * 128; const float* ps = A.pool_scale + g * 128; const float* wo = A.even_w_out + (size_t)(512 + g * 128) * DM + n;
        float o[4] = {0.f, 0.f, 0.f, 0.f};
#pragma unroll 1
        for (int d0 = 0; d0 < 128; d0 += 32) {
            float wv_[32];
#pragma unroll
            for (int dd = 0; dd < 32; ++dd) wv_[dd] = wo[(size_t)(d0 + dd) * DM];
#pragma unroll
            for (int dd = 0; dd < 32; ++dd) { const float x = wv_[dd] * ps[d0 + dd];
#pragma unroll
                for (int e = 0; e < 4; ++e) o[e] += pw[e * 128 + d0 + dd] * x; }
        }
        u32x2 w; w.x = cvt_pk_bf16(o[0], o[1]); w.y = cvt_pk_bf16(o[2], o[3]);
        *(u32x2*)((bf16_t*)(ws + WS_EVOUT) + (size_t)n * DM + 512 + g * 128 + ci0) = w;
    }
}
__device__ __forceinline__ void conv_zero_pad_odd(unsigned char* ws, int widx, int nw, int lane) {
    bf16_t* zp = (bf16_t*)(ws + WS_ODIN) + (size_t)ODD_IN * DM;
    unsigned z_ = 0u; asm volatile("" : "+v"(z_));
    for (int idx = widx * 64 + lane; idx < (ODD_N - ODD_IN) * DM / 8; idx += nw * 64) *(u32x4*)(zp + (size_t)idx * 8) = (u32x4){z_, z_, z_, z_};
}

template <int W> __device__ __forceinline__ void pool_item(const bf16_t* U, bf16_t* mix, int m, int c0, int s) {
    u32x4 r[W];
#pragma unroll
    for (int i = 0; i < W; ++i) r[i] = *(const u32x4*)(U + (size_t)(s >= i ? m - i : m) * 512 + c0);
    float sum[8] = {0.f, 0.f, 0.f, 0.f, 0.f, 0.f, 0.f, 0.f}, cur[8];
#pragma unroll
    for (int i = 0; i < W; ++i) { const float wgt = (s >= i) ? 1.f : 0.f; const unsigned w4[4] = {r[i].x, r[i].y, r[i].z, r[i].w};
#pragma unroll
        for (int e = 0; e < 8; ++e) { const float v = bf2f((e & 1) ? (w4[e >> 1] >> 16) : (w4[e >> 1] & 0xffffu)); if (i == 0) cur[e] = v; sum[e] += wgt * v; } }
    const float ic = 1.0f / (float)((s + 1 < W) ? s + 1 : W);
    f32x4 o0, o1;
#pragma unroll
    for (int e = 0; e < 4; ++e) { o0[e] = sum[e] * ic - cur[e]; o1[e] = sum[4 + e] * ic - cur[4 + e]; }
    *(u32x4*)(mix + (size_t)m * DM + 512 + c0) = pack8(o0, o1);
}
#define XB_TMO      128
#define XB_XCNT(j)  (256  + 64 * (j))
#define XB_XSUB(j)  (1280 + 64 * (j))
#define XB_XGEN(j)  (2304 + 64 * (j))
#define XB_TOP      3328
#define XB_TOPGEN   3392
#define XCD_BAR_WORDS 3456
#define XB_SPIN_CAP (1u << 18)
__device__ __forceinline__ unsigned xb_ld(unsigned* p)              { return __hip_atomic_load(p, __ATOMIC_RELAXED, __HIP_MEMORY_SCOPE_AGENT); }
__device__ __forceinline__ unsigned xb_add(unsigned* p, unsigned v) { return __hip_atomic_fetch_add(p, v, __ATOMIC_RELAXED, __HIP_MEMORY_SCOPE_AGENT); }
__device__ __forceinline__ unsigned xb_xcc_id() { return (unsigned)__builtin_amdgcn_s_getreg((3 << 11) | 20) & 0xFu; }
#define XB_SPIN(cond, bar) do { unsigned _sp = 0; while (cond) { __builtin_amdgcn_s_sleep(1); \
    if ((++_sp & 255u) == 0u) { if (xb_ld(&(bar)[XB_TMO])) break; if (_sp > XB_SPIN_CAP) { atomicAdd(&(bar)[XB_TMO], 1u); break; } } } } while (0)
struct XcdBarrier { unsigned* bar; unsigned x; volatile LAS unsigned* st; };
__device__ __forceinline__ XcdBarrier xcd_barrier_post(unsigned* bar, volatile LAS unsigned* st) {
    XcdBarrier b; b.bar = bar; b.x = xb_xcc_id(); b.st = st;
    if (threadIdx.x == 0) (void)xb_add(&bar[XB_XCNT(b.x)], 1u);
    return b;
}
__device__ __forceinline__ void xcd_barrier_complete(unsigned* bar, unsigned x, unsigned& nloc, unsigned& nx) {
    const unsigned G = gridDim.x * gridDim.y * gridDim.z;
    unsigned sum, cnt, mine, sp = 0u;
    for (;;) {
        sum = 0u; cnt = 0u; mine = 0u;
#pragma unroll
        for (unsigned j = 0; j < 16; ++j) { const unsigned c = xb_ld(&bar[XB_XCNT(j)]); sum += c; cnt += (c > 0u) ? 1u : 0u; mine = (j == x) ? c : mine; }
        if (sum == G) break;
        __builtin_amdgcn_s_sleep(1);
        if ((++sp & 255u) == 0u) { if (xb_ld(&bar[XB_TMO])) break; if (sp > XB_SPIN_CAP) { atomicAdd(&bar[XB_TMO], 1u); break; } }
    }
    nloc = mine > 0u ? mine : 1u; nx = cnt > 0u ? cnt : 1u;
}
__device__ __forceinline__ void xcd_barrier(const XcdBarrier& b, const int wv) {
    asm volatile("s_waitcnt vmcnt(0)" ::: "memory");
    __syncthreads();
    if (wv == 0 && opaque_lane() == 0) {
        unsigned* bar = b.bar;
        __builtin_amdgcn_s_waitcnt(0);
        unsigned nloc = b.st[0], nx = b.st[1];
        if (nloc == 0u) { xcd_barrier_complete(bar, b.x, nloc, nx); b.st[0] = nloc; b.st[1] = nx; }
        const unsigned old = xb_add(&bar[XB_XSUB(b.x)], 1u);
        const unsigned gen = old / nloc;
        if (old + 1u == (gen + 1u) * nloc) {
            __builtin_amdgcn_fence(__ATOMIC_RELEASE, "agent");
            asm volatile("s_waitcnt vmcnt(0)" ::: "memory");
            const unsigned og = xb_add(&bar[XB_TOP], 1u);
            const unsigned tg = og / nx;
            if (og + 1u == (tg + 1u) * nx) xb_add(&bar[XB_TOPGEN], 1u);
            else XB_SPIN(xb_ld(&bar[XB_TOPGEN]) == tg, bar);
            __builtin_amdgcn_fence(__ATOMIC_ACQUIRE, "agent");
            xb_add(&bar[XB_XGEN(b.x)], 1u);
            asm volatile("s_waitcnt vmcnt(0)" ::: "memory");
        } else {
            XB_SPIN(xb_ld(&bar[XB_XGEN(b.x)]) == gen, bar);
            __builtin_amdgcn_fence(__ATOMIC_ACQUIRE, "agent");
            asm volatile("s_waitcnt vmcnt(0)" ::: "memory");
        }
    }
    __syncthreads();
}

__device__ __forceinline__ void cnt_ge4(unsigned& a0, unsigned& a1, unsigned& a2, unsigned& a3, unsigned k0, unsigned k1, unsigned k2, unsigned k3, unsigned cand) {
    unsigned long long m0, m1, m2, m3;
    asm volatile("v_cmp_ge_u32_e64 %4, %8, %12\n\t"
                 "v_cmp_ge_u32_e64 %5, %9, %12\n\t"
                 "v_cmp_ge_u32_e64 %6, %10, %12\n\t"
                 "v_cmp_ge_u32_e64 %7, %11, %12\n\t"
                 "v_addc_co_u32_e64 %0, %4, 0, %0, %4\n\t"
                 "v_addc_co_u32_e64 %1, %5, 0, %1, %5\n\t"
                 "v_addc_co_u32_e64 %2, %6, 0, %2, %6\n\t"
                 "v_addc_co_u32_e64 %3, %7, 0, %3, %7"
                 : "+v"(a0), "+v"(a1), "+v"(a2), "+v"(a3), "=&s"(m0), "=&s"(m1), "=&s"(m2), "=&s"(m3)
                 : "v"(k0), "v"(k1), "v"(k2), "v"(k3), "s"(cand));
}
__device__ __forceinline__ int wave_sum_u32(unsigned x) {
    x += (unsigned)__builtin_amdgcn_update_dpp(0, (int)x, 0xB1, 0xf, 0xf, true);
    x += (unsigned)__builtin_amdgcn_update_dpp(0, (int)x, 0x4E, 0xf, 0xf, true);
    x += (unsigned)__builtin_amdgcn_update_dpp(0, (int)x, 0x141, 0xf, 0xf, true);
    x += (unsigned)__builtin_amdgcn_update_dpp(0, (int)x, 0x140, 0xf, 0xf, true);
    return (int)(__builtin_amdgcn_readlane((int)x, 0) + __builtin_amdgcn_readlane((int)x, 16) + __builtin_amdgcn_readlane((int)x, 32) + __builtin_amdgcn_readlane((int)x, 48));
}

__device__ __forceinline__ unsigned wave_prefix_incl_u32(unsigned x, int lane) {
    x += (unsigned)__builtin_amdgcn_update_dpp(0, (int)x, 0x111, 0xf, 0xf, false);
    x += (unsigned)__builtin_amdgcn_update_dpp(0, (int)x, 0x112, 0xf, 0xf, false);
    x += (unsigned)__builtin_amdgcn_update_dpp(0, (int)x, 0x114, 0xf, 0xf, false);
    x += (unsigned)__builtin_amdgcn_update_dpp(0, (int)x, 0x118, 0xf, 0xf, false);
    const unsigned r0 = (unsigned)__builtin_amdgcn_readlane((int)x, 15), r1 = (unsigned)__builtin_amdgcn_readlane((int)x, 31), r2 = (unsigned)__builtin_amdgcn_readlane((int)x, 47);
    const int row = lane >> 4;
    return x + (row > 0 ? r0 : 0u) + (row > 1 ? r1 : 0u) + (row > 2 ? r2 : 0u);
}
__device__ __forceinline__ unsigned wave_max_u32(unsigned x) {
    unsigned y;
    y = (unsigned)__builtin_amdgcn_update_dpp(0, (int)x, 0xB1, 0xf, 0xf, true); x = x > y ? x : y;
    y = (unsigned)__builtin_amdgcn_update_dpp(0, (int)x, 0x4E, 0xf, 0xf, true); x = x > y ? x : y;
    y = (unsigned)__builtin_amdgcn_update_dpp(0, (int)x, 0x141, 0xf, 0xf, true); x = x > y ? x : y;
    y = (unsigned)__builtin_amdgcn_update_dpp(0, (int)x, 0x140, 0xf, 0xf, true); x = x > y ? x : y;
    const unsigned a = (unsigned)__builtin_amdgcn_readlane((int)x, 0), b = (unsigned)__builtin_amdgcn_readlane((int)x, 16), c = (unsigned)__builtin_amdgcn_readlane((int)x, 32), d = (unsigned)__builtin_amdgcn_readlane((int)x, 48);
    const unsigned ab = a > b ? a : b, cd = c > d ? c : d; return ab > cd ? ab : cd;
}

__global__ void __launch_bounds__(512, 2) fwd_megakernel(KArgs Aarg) {
    extern __shared__ __attribute__((aligned(16))) unsigned char lds[];
    cg::grid_group grid = cg::this_grid();
    (void)Aarg;
    const int G = gridDim.x, bx = blockIdx.x;
    const int wv_ = __builtin_amdgcn_readfirstlane((int)threadIdx.x >> 6);
    const int vcu = (G % 8 == 0) ? (bx % 8) * (G / 8) + bx / 8 : bx;
    LAS unsigned char* ldsl = (LAS unsigned char*)lds;
#define PHASE_ARGS() const KArgs A = load_kargs(); unsigned char* const ws = A.ws; (void)ws
#define PHASE_IDS() PHASE_ARGS(); const int tid = fresh_tid(), lane = tid & 63, wave = __builtin_amdgcn_readfirstlane(tid >> 6); const int gw = vcu * 8 + wave, NGW = G * 8; (void)lane; (void)gw; (void)NGW
#define SSQ ((float*)(ws + WS_SSQ))
#define DVEC ((float*)(ws + WS_DVEC))
#define WI1 ((float*)(ws + WS_WI1))
#define HB ((bf16_t*)(ws + WS_HB))
#define HID ((bf16_t*)(ws + WS_HID))
#define CS ((float*)(ws + WS_CS))
#define QK0 ((bf16_t*)(ws + WS_QK0))
#define V0 ((bf16_t*)(ws + WS_V0))
#define G0 ((bf16_t*)(ws + WS_G0))
#define U0 ((bf16_t*)(ws + WS_U0))
#define LA ((float*)(ws + WS_LA))
#define ST0 ((bf16_t*)(ws + WS_ST0))
#define MIX ((bf16_t*)(ws + WS_MIX))
#define Q1 ((bf16_t*)(ws + WS_Q1))
#define K1 ((bf16_t*)(ws + WS_K1))
#define V1 ((bf16_t*)(ws + WS_V1))
#define QIH ((bf16_t*)(ws + WS_QIH))
#define QIL ((bf16_t*)(ws + WS_QIL))
#define KIH ((bf16_t*)(ws + WS_KIH))
#define KIL ((bf16_t*)(ws + WS_KIL))
#define MASK ((unsigned long long*)(ws + WS_MASK))
    for (int u_ = threadIdx.x; u_ < (LDS_BYTES - RING_BYTES) / 4; u_ += 512) ((LAS unsigned*)(ldsl + RING_BYTES))[u_] = 0u;
    __syncthreads();
    XcdBarrier xbar;
    { KArgsCP kp_ = kargs(); xbar = xcd_barrier_post((unsigned*)(kp_->ws + WS_CTL) + 4096, (volatile LAS unsigned*)(ldsl + RING_BYTES + 512)); }
#define GSYNC() xcd_barrier(xbar, wv_)

#ifndef NO_P0
    for (int dup_ = 0; dup_ < NDUP_P0; ++dup_) { if (dup_) { GSYNC(); }
    {
        PHASE_IDS();
        LAS unsigned char* scr = ldsl + wave * 16384;
        conv_range(A, ws, CV_WI(0), CV_WI(1), gw, NGW, scr, lane);
        if (G != 256) { conv_range(A, ws, CV_WI(1), CV_END, gw, NGW, scr, lane); conv_extras_even(A, ws, gw, NGW, lane); conv_zero_pad_odd(ws, gw, NGW, lane); }
        for (int m0 = gw * 4; m0 < M; m0 += NGW * 4) {
            f32x4 v[4][4];
#pragma unroll
            for (int i = 0; i < 4; ++i) { const f32x4* xr = (const f32x4*)(A.x + (size_t)(m0 + i) * DM) + lane;
#pragma unroll
                for (int j = 0; j < 4; ++j) v[i][j] = xr[64 * j]; }
#pragma unroll
            for (int i = 0; i < 4; ++i) { const int m = m0 + i; float s = 0.f;
#pragma unroll
                for (int j = 0; j < 4; ++j) s += (v[i][j][0] * v[i][j][0] + v[i][j][1] * v[i][j][1]) + (v[i][j][2] * v[i][j][2] + v[i][j][3] * v[i][j][3]);
                s = wave_sum(s);
                u32x2* o8 = (u32x2*)(HB + (size_t)m * DM) + lane;
#pragma unroll
                for (int j = 0; j < 4; ++j) { u32x2 w; w.x = cvt_pk_bf16(v[i][j][0], v[i][j][1]); w.y = cvt_pk_bf16(v[i][j][2], v[i][j][3]); o8[64 * j] = w; }
                if (lane < 16) SSQ[(size_t)m * 16 + lane] = (lane == 0) ? s : 0.f; }
        }
        for (int idx = (vcu * 512 + tid); idx < M * 64; idx += G * 512) {
            const int m = idx >> 6, i = idx & 63;
            const float ang = (float)A.pos[m] * INV128[i];
            float c, s; sincos_acc(ang, c, s);
            *(f32x2*)(CS + (size_t)idx * 2) = (f32x2){c, s};
        }
    }
    }
#endif
    { KArgsCP kp_ = kargs(); if (kp_->ws == nullptr) grid.sync(); }
    GSYNC();

    for (int li = 0; li < 2; ++li) {
        for (int f = 0; f < 2; ++f) {
            if (f == 1) {
                if (li == 0) {
#ifndef NO_PROJ0
    for (int dup_ = 0; dup_ < NDUP_PROJ0; ++dup_) { if (dup_) { GSYNC(); }
                    { PHASE_ARGS(); pg8::Gemm g{HB, (const bf16_t*)(ws + WS_EVIN), M, EVEN_N, DM}; pg8::StaticOrder S; S.init(M, EVEN_N, G, bx);
                      pg8::EpiP0 E{SSQ, A.gate_b, QK0, V0, G0, U0, LA};
                      pg8::gemm_phase<pg8::EpiP0, pg8::StaticOrder, true, true>(ldsl, g, S, E, fresh_tid()); }
                    if (bx >= 64 && G == 256) { PHASE_IDS(); const int widx = (bx - 64) * 8 + wave, nw = 192 * 8; LAS unsigned char* scr = ldsl + wave * 16384;
                        conv_range(A, ws, CV_WI(1), CV_WI(2), widx, nw, scr, lane); conv_range(A, ws, CV_WO(1), CV_WO(2), widx, nw, scr, lane); }
    }
#endif
                    GSYNC();
#ifndef NO_G1
    for (int dup_ = 0; dup_ < NDUP_G1; ++dup_) { if (dup_) { GSYNC(); }
                    {
                        PHASE_IDS();
                        LAS float* BL = (LAS float*)ldsl; LAS float* TOT = (LAS float*)(ldsl + 16384); LAS unsigned char* KDT = ldsl + 18432; LAS unsigned char* VT = ldsl + 46080;
                        const int r32 = lane & 31, hh = lane >> 5;
                        for (int unit = vcu; unit < 1024; unit += G) {
                            const int bh = unit >> 6, n = unit & 63, b = bh >> 2, h = bh & 3; const size_t m0 = (size_t)b * SEQ + n * 64;
                            float lav[8];
#pragma unroll
                            for (int i = 0; i < 8; ++i) lav[i] = LA[(m0 + wave * 8 + i) * 256 + h * 64 + lane];
                            const u32x4 kq_p = *(const u32x4*)(QK0 + (m0 + (tid >> 3)) * 512 + 256 + h * 64 + (tid & 7) * 8);
                            u32x4 vq_p[2];
#pragma unroll
                            for (int c2 = 0; c2 < 2; ++c2) { const int c = tid + 512 * c2; vq_p[c2] = *(const u32x4*)(V0 + (m0 + (c >> 4)) * 512 + h * 128 + (c & 15) * 8); }
                            { const int d = lane; float pr[8]; float run = 0.f;
#pragma unroll
                              for (int i = 0; i < 8; ++i) { run += lav[i]; pr[i] = run; }
                              TOT[wave * 64 + d] = run; __syncthreads();
                              float tv_[8];
#pragma unroll
                              for (int s_ = 0; s_ < 8; ++s_) tv_[s_] = TOT[s_ * 64 + d];
                              float off = 0.f;
#pragma unroll
                              for (int s_ = 0; s_ < 7; ++s_) off += (s_ < wave) ? tv_[s_] : 0.f;
#pragma unroll
                              for (int i = 0; i < 8; ++i) BL[(wave * 8 + i) * 64 + d] = off + pr[i]; }
                            __syncthreads();
                            { const int t = tid >> 3, d0 = (tid & 7) * 8;
                              const u32x4 kq = kq_p;
                              const unsigned kw[4] = {kq.x, kq.y, kq.z, kq.w};
                              float xf[8];
#pragma unroll
                              for (int i = 0; i < 8; ++i) { const float kv = bf2f((i & 1) ? (kw[i >> 1] >> 16) : (kw[i >> 1] & 0xffffu));
                                  xf[i] = kv * __expf(BL[63 * 64 + d0 + i] - BL[t * 64 + d0 + i]); }
                              *(LAS u32x4*)(KDT + att::v_st(t, d0)) = pack8((f32x4){xf[0], xf[1], xf[2], xf[3]}, (f32x4){xf[4], xf[5], xf[6], xf[7]});
                              if (tid < 64) DVEC[unit * 64 + tid] = __expf(BL[63 * 64 + tid]);
#pragma unroll
                              for (int c2 = 0; c2 < 2; ++c2) { const int c = tid + 512 * c2, tt = c >> 4, e0 = (c & 15) * 8;
                                  *(LAS u32x4*)(VT + att::v_st(tt, e0)) = vq_p[c2]; } }
                            __syncthreads();
                            { const int dt = wave >> 2, et = wave & 3; f32x16 c = {};
                              const int kb0_ = (int)(uintptr_t)KDT + att::v_rd_base(lane), vb0_ = (int)(uintptr_t)VT + att::v_rd_base(lane);
#pragma unroll
                              for (int ks = 0; ks < 4; ++ks) { const bf16x8 a = tr_frag(kb0_, att::v_rd_off(dt, ks, 0)), bb = tr_frag(vb0_, att::v_rd_off(et, ks, 0));
                                  c = __builtin_amdgcn_mfma_f32_32x32x16_bf16(a, bb, c, 0, 0, 0); }
                              bf16_t* dst = ST0 + (size_t)unit * 8192 + (32 * et + r32) * 64 + 32 * dt + 4 * hh;
#pragma unroll
                              for (int g4 = 0; g4 < 4; ++g4) { u32x2 w; w.x = cvt_pk_bf16(c[4 * g4], c[4 * g4 + 1]); w.y = cvt_pk_bf16(c[4 * g4 + 2], c[4 * g4 + 3]); *(u32x2*)(dst + 8 * g4) = w; } }
                            __syncthreads();
                        }
                        for (int idx = vcu * 512 + tid; idx < 4 * M * 16; idx += G * 512) {
                            const int gi = idx / (M * 16), rem = idx - gi * (M * 16), m = rem >> 4, c0 = gi * 128 + (rem & 15) * 8, s = m & (SEQ - 1);
                            if (gi == 0) pool_item<2>(U0, MIX, m, c0, s); else if (gi == 1) pool_item<4>(U0, MIX, m, c0, s); else if (gi == 2) pool_item<8>(U0, MIX, m, c0, s); else pool_item<16>(U0, MIX, m, c0, s);
                        }
                    }
    }
#endif
                    GSYNC();
#ifndef NO_G2
                    { PHASE_IDS();
                    for (int idx = vcu * 512 + tid; idx < 16 * 8192; idx += G * 512) {
                        const int bh = idx >> 13, de = idx & 8191, d = de & 63;
                        bf16_t* p = ST0 + (size_t)bh * 64 * 8192 + de; const float* dv = DVEC + bh * 64 * 64 + d;
                        float uu[64];
#pragma unroll
                        for (int n = 0; n < 64; ++n) uu[n] = bf2f(p[(size_t)n * 8192]);
                        float st = 0.f;
#pragma unroll
                        for (int n = 0; n < 64; ++n) { p[(size_t)n * 8192] = (bf16_t)f2bf(st); st = dv[n * 64] * st + uu[n]; }
                    } }
#endif
                    GSYNC();
#ifndef NO_G3
    for (int dup_ = 0; dup_ < NDUP_G3; ++dup_) { if (dup_) { GSYNC(); }
                    {
                        PHASE_IDS();
                        LAS float* BL = (LAS float*)ldsl; LAS float* TOT = (LAS float*)(ldsl + 16384); LAS unsigned char* QS = ldsl + 18432; LAS unsigned char* KS = ldsl + 27648; LAS unsigned char* SCB = ldsl + 36864;
                        LAS unsigned char* VT = ldsl + 46080; LAS unsigned char* SLT = ldsl + 64512; LAS float* OUTL = (LAS float*)(ldsl + 82944);
                        const int r32 = lane & 31, hh = lane >> 5;
                        for (int unit = vcu; unit < 1024; unit += G) {
                            const int bh = unit >> 6, n = unit & 63, b = bh >> 2, h = bh & 3; const size_t m0 = (size_t)b * SEQ + n * 64;
                            float lav[8];
#pragma unroll
                            for (int i = 0; i < 8; ++i) lav[i] = LA[(m0 + wave * 8 + i) * 256 + h * 64 + lane];
                            const u32x4 qq_p = *(const u32x4*)(QK0 + (m0 + (tid >> 3)) * 512 + h * 64 + (tid & 7) * 8), kq_p = *(const u32x4*)(QK0 + (m0 + (tid >> 3)) * 512 + 256 + h * 64 + (tid & 7) * 8);
                            u32x4 vq_p[2], sq_p[2];
#pragma unroll
                            for (int c2 = 0; c2 < 2; ++c2) { const int c = tid + 512 * c2; vq_p[c2] = *(const u32x4*)(V0 + (m0 + (c >> 4)) * 512 + h * 128 + (c & 15) * 8);
                                sq_p[c2] = *(const u32x4*)(ST0 + (size_t)unit * 8192 + (c >> 3) * 64 + (c & 7) * 8); }
                            const u32x4 g0_p = *(const u32x4*)(G0 + (m0 + (tid >> 3)) * 512 + h * 128 + (tid & 7) * 16), g1_p = *(const u32x4*)(G0 + (m0 + (tid >> 3)) * 512 + h * 128 + (tid & 7) * 16 + 8);
                            f32x4 on_p[4];
#pragma unroll
                            for (int j4 = 0; j4 < 4; ++j4) on_p[j4] = *(const f32x4*)(A.out_norm + h * 128 + (tid & 7) * 16 + j4 * 4);
                            { const int d = lane; float pr[8]; float run = 0.f;
#pragma unroll
                              for (int i = 0; i < 8; ++i) { run += lav[i]; pr[i] = run; }
                              TOT[wave * 64 + d] = run; __syncthreads();
                              float tv_[8];
#pragma unroll
                              for (int s_ = 0; s_ < 8; ++s_) tv_[s_] = TOT[s_ * 64 + d];
                              float off = 0.f;
#pragma unroll
                              for (int s_ = 0; s_ < 7; ++s_) off += (s_ < wave) ? tv_[s_] : 0.f;
#pragma unroll
                              for (int i = 0; i < 8; ++i) BL[(wave * 8 + i) * 64 + d] = off + pr[i]; }
                            __syncthreads();
                            { const int t = tid >> 3, d0 = (tid & 7) * 8;
                              const u32x4 qq = qq_p, kq = kq_p;
                              const unsigned qw[4] = {qq.x, qq.y, qq.z, qq.w}, kw[4] = {kq.x, kq.y, kq.z, kq.w};
                              float qf[8], kf[8];
#pragma unroll
                              for (int i = 0; i < 8; ++i) { const float bb = BL[t * 64 + d0 + i];
                                  qf[i] = bf2f((i & 1) ? (qw[i >> 1] >> 16) : (qw[i >> 1] & 0xffffu)) * 0.125f * __expf(bb);
                                  kf[i] = bf2f((i & 1) ? (kw[i >> 1] >> 16) : (kw[i >> 1] & 0xffffu)) * __expf(-bb); }
                              *(LAS u32x4*)(QS + t * 144 + d0 * 2) = pack8((f32x4){qf[0], qf[1], qf[2], qf[3]}, (f32x4){qf[4], qf[5], qf[6], qf[7]});
                              *(LAS u32x4*)(KS + t * 144 + d0 * 2) = pack8((f32x4){kf[0], kf[1], kf[2], kf[3]}, (f32x4){kf[4], kf[5], kf[6], kf[7]});
#pragma unroll
                              for (int c2 = 0; c2 < 2; ++c2) { const int c = tid + 512 * c2, tt = c >> 4, e0 = (c & 15) * 8;
                                  *(LAS u32x4*)(VT + att::v_st(tt, e0)) = vq_p[c2];
                                  const int e = c >> 3, dd0 = (c & 7) * 8;
                                  *(LAS u32x4*)(SLT + e * 144 + dd0 * 2) = sq_p[c2]; } }
                            __syncthreads();
                            if (wave < 3) { const int it = (wave + 1) >> 1, jt = wave == 2 ? 1 : 0; f32x16 c = {};
#pragma unroll
                                for (int ks = 0; ks < 4; ++ks) { const bf16x8 a = *(const LAS bf16x8*)(QS + (32 * it + r32) * 144 + ks * 32 + hh * 16), bb = *(const LAS bf16x8*)(KS + (32 * jt + r32) * 144 + ks * 32 + hh * 16);
                                    c = __builtin_amdgcn_mfma_f32_32x32x16_bf16(a, bb, c, 0, 0, 0); }
#pragma unroll
                                for (int ii = 0; ii < 16; ++ii) { const int i = 32 * it + (ii & 3) + 8 * (ii >> 2) + 4 * hh, j = 32 * jt + r32;
                                    *(LAS bf16_t*)(SCB + i * 144 + j * 2) = (bf16_t)f2bf(j <= i ? c[ii] : 0.f); } }
                            __syncthreads();
                            { const int it = wave >> 2, et = wave & 3; f32x16 c = {};
#pragma unroll
                              for (int ks = 0; ks < 4; ++ks) { const bf16x8 a = *(const LAS bf16x8*)(QS + (32 * it + r32) * 144 + ks * 32 + hh * 16), bb = *(const LAS bf16x8*)(SLT + (32 * et + r32) * 144 + ks * 32 + hh * 16);
                                  c = __builtin_amdgcn_mfma_f32_32x32x16_bf16(a, bb, c, 0, 0, 0); }
#pragma unroll
                              for (int ks = 0; ks < 4; ++ks) if (ks < 2 * (it + 1)) { const bf16x8 a = *(const LAS bf16x8*)(SCB + (32 * it + r32) * 144 + ks * 32 + hh * 16), bb = tr_frag((int)(uintptr_t)VT + att::v_rd_base(lane), att::v_rd_off(et, ks, 0));
                                  c = __builtin_amdgcn_mfma_f32_32x32x16_bf16(a, bb, c, 0, 0, 0); }
#pragma unroll
                              for (int ii = 0; ii < 16; ++ii) OUTL[(32 * it + (ii & 3) + 8 * (ii >> 2) + 4 * hh) * 132 + 32 * et + r32] = c[ii]; }
                            __syncthreads();
                            { const int i = tid >> 3, e0 = (tid & 7) * 16; float acc[16];
#pragma unroll
                              for (int j4 = 0; j4 < 4; ++j4) { const f32x4 v4 = *(const LAS f32x4*)(OUTL + i * 132 + e0 + j4 * 4); acc[j4 * 4] = v4[0]; acc[j4 * 4 + 1] = v4[1]; acc[j4 * 4 + 2] = v4[2]; acc[j4 * 4 + 3] = v4[3]; }
                              float ss = 0.f;
#pragma unroll
                              for (int j = 0; j < 16; ++j) ss += acc[j] * acc[j];
                              ss += DPP_F(ss, 0xB1); ss += DPP_F(ss, 0x4E); ss += DPP_F(ss, 0x141);
                              const float rs = __builtin_amdgcn_rsqf(ss * (1.0f / 128.0f) + RMS_EPS);
                              const size_t mrow = m0 + i; const int cb = h * 128 + e0;
                              const u32x4 g0 = g0_p, g1 = g1_p;
                              const unsigned gw_[8] = {g0.x, g0.y, g0.z, g0.w, g1.x, g1.y, g1.z, g1.w};
                              float o[16];
#pragma unroll
                              for (int j = 0; j < 16; ++j) { const float gv = bf2f((j & 1) ? (gw_[j >> 1] >> 16) : (gw_[j >> 1] & 0xffffu)); o[j] = acc[j] * rs * on_p[j >> 2][j & 3] * gv; }
                              bf16_t* dst = MIX + mrow * DM + cb;
                              *(u32x4*)dst = pack8((f32x4){o[0], o[1], o[2], o[3]}, (f32x4){o[4], o[5], o[6], o[7]});
                              *(u32x4*)(dst + 8) = pack8((f32x4){o[8], o[9], o[10], o[11]}, (f32x4){o[12], o[13], o[14], o[15]}); }
                            __syncthreads();
                        }
                    }
    }
#endif
                    GSYNC();
                } else {
#ifndef NO_PROJ1
    for (int dup_ = 0; dup_ < NDUP_PROJ1; ++dup_) { if (dup_) { GSYNC(); }
                    { PHASE_ARGS(); pg8::Gemm g{HB, (const bf16_t*)(ws + WS_ODIN), M, ODD_N, DM}; pg8::StaticOrder S; S.init(M, ODD_N, G, bx);
                      pg8::EpiP1 E{SSQ, CS, Q1, K1, V1, QIH, QIL, KIH, KIL, WI1};
                      pg8::gemm_phase<pg8::EpiP1, pg8::StaticOrder, true, true>(ldsl, g, S, E, fresh_tid()); }
    }
#endif
                    GSYNC();
#ifndef NO_IDX
    for (int dup_ = 0; dup_ < NDUP_IDX; ++dup_) { if (dup_) { GSYNC(); }
                    {
                        PHASE_IDS();
                        LAS float* SC = (LAS float*)ldsl;
                        const int r32 = lane & 31, h2 = lane >> 5;
                        const bool scorer = wave < 4; const int sw = wave & 3;
                        LAS unsigned* histw = (LAS unsigned*)(ldsl + RING_BYTES + 2048 + sw * 1024);
                        LAS unsigned long long* wroww = (LAS unsigned long long*)(ldsl + RING_BYTES + 6144 + sw * 512);
                        int up = -1;
#pragma unroll 1
                        for (int k = 0; ; ++k) {
                            const int u = (G == 256) ? ((((k & 1) | ((k >> 2) << 1)) << 9) + ((((k + 2) >> 2) & 1) << 8) + vcu) : vcu + k * G;
                            const bool have = (G == 256) ? k < 8 : u < 2048;
                            const int bp = up >> 9, urp = up & 511; const int rgp = (urp & 256) ? 511 - (urp & 255) : (urp & 255);
                            const int t0p = rgp * 8; const int nk64p = (t0p >> 6) + 1;
                            if (scorer) {
                                __syncthreads();
                                const int b = u >> 9, ur = u & 511; const int rg = (ur & 256) ? 511 - (ur & 255) : (ur & 255);
                                const int t0 = rg * 8; const size_t mb = (size_t)b * SEQ;
                                if (have && t0 >= 256) {
                                    const int nk64 = (t0 >> 6) + 1, nkb = 2 * nk64;
                                    bf16x8 ah[4], al[4];
                                    { const size_t qrow = mb + t0 + (r32 >> 2); const int hd = r32 & 3;
#pragma unroll
                                      for (int ks = 0; ks < 4; ++ks) { ah[ks] = *(const bf16x8*)(QIH + qrow * 256 + hd * 64 + ks * 16 + h2 * 8); al[ks] = *(const bf16x8*)(QIL + qrow * 256 + hd * 64 + ks * 16 + h2 * 8); } }
                                    f32x4 wv[4];
#pragma unroll
                                    for (int g = 0; g < 4; ++g) wv[g] = *(const f32x4*)(WI1 + (mb + t0 + 2 * g + h2) * 4);
                                    const bf16_t* kt = KIH + (size_t)b * 128 * 4096 + lane * 8;
                                    bf16x8 bA[8], bB[8], bC[8];
#define IDX_LOAD(dst, kb_) do { _Pragma("unroll") for (int q = 0; q < 8; ++q) dst[q] = *(const bf16x8*)(kt + (size_t)(kb_) * 4096 + q * 512); } while (0)
#define IDX_FMA(d, a, b, c) asm("v_fma_f32 %0, %1, %2, %3" : "=v"(d) : "v"(a), "v"(b), "v"(c))
#define IDX_COMP(src, kb_) do { const int key = (kb_) * 32 + r32; f32x16 acc = {}; \
                                _Pragma("unroll") for (int ks = 0; ks < 4; ++ks) { \
                                    acc = __builtin_amdgcn_mfma_f32_32x32x16_bf16(ah[ks], src[2 * ks], acc, 0, 0, 0); \
                                    acc = __builtin_amdgcn_mfma_f32_32x32x16_bf16(ah[ks], src[2 * ks + 1], acc, 0, 0, 0); \
                                    acc = __builtin_amdgcn_mfma_f32_32x32x16_bf16(al[ks], src[2 * ks], acc, 0, 0, 0); } \
                                const bool diag_ = (kb_) * 32 + 31 > t0;            \
                                _Pragma("unroll") for (int g = 0; g < 4; ++g) { \
                                      \
                                    const float e0 = acc[4 * g + 0], e1 = acc[4 * g + 1], e2 = acc[4 * g + 2], e3 = acc[4 * g + 3];       \
                                    int r0 = __float_as_int(e0), r1 = __float_as_int(e1), r2 = __float_as_int(e2), r3 = __float_as_int(e3); \
                                    r0 = r0 > 0 ? r0 : 0; r1 = r1 > 0 ? r1 : 0; r2 = r2 > 0 ? r2 : 0; r3 = r3 > 0 ? r3 : 0; \
                                    float sc, z_ = 0.0f; IDX_FMA(sc, wv[g][0], __builtin_bit_cast(float, r0), z_);               \
                                    IDX_FMA(sc, wv[g][1], __builtin_bit_cast(float, r1), sc); IDX_FMA(sc, wv[g][2], __builtin_bit_cast(float, r2), sc); IDX_FMA(sc, wv[g][3], __builtin_bit_cast(float, r3), sc); \
                                    unsigned uu = __builtin_bit_cast(unsigned, sc); uu ^= (unsigned)((int)uu >> 31) | 0x80000000u;     \
                                    const int rl = 2 * g + h2; if (diag_ && key > t0 + rl) uu = 0u;                                      \
                                    SC[rl * 4096 + key] = __builtin_bit_cast(float, uu); } } while (0)
                                    { int kb = sw;
                                      IDX_LOAD(bA, kb);
                                      { const int k1 = kb + 4 < nkb ? kb + 4 : nkb - 1; IDX_LOAD(bB, k1); }
#pragma unroll 1
                                      for (; kb < nkb; kb += 12) {
                                          { const int k2 = kb + 8 < nkb ? kb + 8 : nkb - 1; IDX_LOAD(bC, k2); }
                                          IDX_COMP(bA, kb);
                                          { const int k3 = kb + 12 < nkb ? kb + 12 : nkb - 1; IDX_LOAD(bA, k3); }
                                          if (kb + 4 < nkb) IDX_COMP(bB, kb + 4);
                                          { const int k4 = kb + 16 < nkb ? kb + 16 : nkb - 1; IDX_LOAD(bB, k4); }
                                          if (kb + 8 < nkb) IDX_COMP(bC, kb + 8);
                                      } }
#undef IDX_LOAD
#undef IDX_COMP
#undef IDX_FMA
                                }
                                __syncthreads();
                            } else {
                                const bool selp = up >= 0 && t0p >= 256;
                                unsigned key[64], key2[64];
                                { const int nkl = selp ? nk64p : 0;
#pragma unroll
                                  for (int j = 0; j < 64; ++j) {
                                    unsigned k0 = 0u, k1 = 0u;
                                    if (j < nkl) { k0 = __builtin_bit_cast(unsigned, SC[(2 * sw) * 4096 + j * 64 + lane]); k1 = __builtin_bit_cast(unsigned, SC[(2 * sw + 1) * 4096 + j * 64 + lane]); }
                                    key[j] = k0; key2[j] = k1;
                                  } }
                                __syncthreads();
                                if (up >= 0) {
                                if (t0p < 256) {
#pragma unroll 1
                                    for (int r = 0; r < 2; ++r) { const int tp = t0p + 2 * sw + r; const int j = lane; unsigned long long w;
                                        if (64 * j + 63 <= tp) w = ~0ull; else if (64 * j > tp) w = 0ull; else w = (~0ull) >> (63 - (tp - 64 * j));
                                        MASK[((size_t)bp * 64 + lane) * SEQ + tp] = w; }
                                } else {
                                unsigned Tq0 = 0u, Tq1 = 0u, neqq0 = 0u, neqq1 = 0u; int needq0 = 256, needq1 = 256, p0q0 = 0, p0q1 = 0;
                                bool dA = false, dB = false;
                                { unsigned a0 = 0u, a1 = 0u, a2 = 0u, a3 = 0u, b0 = 0u, b1 = 0u, b2 = 0u, b3 = 0u, c0 = 0u, c1 = 0u, c2 = 0u, c3 = 0u, e0 = 0u, e1 = 0u, e2 = 0u, e3 = 0u;
                                  unsigned zp = 0x80000001u, z0 = 0x80000000u; asm volatile("" : "+s"(zp), "+s"(z0));
#pragma unroll
                                  for (int grp = 0; grp < 8; ++grp) if (grp * 8 < nk64p) {
#pragma unroll
                                      for (int q4 = 0; q4 < 2; ++q4) {
                                          cnt_ge4(a0, a1, a2, a3, key[grp * 8 + q4 * 4 + 0], key[grp * 8 + q4 * 4 + 1], key[grp * 8 + q4 * 4 + 2], key[grp * 8 + q4 * 4 + 3], zp);
                                          cnt_ge4(b0, b1, b2, b3, key2[grp * 8 + q4 * 4 + 0], key2[grp * 8 + q4 * 4 + 1], key2[grp * 8 + q4 * 4 + 2], key2[grp * 8 + q4 * 4 + 3], zp);
                                          cnt_ge4(c0, c1, c2, c3, key[grp * 8 + q4 * 4 + 0], key[grp * 8 + q4 * 4 + 1], key[grp * 8 + q4 * 4 + 2], key[grp * 8 + q4 * 4 + 3], z0);
                                          cnt_ge4(e0, e1, e2, e3, key2[grp * 8 + q4 * 4 + 0], key2[grp * 8 + q4 * 4 + 1], key2[grp * 8 + q4 * 4 + 2], key2[grp * 8 + q4 * 4 + 3], z0); } }
                                  const int posA = wave_sum_u32((a0 + a1) + (a2 + a3)), posB = wave_sum_u32((b0 + b1) + (b2 + b3)), nnA = wave_sum_u32((c0 + c1) + (c2 + c3)), nnB = wave_sum_u32((e0 + e1) + (e2 + e3));
                                  if (posA < 256 && nnA >= 256) { Tq0 = 0x80000000u; needq0 = 256 - posA; neqq0 = (unsigned)(nnA - posA); p0q0 = 4; dA = true; }
                                  else if (nnA < 256) dA = true;
                                  if (posB < 256 && nnB >= 256) { Tq1 = 0x80000000u; needq1 = 256 - posB; neqq1 = (unsigned)(nnB - posB); p0q1 = 4; dB = true; }
                                  else if (nnB < 256) dB = true; }
                                if (!(dA && dB))
                                { unsigned mxA = 0u, mxB = 0u;
#pragma unroll
                                  for (int grp = 0; grp < 8; ++grp) if (grp * 8 < nk64p) {
#pragma unroll
                                      for (int jj = 0; jj < 8; ++jj) { mxA = key[grp * 8 + jj] > mxA ? key[grp * 8 + jj] : mxA; mxB = key2[grp * 8 + jj] > mxB ? key2[grp * 8 + jj] : mxB; } }
                                  unsigned tbA = wave_max_u32(mxA) >> 24, tbB = wave_max_u32(mxB) >> 24; int abA = 0, abB = 0;
#pragma unroll 1
                                  for (int step = 0; step < 4 && !(dA && dB); ++step) {
                                      const unsigned cA = tbA << 24, cB = tbB << 24; unsigned a0 = 0u, a1 = 0u, a2 = 0u, a3 = 0u, b0 = 0u, b1 = 0u, b2 = 0u, b3 = 0u;
#pragma unroll
                                      for (int grp = 0; grp < 8; ++grp) if (grp * 8 < nk64p) {
                                          cnt_ge4(a0, a1, a2, a3, key[grp * 8 + 0], key[grp * 8 + 1], key[grp * 8 + 2], key[grp * 8 + 3], cA);
                                          cnt_ge4(b0, b1, b2, b3, key2[grp * 8 + 0], key2[grp * 8 + 1], key2[grp * 8 + 2], key2[grp * 8 + 3], cB);
                                          cnt_ge4(a0, a1, a2, a3, key[grp * 8 + 4], key[grp * 8 + 5], key[grp * 8 + 6], key[grp * 8 + 7], cA);
                                          cnt_ge4(b0, b1, b2, b3, key2[grp * 8 + 4], key2[grp * 8 + 5], key2[grp * 8 + 6], key2[grp * 8 + 7], cB); }
                                      const int cntA = wave_sum_u32((a0 + a1) + (a2 + a3)), cntB = wave_sum_u32((b0 + b1) + (b2 + b3));
                                      if (!dA) { if (cntA >= 256) { Tq0 = cA; needq0 = 256 - abA; p0q0 = 1; dA = true; } else { abA = cntA; if (tbA == 0u) dA = true; else --tbA; } }
                                      if (!dB) { if (cntB >= 256) { Tq1 = cB; needq1 = 256 - abB; p0q1 = 1; dB = true; } else { abB = cntB; if (tbB == 0u) dB = true; else --tbB; } }
                                  } }
#pragma unroll 1
                                for (int r = 0; r < 2; ++r) {
                                if (r) {
#pragma unroll
                                    for (int j = 0; j < 64; ++j) key[j] = key2[j]; }
                                const int tp = t0p + 2 * sw + r;
                                unsigned T = r ? Tq1 : Tq0; int need = r ? needq1 : needq0; unsigned neq = r ? neqq1 : neqq0; const int pass0 = r ? p0q1 : p0q0;
                                { LAS unsigned* hist = histw;
#pragma unroll 1
                                  for (int pass = pass0; pass < 4; ++pass) {
                                    const int shift = 24 - 8 * pass; const unsigned pmask = pass == 0 ? 0u : (0xFFFFFFFFu << (shift + 8));
                                    { unsigned z_ = 0u; asm volatile("" : "+v"(z_)); *(LAS u32x4*)(hist + 4 * lane) = (u32x4){z_, z_, z_, z_}; }
#pragma unroll
                                    for (int grp = 0; grp < 8; ++grp) if (grp * 8 < nk64p) {
#pragma unroll
                                        for (int jj = 0; jj < 8; ++jj) { const unsigned k = key[grp * 8 + jj];
                                            if (((k ^ T) & pmask) == 0u) atomicAdd((unsigned*)(hist + ((k >> shift) & 255u)), 1u); } }
                                    const u32x4 h = *(const LAS u32x4*)(hist + 4 * lane);
                                    const unsigned sl = (h.x + h.y) + (h.z + h.w);
                                    const unsigned P_ = wave_prefix_incl_u32(sl, lane);
                                    const unsigned S = (unsigned)__builtin_amdgcn_readlane((int)P_, 63) - P_ + sl;
                                    const unsigned C = S - sl;
                                    const unsigned long long bm = __ballot(C < (unsigned)need && (unsigned)need <= S);
                                    const int L = __builtin_amdgcn_readfirstlane((int)__builtin_ctzll(bm | (1ull << 63)));
                                    const unsigned h0 = __builtin_amdgcn_readlane(h.x, L), h1 = __builtin_amdgcn_readlane(h.y, L), h2_ = __builtin_amdgcn_readlane(h.z, L), h3 = __builtin_amdgcn_readlane(h.w, L);
                                    unsigned c = __builtin_amdgcn_readlane(C, L); int D = 3;
                                    if (c + h3 < (unsigned)need) { c += h3; D = 2; if (c + h2_ < (unsigned)need) { c += h2_; D = 1; if (c + h1 < (unsigned)need) { c += h1; D = 0; } } }
                                    need -= (int)c; T |= (unsigned)(4 * L + D) << shift;
                                    neq = (D == 3) ? h3 : (D == 2) ? h2_ : (D == 1) ? h1 : h0;
                                    if (neq == (unsigned)need) break;
                                  } }
                                if (neq == (unsigned)need) {
                                    unsigned wlo = 0u, whi = 0u; unsigned Tv = T; asm volatile("" : "+v"(Tv));
                                    if (0 < nk64p) {
                                        asm volatile("v_cmp_le_u32_e32 vcc, %2, %3\n\ts_nop 1\n\tv_writelane_b32 %0, vcc_lo, 0\n\tv_writelane_b32 %1, vcc_hi, 0" : "+v"(wlo), "+v"(whi) : "v"(Tv), "v"(key[0]) : "vcc");
                                        asm volatile("v_cmp_le_u32_e32 vcc, %2, %3\n\ts_nop 1\n\tv_writelane_b32 %0, vcc_lo, 1\n\tv_writelane_b32 %1, vcc_hi, 1" : "+v"(wlo), "+v"(whi) : "v"(Tv), "v"(key[1]) : "vcc");
                                        asm volatile("v_cmp_le_u32_e32 vcc, %2, %3\n\ts_nop 1\n\tv_writelane_b32 %0, vcc_lo, 2\n\tv_writelane_b32 %1, vcc_hi, 2" : "+v"(wlo), "+v"(whi) : "v"(Tv), "v"(key[2]) : "vcc");
                                        asm volatile("v_cmp_le_u32_e32 vcc, %2, %3\n\ts_nop 1\n\tv_writelane_b32 %0, vcc_lo, 3\n\tv_writelane_b32 %1, vcc_hi, 3" : "+v"(wlo), "+v"(whi) : "v"(Tv), "v"(key[3]) : "vcc");
                                        asm volatile("v_cmp_le_u32_e32 vcc, %2, %3\n\ts_nop 1\n\tv_writelane_b32 %0, vcc_lo, 4\n\tv_writelane_b32 %1, vcc_hi, 4" : "+v"(wlo), "+v"(whi) : "v"(Tv), "v"(key[4]) : "vcc");
                                        asm volatile("v_cmp_le_u32_e32 vcc, %2, %3\n\ts_nop 1\n\tv_writelane_b32 %0, vcc_lo, 5\n\tv_writelane_b32 %1, vcc_hi, 5" : "+v"(wlo), "+v"(whi) : "v"(Tv), "v"(key[5]) : "vcc");
                                        asm volatile("v_cmp_le_u32_e32 vcc, %2, %3\n\ts_nop 1\n\tv_writelane_b32 %0, vcc_lo, 6\n\tv_writelane_b32 %1, vcc_hi, 6" : "+v"(wlo), "+v"(whi) : "v"(Tv), "v"(key[6]) : "vcc");
                                        asm volatile("v_cmp_le_u32_e32 vcc, %2, %3\n\ts_nop 1\n\tv_writelane_b32 %0, vcc_lo, 7\n\tv_writelane_b32 %1, vcc_hi, 7" : "+v"(wlo), "+v"(whi) : "v"(Tv), "v"(key[7]) : "vcc");
                                    }
                                    if (8 < nk64p) {
                                        asm volatile("v_cmp_le_u32_e32 vcc, %2, %3\n\ts_nop 1\n\tv_writelane_b32 %0, vcc_lo, 8\n\tv_writelane_b32 %1, vcc_hi, 8" : "+v"(wlo), "+v"(whi) : "v"(Tv), "v"(key[8]) : "vcc");
                                        asm volatile("v_cmp_le_u32_e32 vcc, %2, %3\n\ts_nop 1\n\tv_writelane_b32 %0, vcc_lo, 9\n\tv_writelane_b32 %1, vcc_hi, 9" : "+v"(wlo), "+v"(whi) : "v"(Tv), "v"(key[9]) : "vcc");
                                        asm volatile("v_cmp_le_u32_e32 vcc, %2, %3\n\ts_nop 1\n\tv_writelane_b32 %0, vcc_lo, 10\n\tv_writelane_b32 %1, vcc_hi, 10" : "+v"(wlo), "+v"(whi) : "v"(Tv), "v"(key[10]) : "vcc");
                                        asm volatile("v_cmp_le_u32_e32 vcc, %2, %3\n\ts_nop 1\n\tv_writelane_b32 %0, vcc_lo, 11\n\tv_writelane_b32 %1, vcc_hi, 11" : "+v"(wlo), "+v"(whi) : "v"(Tv), "v"(key[11]) : "vcc");
                                        asm volatile("v_cmp_le_u32_e32 vcc, %2, %3\n\ts_nop 1\n\tv_writelane_b32 %0, vcc_lo, 12\n\tv_writelane_b32 %1, vcc_hi, 12" : "+v"(wlo), "+v"(whi) : "v"(Tv), "v"(key[12]) : "vcc");
                                        asm volatile("v_cmp_le_u32_e32 vcc, %2, %3\n\ts_nop 1\n\tv_writelane_b32 %0, vcc_lo, 13\n\tv_writelane_b32 %1, vcc_hi, 13" : "+v"(wlo), "+v"(whi) : "v"(Tv), "v"(key[13]) : "vcc");
                                        asm volatile("v_cmp_le_u32_e32 vcc, %2, %3\n\ts_nop 1\n\tv_writelane_b32 %0, vcc_lo, 14\n\tv_writelane_b32 %1, vcc_hi, 14" : "+v"(wlo), "+v"(whi) : "v"(Tv), "v"(key[14]) : "vcc");
                                        asm volatile("v_cmp_le_u32_e32 vcc, %2, %3\n\ts_nop 1\n\tv_writelane_b32 %0, vcc_lo, 15\n\tv_writelane_b32 %1, vcc_hi, 15" : "+v"(wlo), "+v"(whi) : "v"(Tv), "v"(key[15]) : "vcc");
                                    }
                                    if (16 < nk64p) {
                                        asm volatile("v_cmp_le_u32_e32 vcc, %2, %3\n\ts_nop 1\n\tv_writelane_b32 %0, vcc_lo, 16\n\tv_writelane_b32 %1, vcc_hi, 16" : "+v"(wlo), "+v"(whi) : "v"(Tv), "v"(key[16]) : "vcc");
                                        asm volatile("v_cmp_le_u32_e32 vcc, %2, %3\n\ts_nop 1\n\tv_writelane_b32 %0, vcc_lo, 17\n\tv_writelane_b32 %1, vcc_hi, 17" : "+v"(wlo), "+v"(whi) : "v"(Tv), "v"(key[17]) : "vcc");
                                        asm volatile("v_cmp_le_u32_e32 vcc, %2, %3\n\ts_nop 1\n\tv_writelane_b32 %0, vcc_lo, 18\n\tv_writelane_b32 %1, vcc_hi, 18" : "+v"(wlo), "+v"(whi) : "v"(Tv), "v"(key[18]) : "vcc");
                                        asm volatile("v_cmp_le_u32_e32 vcc, %2, %3\n\ts_nop 1\n\tv_writelane_b32 %0, vcc_lo, 19\n\tv_writelane_b32 %1, vcc_hi, 19" : "+v"(wlo), "+v"(whi) : "v"(Tv), "v"(key[19]) : "vcc");
                                        asm volatile("v_cmp_le_u32_e32 vcc, %2, %3\n\ts_nop 1\n\tv_writelane_b32 %0, vcc_lo, 20\n\tv_writelane_b32 %1, vcc_hi, 20" : "+v"(wlo), "+v"(whi) : "v"(Tv), "v"(key[20]) : "vcc");
                                        asm volatile("v_cmp_le_u32_e32 vcc, %2, %3\n\ts_nop 1\n\tv_writelane_b32 %0, vcc_lo, 21\n\tv_writelane_b32 %1, vcc_hi, 21" : "+v"(wlo), "+v"(whi) : "v"(Tv), "v"(key[21]) : "vcc");
                                        asm volatile("v_cmp_le_u32_e32 vcc, %2, %3\n\ts_nop 1\n\tv_writelane_b32 %0, vcc_lo, 22\n\tv_writelane_b32 %1, vcc_hi, 22" : "+v"(wlo), "+v"(whi) : "v"(Tv), "v"(key[22]) : "vcc");
                                        asm volatile("v_cmp_le_u32_e32 vcc, %2, %3\n\ts_nop 1\n\tv_writelane_b32 %0, vcc_lo, 23\n\tv_writelane_b32 %1, vcc_hi, 23" : "+v"(wlo), "+v"(whi) : "v"(Tv), "v"(key[23]) : "vcc");
                                    }
                                    if (24 < nk64p) {
                                        asm volatile("v_cmp_le_u32_e32 vcc, %2, %3\n\ts_nop 1\n\tv_writelane_b32 %0, vcc_lo, 24\n\tv_writelane_b32 %1, vcc_hi, 24" : "+v"(wlo), "+v"(whi) : "v"(Tv), "v"(key[24]) : "vcc");
                                        asm volatile("v_cmp_le_u32_e32 vcc, %2, %3\n\ts_nop 1\n\tv_writelane_b32 %0, vcc_lo, 25\n\tv_writelane_b32 %1, vcc_hi, 25" : "+v"(wlo), "+v"(whi) : "v"(Tv), "v"(key[25]) : "vcc");
                                        asm volatile("v_cmp_le_u32_e32 vcc, %2, %3\n\ts_nop 1\n\tv_writelane_b32 %0, vcc_lo, 26\n\tv_writelane_b32 %1, vcc_hi, 26" : "+v"(wlo), "+v"(whi) : "v"(Tv), "v"(key[26]) : "vcc");
                                        asm volatile("v_cmp_le_u32_e32 vcc, %2, %3\n\ts_nop 1\n\tv_writelane_b32 %0, vcc_lo, 27\n\tv_writelane_b32 %1, vcc_hi, 27" : "+v"(wlo), "+v"(whi) : "v"(Tv), "v"(key[27]) : "vcc");
                                        asm volatile("v_cmp_le_u32_e32 vcc, %2, %3\n\ts_nop 1\n\tv_writelane_b32 %0, vcc_lo, 28\n\tv_writelane_b32 %1, vcc_hi, 28" : "+v"(wlo), "+v"(whi) : "v"(Tv), "v"(key[28]) : "vcc");
                                        asm volatile("v_cmp_le_u32_e32 vcc, %2, %3\n\ts_nop 1\n\tv_writelane_b32 %0, vcc_lo, 29\n\tv_writelane_b32 %1, vcc_hi, 29" : "+v"(wlo), "+v"(whi) : "v"(Tv), "v"(key[29]) : "vcc");
                                        asm volatile("v_cmp_le_u32_e32 vcc, %2, %3\n\ts_nop 1\n\tv_writelane_b32 %0, vcc_lo, 30\n\tv_writelane_b32 %1, vcc_hi, 30" : "+v"(wlo), "+v"(whi) : "v"(Tv), "v"(key[30]) : "vcc");
                                        asm volatile("v_cmp_le_u32_e32 vcc, %2, %3\n\ts_nop 1\n\tv_writelane_b32 %0, vcc_lo, 31\n\tv_writelane_b32 %1, vcc_hi, 31" : "+v"(wlo), "+v"(whi) : "v"(Tv), "v"(key[31]) : "vcc");
                                    }
                                    if (32 < nk64p) {
                                        asm volatile("v_cmp_le_u32_e32 vcc, %2, %3\n\ts_nop 1\n\tv_writelane_b32 %0, vcc_lo, 32\n\tv_writelane_b32 %1, vcc_hi, 32" : "+v"(wlo), "+v"(whi) : "v"(Tv), "v"(key[32]) : "vcc");
                                        asm volatile("v_cmp_le_u32_e32 vcc, %2, %3\n\ts_nop 1\n\tv_writelane_b32 %0, vcc_lo, 33\n\tv_writelane_b32 %1, vcc_hi, 33" : "+v"(wlo), "+v"(whi) : "v"(Tv), "v"(key[33]) : "vcc");
                                        asm volatile("v_cmp_le_u32_e32 vcc, %2, %3\n\ts_nop 1\n\tv_writelane_b32 %0, vcc_lo, 34\n\tv_writelane_b32 %1, vcc_hi, 34" : "+v"(wlo), "+v"(whi) : "v"(Tv), "v"(key[34]) : "vcc");
                                        asm volatile("v_cmp_le_u32_e32 vcc, %2, %3\n\ts_nop 1\n\tv_writelane_b32 %0, vcc_lo, 35\n\tv_writelane_b32 %1, vcc_hi, 35" : "+v"(wlo), "+v"(whi) : "v"(Tv), "v"(key[35]) : "vcc");
                                        asm volatile("v_cmp_le_u32_e32 vcc, %2, %3\n\ts_nop 1\n\tv_writelane_b32 %0, vcc_lo, 36\n\tv_writelane_b32 %1, vcc_hi, 36" : "+v"(wlo), "+v"(whi) : "v"(Tv), "v"(key[36]) : "vcc");
                                        asm volatile("v_cmp_le_u32_e32 vcc, %2, %3\n\ts_nop 1\n\tv_writelane_b32 %0, vcc_lo, 37\n\tv_writelane_b32 %1, vcc_hi, 37" : "+v"(wlo), "+v"(whi) : "v"(Tv), "v"(key[37]) : "vcc");
                                        asm volatile("v_cmp_le_u32_e32 vcc, %2, %3\n\ts_nop 1\n\tv_writelane_b32 %0, vcc_lo, 38\n\tv_writelane_b32 %1, vcc_hi, 38" : "+v"(wlo), "+v"(whi) : "v"(Tv), "v"(key[38]) : "vcc");
                                        asm volatile("v_cmp_le_u32_e32 vcc, %2, %3\n\ts_nop 1\n\tv_writelane_b32 %0, vcc_lo, 39\n\tv_writelane_b32 %1, vcc_hi, 39" : "+v"(wlo), "+v"(whi) : "v"(Tv), "v"(key[39]) : "vcc");
                                    }
                                    if (40 < nk64p) {
                                        asm volatile("v_cmp_le_u32_e32 vcc, %2, %3\n\ts_nop 1\n\tv_writelane_b32 %0, vcc_lo, 40\n\tv_writelane_b32 %1, vcc_hi, 40" : "+v"(wlo), "+v"(whi) : "v"(Tv), "v"(key[40]) : "vcc");
                                        asm volatile("v_cmp_le_u32_e32 vcc, %2, %3\n\ts_nop 1\n\tv_writelane_b32 %0, vcc_lo, 41\n\tv_writelane_b32 %1, vcc_hi, 41" : "+v"(wlo), "+v"(whi) : "v"(Tv), "v"(key[41]) : "vcc");
                                        asm volatile("v_cmp_le_u32_e32 vcc, %2, %3\n\ts_nop 1\n\tv_writelane_b32 %0, vcc_lo, 42\n\tv_writelane_b32 %1, vcc_hi, 42" : "+v"(wlo), "+v"(whi) : "v"(Tv), "v"(key[42]) : "vcc");
                                        asm volatile("v_cmp_le_u32_e32 vcc, %2, %3\n\ts_nop 1\n\tv_writelane_b32 %0, vcc_lo, 43\n\tv_writelane_b32 %1, vcc_hi, 43" : "+v"(wlo), "+v"(whi) : "v"(Tv), "v"(key[43]) : "vcc");
                                        asm volatile("v_cmp_le_u32_e32 vcc, %2, %3\n\ts_nop 1\n\tv_writelane_b32 %0, vcc_lo, 44\n\tv_writelane_b32 %1, vcc_hi, 44" : "+v"(wlo), "+v"(whi) : "v"(Tv), "v"(key[44]) : "vcc");
                                        asm volatile("v_cmp_le_u32_e32 vcc, %2, %3\n\ts_nop 1\n\tv_writelane_b32 %0, vcc_lo, 45\n\tv_writelane_b32 %1, vcc_hi, 45" : "+v"(wlo), "+v"(whi) : "v"(Tv), "v"(key[45]) : "vcc");
                                        asm volatile("v_cmp_le_u32_e32 vcc, %2, %3\n\ts_nop 1\n\tv_writelane_b32 %0, vcc_lo, 46\n\tv_writelane_b32 %1, vcc_hi, 46" : "+v"(wlo), "+v"(whi) : "v"(Tv), "v"(key[46]) : "vcc");
                                        asm volatile("v_cmp_le_u32_e32 vcc, %2, %3\n\ts_nop 1\n\tv_writelane_b32 %0, vcc_lo, 47\n\tv_writelane_b32 %1, vcc_hi, 47" : "+v"(wlo), "+v"(whi) : "v"(Tv), "v"(key[47]) : "vcc");
                                    }
                                    if (48 < nk64p) {
                                        asm volatile("v_cmp_le_u32_e32 vcc, %2, %3\n\ts_nop 1\n\tv_writelane_b32 %0, vcc_lo, 48\n\tv_writelane_b32 %1, vcc_hi, 48" : "+v"(wlo), "+v"(whi) : "v"(Tv), "v"(key[48]) : "vcc");
                                        asm volatile("v_cmp_le_u32_e32 vcc, %2, %3\n\ts_nop 1\n\tv_writelane_b32 %0, vcc_lo, 49\n\tv_writelane_b32 %1, vcc_hi, 49" : "+v"(wlo), "+v"(whi) : "v"(Tv), "v"(key[49]) : "vcc");
                                        asm volatile("v_cmp_le_u32_e32 vcc, %2, %3\n\ts_nop 1\n\tv_writelane_b32 %0, vcc_lo, 50\n\tv_writelane_b32 %1, vcc_hi, 50" : "+v"(wlo), "+v"(whi) : "v"(Tv), "v"(key[50]) : "vcc");
                                        asm volatile("v_cmp_le_u32_e32 vcc, %2, %3\n\ts_nop 1\n\tv_writelane_b32 %0, vcc_lo, 51\n\tv_writelane_b32 %1, vcc_hi, 51" : "+v"(wlo), "+v"(whi) : "v"(Tv), "v"(key[51]) : "vcc");
                                        asm volatile("v_cmp_le_u32_e32 vcc, %2, %3\n\ts_nop 1\n\tv_writelane_b32 %0, vcc_lo, 52\n\tv_writelane_b32 %1, vcc_hi, 52" : "+v"(wlo), "+v"(whi) : "v"(Tv), "v"(key[52]) : "vcc");
                                        asm volatile("v_cmp_le_u32_e32 vcc, %2, %3\n\ts_nop 1\n\tv_writelane_b32 %0, vcc_lo, 53\n\tv_writelane_b32 %1, vcc_hi, 53" : "+v"(wlo), "+v"(whi) : "v"(Tv), "v"(key[53]) : "vcc");
                                        asm volatile("v_cmp_le_u32_e32 vcc, %2, %3\n\ts_nop 1\n\tv_writelane_b32 %0, vcc_lo, 54\n\tv_writelane_b32 %1, vcc_hi, 54" : "+v"(wlo), "+v"(whi) : "v"(Tv), "v"(key[54]) : "vcc");
                                        asm volatile("v_cmp_le_u32_e32 vcc, %2, %3\n\ts_nop 1\n\tv_writelane_b32 %0, vcc_lo, 55\n\tv_writelane_b32 %1, vcc_hi, 55" : "+v"(wlo), "+v"(whi) : "v"(Tv), "v"(key[55]) : "vcc");
                                    }
                                    if (56 < nk64p) {
                                        asm volatile("v_cmp_le_u32_e32 vcc, %2, %3\n\ts_nop 1\n\tv_writelane_b32 %0, vcc_lo, 56\n\tv_writelane_b32 %1, vcc_hi, 56" : "+v"(wlo), "+v"(whi) : "v"(Tv), "v"(key[56]) : "vcc");
                                        asm volatile("v_cmp_le_u32_e32 vcc, %2, %3\n\ts_nop 1\n\tv_writelane_b32 %0, vcc_lo, 57\n\tv_writelane_b32 %1, vcc_hi, 57" : "+v"(wlo), "+v"(whi) : "v"(Tv), "v"(key[57]) : "vcc");
                                        asm volatile("v_cmp_le_u32_e32 vcc, %2, %3\n\ts_nop 1\n\tv_writelane_b32 %0, vcc_lo, 58\n\tv_writelane_b32 %1, vcc_hi, 58" : "+v"(wlo), "+v"(whi) : "v"(Tv), "v"(key[58]) : "vcc");
                                        asm volatile("v_cmp_le_u32_e32 vcc, %2, %3\n\ts_nop 1\n\tv_writelane_b32 %0, vcc_lo, 59\n\tv_writelane_b32 %1, vcc_hi, 59" : "+v"(wlo), "+v"(whi) : "v"(Tv), "v"(key[59]) : "vcc");
                                        asm volatile("v_cmp_le_u32_e32 vcc, %2, %3\n\ts_nop 1\n\tv_writelane_b32 %0, vcc_lo, 60\n\tv_writelane_b32 %1, vcc_hi, 60" : "+v"(wlo), "+v"(whi) : "v"(Tv), "v"(key[60]) : "vcc");
                                        asm volatile("v_cmp_le_u32_e32 vcc, %2, %3\n\ts_nop 1\n\tv_writelane_b32 %0, vcc_lo, 61\n\tv_writelane_b32 %1, vcc_hi, 61" : "+v"(wlo), "+v"(whi) : "v"(Tv), "v"(key[61]) : "vcc");
                                        asm volatile("v_cmp_le_u32_e32 vcc, %2, %3\n\ts_nop 1\n\tv_writelane_b32 %0, vcc_lo, 62\n\tv_writelane_b32 %1, vcc_hi, 62" : "+v"(wlo), "+v"(whi) : "v"(Tv), "v"(key[62]) : "vcc");
                                        asm volatile("v_cmp_le_u32_e32 vcc, %2, %3\n\ts_nop 1\n\tv_writelane_b32 %0, vcc_lo, 63\n\tv_writelane_b32 %1, vcc_hi, 63" : "+v"(wlo), "+v"(whi) : "v"(Tv), "v"(key[63]) : "vcc");
                                    }
                                    MASK[((size_t)bp * 64 + lane) * SEQ + tp] = ((unsigned long long)whi << 32) | wlo;
                                } else {
                                int base = 0;
                                LAS unsigned long long* wrow = wroww;
#pragma unroll
                                for (int grp = 0; grp < 8; ++grp) if (grp * 8 < nk64p) {
#pragma unroll
                                    for (int jj = 0; jj < 8; ++jj) { const int j = grp * 8 + jj;
                                        const bool eq = key[j] == T; const unsigned long long eqm = __ballot(eq);
                                        const int rank = base + (int)__builtin_amdgcn_mbcnt_hi((unsigned)(eqm >> 32), __builtin_amdgcn_mbcnt_lo((unsigned)eqm, 0u));
                                        const bool sel = (key[j] > T) || (eq && rank < need);
                                        const unsigned long long wj = __ballot(sel);
                                        if (lane == 0) wrow[j] = wj;
                                        base += __popcll(eqm); } }
                                { const unsigned long long wv_ = wrow[lane]; const unsigned lo_ = (lane < nk64p) ? (unsigned)wv_ : 0u, hi_ = (lane < nk64p) ? (unsigned)(wv_ >> 32) : 0u;
                                  MASK[((size_t)bp * 64 + lane) * SEQ + tp] = ((unsigned long long)hi_ << 32) | lo_; }
                                }

                                }
                                }
                                }
                                __syncthreads();
                            }
                            if (!have) break;
                            up = u;
                        }
                    }
    }
#endif
                    GSYNC();
#ifndef NO_ATT
    for (int dup_ = 0; dup_ < NDUP_ATT; ++dup_) { if (dup_) { GSYNC(); }
                    {
                        PHASE_ARGS();
                        att::Seam S;
                        auto mkref = [&](int L, int pass) {
                            const int x8 = L & 7, kk = L >> 3, b = x8 >> 1, kvh = x8 & 1, head = kvh * 4 + (kk >> 3), x = kk & 7;
                            const int qb = pass ? 15 - x : x;
                            att::BlockRef r;
                            r.Q = Q1 + ((size_t)(b * 8 + head) * SEQ + qb * 256) * 128; r.K = K1 + (size_t)(b * 2 + kvh) * SEQ * 128;
                            r.O = MIX + ((size_t)b * SEQ + qb * 256) * DM + head * 128; r.MW = MASK + (size_t)b * 64 * SEQ + qb * 256; r.P0 = qb * 256;
                            return r; };
                        int L = bx;
                        if (L < 256) {
                            int pass = 0; att::BlockRef cur = mkref(L, 0);
                            const int atid = fresh_tid();
                            att::attn_prime(cur, (char*)lds, S, atid);
                            for (;;) {
                                const bool more_pass = pass == 0, more_item = L + G < 256, last = !more_pass && !more_item;
                                int passn = pass + 1, Ln = L;
                                if (!more_pass) { passn = 0; Ln = more_item ? L + G : L; }
                                const att::BlockRef nxt = last ? cur : mkref(Ln, passn);
                                att::attn_block(cur, nxt, (char*)lds, S, atid);
                                if (last) break;
                                cur = nxt; pass = passn; L = Ln;
                            }
                        }
                    }
    }
#endif
                    GSYNC();
                }
#ifndef NO_OUTP
    for (int dup_ = 0; dup_ < NDUP_OUTP; ++dup_) { if (dup_) { GSYNC(); }
                { PHASE_ARGS(); pg8::Gemm g{MIX, (const bf16_t*)(ws + (li == 0 ? WS_EVOUT : WS_ODOUT)), M, DM, DM}; pg8::StaticOrder S; S.init(M, DM, G, bx);
                  pg8::EpiRes E{HB, SSQ, dup_ ? 0.0f : 1.0f};
                  pg8::gemm_phase<pg8::EpiRes, pg8::StaticOrder, true, true>(ldsl, g, S, E, fresh_tid()); }
    }
#endif
                GSYNC();
            }
#ifndef NO_UP
    for (int dup_ = 0; dup_ < NDUP_UP; ++dup_) { if (dup_) { GSYNC(); }
            { PHASE_ARGS(); pg8::Gemm g{HB, (const bf16_t*)(ws + WS_WIT + (size_t)(li * 2 + f) * 11 * MiB), M, NFF, DM}; pg8::StaticOrder S; S.init(M, NFF, G, bx);
              pg8::EpiUp E{SSQ, HID};
              pg8::gemm_phase<pg8::EpiUp, pg8::StaticOrder, true, true>(ldsl, g, S, E, fresh_tid()); }
            if (bx >= (M / 256) * (NFF / 256) % 256 && G == 256) { PHASE_IDS(); const int widx = (bx - 128) * 8 + wave, nw = 128 * 8; LAS unsigned char* scr = ldsl + wave * 16384;
                if (li == 0 && f == 0) { conv_range(A, ws, CV_WO(0), CV_WO(1), widx, nw, scr, lane);
                              conv_range(A, ws, CV_EV, CV_OD, widx, nw, scr, lane); conv_range(A, ws, CV_EO, CV_OO, widx, nw, scr, lane); conv_extras_even(A, ws, widx, nw, lane); }
                else if (li == 0) { conv_range(A, ws, CV_WI(2), CV_WI(3), widx, nw, scr, lane); conv_range(A, ws, CV_WO(2), CV_WO(3), widx, nw, scr, lane); }
                else if (f == 0) { conv_range(A, ws, CV_OD, CV_EO, widx, nw, scr, lane); conv_range(A, ws, CV_OO, CV_END, widx, nw, scr, lane); conv_zero_pad_odd(ws, widx, nw, lane);
                              conv_range(A, ws, CV_WI(3), CV_WI(4), widx, nw, scr, lane); }
                else conv_range(A, ws, CV_WO(3), CV_WO(4), widx, nw, scr, lane); }
    }
#endif
            GSYNC();
#ifndef NO_DOWN
    for (int dup_ = 0; dup_ < NDUP_DOWN; ++dup_) { if (dup_) { GSYNC(); }
            { PHASE_ARGS(); pg8::Gemm g{HID, (const bf16_t*)(ws + WS_WOT + (size_t)(li * 2 + f) * 5632 * 1024), M, DM, DFF}; pg8::StaticOrder S; S.init(M, DM, G, bx);
              pg8::EpiRes E{HB, SSQ, dup_ ? 0.0f : 0.5f};
              pg8::gemm_phase<pg8::EpiRes, pg8::StaticOrder, true, true>(ldsl, g, S, E, fresh_tid()); }
    }
#endif
            GSYNC();
        }
    }
    { PHASE_IDS();
    const f32x4* gn = (const f32x4*)A.final_norm + lane * 2;
    const f32x4 g0 = gn[0], g1 = gn[1], g2 = gn[128], g3 = gn[129];
    auto fin_load = [&](int m0, u32x4 (&v)[4][2], f32x4 (&sq)[4][4]) {
#pragma unroll
        for (int i = 0; i < 4; ++i) { const u32x4* xr = (const u32x4*)(HB + (size_t)(m0 + i) * DM) + lane; v[i][0] = xr[0]; v[i][1] = xr[64];
            const f32x4* sp = (const f32x4*)(SSQ + (size_t)(m0 + i) * 16); sq[i][0] = sp[0]; sq[i][1] = sp[1]; sq[i][2] = sp[2]; sq[i][3] = sp[3]; } };
    u32x4 vc[4][2]; f32x4 sc_[4][4];
    int m0 = gw * 4;
    if (m0 < M) fin_load(m0, vc, sc_);
    for (; m0 < M; m0 += NGW * 4) {
        u32x4 vn[4][2]; f32x4 sn[4][4]; const int m1 = m0 + NGW * 4;
        if (m1 < M) fin_load(m1, vn, sn);
        else {
#pragma unroll
            for (int i = 0; i < 4; ++i) { vn[i][0] = vc[i][0]; vn[i][1] = vc[i][1]; sn[i][0] = sc_[i][0]; sn[i][1] = sc_[i][1]; sn[i][2] = sc_[i][2]; sn[i][3] = sc_[i][3]; } }
#pragma unroll
        for (int i = 0; i < 4; ++i) {
            const f32x4 a = sc_[i][0], b = sc_[i][1], c = sc_[i][2], d = sc_[i][3];
            const float ssum = ((a[0] + a[1]) + (a[2] + a[3])) + ((b[0] + b[1]) + (b[2] + b[3])) + ((c[0] + c[1]) + (c[2] + c[3])) + ((d[0] + d[1]) + (d[2] + d[3]));
            const float rs = __builtin_amdgcn_rsqf(ssum * (1.0f / 1024.0f) + RMS_EPS);
            f32x4* xr = (f32x4*)(A.out + (size_t)(m0 + i) * DM) + lane * 2; f32x4 a0, a1, a2, a3; unpack8(vc[i][0], a0, a1); unpack8(vc[i][1], a2, a3);
            xr[0] = a0 * rs * g0; xr[1] = a1 * rs * g1; xr[128] = a2 * rs * g2; xr[129] = a3 * rs * g3; }
#pragma unroll
        for (int i = 0; i < 4; ++i) { vc[i][0] = vn[i][0]; vc[i][1] = vn[i][1]; sc_[i][0] = sn[i][0]; sc_[i][1] = sn[i][1]; sc_[i][2] = sn[i][2]; sc_[i][3] = sn[i][3]; }
    } }
#undef GSYNC
}

extern "C" void kernel_launch(void* const* d_in, const int* in_sizes, int n_in, void* d_out, int out_size, void* d_ws, size_t ws_size, hipStream_t stream) {
    static int grid = 0;
    if (grid == 0) {
        if (n_in != 19 || in_sizes[0] != M * DM || out_size != M * DM || ws_size < WS_END) { fprintf(stderr, "kernel_launch: unexpected shapes n_in %d in0 %d out %d ws %zu\n", n_in, n_in > 0 ? in_sizes[0] : -1, out_size, ws_size); grid = -1; return; }
        int dev = 0, cus = 0, per_cu = 0;
        if (hipGetDevice(&dev) != hipSuccess || hipDeviceGetAttribute(&cus, hipDeviceAttributeMultiprocessorCount, dev) != hipSuccess) { grid = -1; return; }
        if (hipFuncSetAttribute((const void*)fwd_megakernel, hipFuncAttributeMaxDynamicSharedMemorySize, LDS_BYTES) != hipSuccess) { fprintf(stderr, "kernel_launch: hipFuncSetAttribute failed\n"); grid = -1; return; }
        if (hipOccupancyMaxActiveBlocksPerMultiprocessor(&per_cu, (const void*)fwd_megakernel, 512, LDS_BYTES) != hipSuccess || per_cu < 1) { fprintf(stderr, "kernel_launch: occupancy query gave %d\n", per_cu); (void)hipGetLastError(); grid = -1; return; }
        grid = cus;
    }
    if (grid < 0) return;
    (void)hipMemsetAsync((char*)d_ws + WS_CTL + 16384, 0, 16384, stream);
    KArgs a{};
    a.x = (const float*)d_in[0]; a.pos = (const int*)d_in[1]; a.ffn1_norm = (const float*)d_in[2]; a.ffn1_wi = (const float*)d_in[3]; a.ffn1_wo = (const float*)d_in[4];
    a.mix_norm = (const float*)d_in[5]; a.ffn2_norm = (const float*)d_in[6]; a.ffn2_wi = (const float*)d_in[7]; a.ffn2_wo = (const float*)d_in[8];
    a.even_w_in = (const float*)d_in[9]; a.gate_w = (const float*)d_in[10]; a.gate_b = (const float*)d_in[11]; a.out_norm = (const float*)d_in[12];
    a.pool_w = (const float*)d_in[13]; a.pool_scale = (const float*)d_in[14]; a.even_w_out = (const float*)d_in[15]; a.odd_w_in = (const float*)d_in[16];
    a.odd_w_out = (const float*)d_in[17]; a.final_norm = (const float*)d_in[18];
    a.out = (float*)d_out; a.ws = (unsigned char*)d_ws;
    void* args[] = {&a};
    hipError_t e = hipLaunchCooperativeKernel((const void*)fwd_megakernel, dim3(grid), dim3(512), args, LDS_BYTES, stream);
    if (e != hipSuccess) fprintf(stderr, "cooperative launch failed: %s (grid %d)\n", hipGetErrorString(e), grid);
}
```

```cpp
#include <hip/hip_runtime.h>
#include <hip/hip_cooperative_groups.h>
#include <cstdio>
#include <cstdint>
namespace cg = cooperative_groups;

#ifndef NDUP_P0
#define NDUP_P0 1
#endif
#ifndef NDUP_PROJ0
#define NDUP_PROJ0 1
#endif
#ifndef NDUP_G1
#define NDUP_G1 1
#endif
#ifndef NDUP_G3
#define NDUP_G3 1
#endif
#ifndef NDUP_PROJ1
#define NDUP_PROJ1 1
#endif
#ifndef NDUP_IDX
#define NDUP_IDX 1
#endif
#ifndef NDUP_ATT
#define NDUP_ATT 1
#endif
#ifndef NDUP_UP
#define NDUP_UP 1
#endif
#ifndef NDUP_DOWN
#define NDUP_DOWN 1
#endif
#ifndef NDUP_OUTP
#define NDUP_OUTP 1
#endif
constexpr int BATCH = 4, SEQ = 4096, DM = 1024, M = BATCH * SEQ, DFF = 2816, NFF = 2 * DFF;
constexpr int EVEN_IN = 2064, EVEN_N = 2304, ODD_IN = 1860, ODD_N = 2048;
constexpr float RMS_EPS = 1e-6f;
constexpr float QSCALE = 0.08838834764831845f * 1.4426950408889634f;

#define LAS __attribute__((address_space(3)))
typedef unsigned short bf16_t;
typedef short bf16x8 __attribute__((ext_vector_type(8)));
typedef short s16x4 __attribute__((ext_vector_type(4)));
typedef float f32x4 __attribute__((ext_vector_type(4)));
typedef float f32x2 __attribute__((ext_vector_type(2)));
typedef float f32x16 __attribute__((ext_vector_type(16)));
typedef unsigned u32x4 __attribute__((ext_vector_type(4)));
typedef unsigned u32x2 __attribute__((ext_vector_type(2)));

typedef __bf16 bf16x2_t __attribute__((ext_vector_type(2)));
__device__ __forceinline__ unsigned cvt_pk_bf16(float lo, float hi) { f32x2 v = {lo, hi}; bf16x2_t b = __builtin_convertvector(v, bf16x2_t); return __builtin_bit_cast(unsigned, b); }
__device__ __forceinline__ unsigned f2bf(float f) { unsigned u = __builtin_bit_cast(unsigned, f); return (u + 0x7fffu + ((u >> 16) & 1u)) >> 16; }
__device__ __forceinline__ float bf2f(unsigned h) { return __builtin_bit_cast(float, h << 16); }
__device__ __forceinline__ float rows_sum(float x) {
    { auto r = __builtin_amdgcn_permlane16_swap(__float_as_uint(x), __float_as_uint(x), false, false); x = __uint_as_float(r[0]) + __uint_as_float(r[1]); }
    { auto r = __builtin_amdgcn_permlane32_swap(__float_as_uint(x), __float_as_uint(x), false, false); x = __uint_as_float(r[0]) + __uint_as_float(r[1]); }
    return x; }
#define DPP_F(v, ctrl) __builtin_bit_cast(float, __builtin_amdgcn_update_dpp(0, __builtin_bit_cast(int, (float)(v)), (ctrl), 0xf, 0xf, true))
__device__ __forceinline__ void unpack8(const u32x4 w, f32x4& a, f32x4& b) {
    a[0] = __uint_as_float(w[0] << 16); a[1] = __uint_as_float(w[0] & 0xffff0000u); a[2] = __uint_as_float(w[1] << 16); a[3] = __uint_as_float(w[1] & 0xffff0000u);
    b[0] = __uint_as_float(w[2] << 16); b[1] = __uint_as_float(w[2] & 0xffff0000u); b[2] = __uint_as_float(w[3] << 16); b[3] = __uint_as_float(w[3] & 0xffff0000u); }
__device__ __forceinline__ u32x4 pack8(f32x4 a, f32x4 b) { u32x4 w; w.x = cvt_pk_bf16(a[0], a[1]); w.y = cvt_pk_bf16(a[2], a[3]); w.z = cvt_pk_bf16(b[0], b[1]); w.w = cvt_pk_bf16(b[2], b[3]); return w; }

constexpr size_t MiB = 1u << 20;
constexpr size_t WS_CTL = 0;
constexpr size_t WS_SSQ = 1 * MiB;
constexpr size_t WS_DVEC = 2 * MiB;
constexpr size_t WS_WI1 = 2 * MiB + 256 * 1024;
constexpr size_t WS_W = 3 * MiB;
constexpr size_t WS_WIT = WS_W;
constexpr size_t WS_WOT = WS_W + 44 * MiB;
constexpr size_t WS_EVIN = WS_W + 66 * MiB;
constexpr size_t WS_ODIN = WS_EVIN + 4608 * 1024;
constexpr size_t WS_EVOUT = WS_ODIN + 4 * MiB;
constexpr size_t WS_ODOUT = WS_EVOUT + 2 * MiB;
constexpr size_t WS_CS = 82 * MiB;
constexpr size_t WS_HB = 94 * MiB;
constexpr size_t WS_R = 126 * MiB;
constexpr size_t WS_HID = WS_R;
constexpr size_t WS_QK0 = WS_R, WS_V0 = WS_R + 16 * MiB, WS_G0 = WS_R + 32 * MiB, WS_U0 = WS_R + 48 * MiB, WS_LA = WS_R + 64 * MiB, WS_ST0 = WS_R + 80 * MiB;
constexpr size_t WS_MIX = WS_R + 96 * MiB;
constexpr size_t WS_Q1 = WS_R, WS_K1 = WS_R + 32 * MiB, WS_V1 = WS_R + 40 * MiB, WS_QIH = WS_R + 48 * MiB, WS_QIL = WS_R + 56 * MiB, WS_KIH = WS_R + 64 * MiB, WS_KIL = WS_R + 66 * MiB, WS_MASK = WS_R + 68 * MiB;
constexpr size_t WS_END = 256 * MiB;
static_assert(WS_V1 - WS_K1 == 8 * MiB, "att::VOFF");
static_assert(WS_MIX + 32 * MiB <= WS_END && WS_ODOUT + 2 * MiB <= WS_CS && WS_CS + 8 * MiB <= WS_HB + 4 * MiB && WS_HB + 32 * MiB <= WS_R, "ws map");

constexpr int RING_BYTES = 131072, LDS_BYTES = 163840;

struct KArgs {
    const float* x; const int* pos; const float* ffn1_norm; const float* ffn1_wi; const float* ffn1_wo; const float* mix_norm;
    const float* ffn2_norm; const float* ffn2_wi; const float* ffn2_wo; const float* even_w_in; const float* gate_w; const float* gate_b;
    const float* out_norm; const float* pool_w; const float* pool_scale; const float* even_w_out; const float* odd_w_in; const float* odd_w_out; const float* final_norm;
    float* out; unsigned char* ws;
};

namespace pg8 {
#define PG8_LAS __attribute__((address_space(3)))
constexpr int BM = 256, BK = 64, HALF = 128, HTB = HALF * BK * 2, STAGE_BYTES = 8 * HTB, NXCD = 8, WGM = 8;
__host__ __device__ __forceinline__ int lds_byte(int r, int c) { const int st = (r >> 4) * 2 + (c >> 5), rr = r & 15, cc = c & 31, ob = rr * 64 + cc * 2; return st * 1024 + (ob ^ (((ob >> 9) & 1) << 5)); }
__host__ __device__ __forceinline__ void stage_rc(int b, int& R, int& C) { const int st = b / 1024, sb = b % 1024, swz = sb ^ (((sb >> 9) & 1) << 5); R = (st >> 1) * 16 + swz / 64; C = (st & 1) * 32 + (swz % 64) / 2; }
__host__ __device__ __forceinline__ int perm32(int rho) { const int n = rho >> 4, i = rho & 15; return 8 * (i >> 2) + 4 * n + (i & 3); }
struct Unit { int pm, pn; };
struct Gemm { const bf16_t* A; const bf16_t* Bt; int M, N, K; };
struct StaticOrder {
    int nM, nN, nwg, G, c;
    __host__ __device__ void init(int M_, int N_, int G_, int c_) { nM = M_ / BM; nN = N_ / BM; nwg = nM * nN; G = G_; c = c_; }
    __host__ __device__ bool next(int i, Unit& u) const {
        const long L = (long)i * G + c; if (L >= nwg) return false;
        int wgid = (int)L; { const int q = nwg / NXCD, r = nwg % NXCD, xcd = wgid % NXCD, off = wgid / NXCD; wgid = (xcd < r ? xcd * (q + 1) : r * (q + 1) + (xcd - r) * q) + off; }
        const int nig = WGM * nN, gid = wgid / nig, fm = gid * WGM, gsz = (nM - fm) < WGM ? (nM - fm) : WGM;
        u.pm = fm + ((wgid % nig) % gsz); u.pn = (wgid % nig) / gsz; return true;
    }
    __device__ __forceinline__ void a_ready(const Unit&) const {}
    __device__ __forceinline__ void done(const Unit&) const {}
};

__device__ __forceinline__ float row_rs(const float* ssq, int row) {
    const f32x4* p = (const f32x4*)(ssq + (size_t)row * 16);
    const f32x4 a = p[0], b = p[1], c = p[2], d = p[3];
    const float s = ((a[0] + a[1]) + (a[2] + a[3])) + ((b[0] + b[1]) + (b[2] + b[3])) + ((c[0] + c[1]) + (c[2] + c[3])) + ((d[0] + d[1]) + (d[2] + d[3]));
    return __builtin_amdgcn_rsqf(s * (1.0f / 1024.0f) + RMS_EPS);
}
__device__ __forceinline__ float silu_f(float g) { return g * __builtin_amdgcn_rcpf(1.0f + __expf(-g)); }

__device__ __forceinline__ void rs8(const float* ssq, int row0, int fq, float (&rs)[2][4]) {
    f32x4 p[2][4];
#pragma unroll
    for (int ai = 0; ai < 2; ++ai)
#pragma unroll
        for (int m = 0; m < 4; ++m) p[ai][m] = *(const f32x4*)(ssq + (size_t)(row0 + ai * HALF + m * 16) * 16 + fq * 4);
#pragma unroll
    for (int ai = 0; ai < 2; ++ai)
#pragma unroll
        for (int m = 0; m < 4; ++m) { float t = (p[ai][m][0] + p[ai][m][1]) + (p[ai][m][2] + p[ai][m][3]); t = rows_sum(t);
            rs[ai][m] = __builtin_amdgcn_rsqf(t * (1.0f / 1024.0f) + RMS_EPS); }
}
__device__ __forceinline__ void rs4(const float* ssq, int row0, int fq, float (&rs)[4]) {
    f32x4 p[4];
#pragma unroll
    for (int m = 0; m < 4; ++m) p[m] = *(const f32x4*)(ssq + (size_t)(row0 + m * 16) * 16 + fq * 4);
#pragma unroll
    for (int m = 0; m < 4; ++m) { float t = (p[m][0] + p[m][1]) + (p[m][2] + p[m][3]); t = rows_sum(t); rs[m] = __builtin_amdgcn_rsqf(t * (1.0f / 1024.0f) + RMS_EPS); }
}
constexpr int RSB_OFF = 131072 + 10240;
__device__ __forceinline__ void rs_issue(const float* ssq, int pm, int tid, f32x4& p0, f32x4& p1) {
    const float* sp = ssq + ((size_t)pm * BM + (tid >> 1)) * 16 + (tid & 1) * 8; p0 = *(const f32x4*)sp; p1 = *(const f32x4*)(sp + 4); }
__device__ __forceinline__ void rs_commit(PG8_LAS unsigned char* lds, int parity, int tid, const f32x4 p0, const f32x4 p1) {
    float t = ((p0[0] + p0[1]) + (p0[2] + p0[3])) + ((p1[0] + p1[1]) + (p1[2] + p1[3]));
    t += __builtin_bit_cast(float, __builtin_amdgcn_update_dpp(0, __builtin_bit_cast(int, t), 0xB1, 0xF, 0xF, true));
    const float r = __builtin_amdgcn_rsqf(t * (1.0f / 1024.0f) + RMS_EPS);
    if ((tid & 1) == 0) *(PG8_LAS float*)(lds + RSB_OFF + parity * 1024 + (tid >> 1) * 4) = r; }
__device__ __forceinline__ void rs_read(const PG8_LAS float* rsb, int wr, int fr, float (&rs)[2][4]) {
    const PG8_LAS float* b = rsb + wr * 64 + fr;
#pragma unroll
    for (int ai = 0; ai < 2; ++ai)
#pragma unroll
        for (int m = 0; m < 4; ++m) rs[ai][m] = b[ai * HALF + m * 16]; }
struct EpiUp {
    static constexpr bool PERM = true, AFTER_DRAIN = false, IDEMPOTENT = true, USES_RS = true, RS_EARLY = true;
    const float* ssq; bf16_t* hid;
    __device__ __forceinline__ void operator()(const f32x4 (&acc)[2][2][4][2], const Unit& u, int wr, int wc, int fr, int fq, const PG8_LAS float* rsb) const {
        const int col0 = u.pn * 128 + wc * 32 + 8 * fq, row0 = u.pm * BM + wr * 64 + fr;
        float rs[2][4]; rs_read(rsb, wr, fr, rs);
#pragma unroll
        for (int ai = 0; ai < 2; ++ai)
#pragma unroll
            for (int m = 0; m < 4; ++m) {
                const int row = row0 + ai * HALF + m * 16; const float r = rs[ai][m], nr = r * -1.4426950408889634f, ir2 = __builtin_amdgcn_rcpf(r * r);
                const f32x2 nr2 = {nr, nr}, ir22 = {ir2, ir2};
                unsigned w[4]; f32x2 t2[4], p2[4];
#pragma unroll
                for (int q = 0; q < 4; ++q) { const int n = q >> 1, e = (q & 1) * 2;
                    const f32x2 g2 = {acc[ai][0][m][n][e], acc[ai][0][m][n][e + 1]}, u2 = {acc[ai][1][m][n][e], acc[ai][1][m][n][e + 1]};
                    t2[q] = g2 * nr2; p2[q] = g2 * u2; }
#pragma unroll
                for (int q = 0; q < 4; ++q) t2[q] = (f32x2){__builtin_amdgcn_exp2f(t2[q][0]), __builtin_amdgcn_exp2f(t2[q][1])};
#pragma unroll
                for (int q = 0; q < 4; ++q) t2[q] = __builtin_elementwise_fma(t2[q], ir22, ir22);
#pragma unroll
                for (int q = 0; q < 4; ++q) t2[q] = (f32x2){__builtin_amdgcn_rcpf(t2[q][0]), __builtin_amdgcn_rcpf(t2[q][1])};
#pragma unroll
                for (int q = 0; q < 4; ++q) p2[q] = p2[q] * t2[q];
#pragma unroll
                for (int q = 0; q < 4; ++q) w[q] = cvt_pk_bf16(p2[q][0], p2[q][1]);
                *(u32x4*)(hid + (unsigned)(row * DFF + col0)) = (u32x4){w[0], w[1], w[2], w[3]};
            }
    }
};
struct EpiRes {
    static constexpr bool PERM = true, AFTER_DRAIN = false, IDEMPOTENT = false, USES_RS = false, RS_EARLY = false;
    bf16_t* hb; float* ssq; float scale;
    __device__ __forceinline__ void operator()(const f32x4 (&acc)[2][2][4][2], const Unit& u, int wr, int wc, int fr, int fq, const PG8_LAS float*) const {
        const int col0 = u.pn * BM + wc * 32 + 8 * fq, row0 = u.pm * BM + wr * 64 + fr;
        u32x4 pre[2][4][2];
#pragma unroll
        for (int ai = 0; ai < 2; ++ai)
#pragma unroll
            for (int m = 0; m < 4; ++m)
#pragma unroll
                for (int bj = 0; bj < 2; ++bj) pre[ai][m][bj] = *(const u32x4*)(hb + (unsigned)((row0 + ai * HALF + m * 16) * DM + col0 + bj * HALF));
#pragma unroll
        for (int ai = 0; ai < 2; ++ai) {
#pragma unroll
            for (int m = 0; m < 4; ++m) {
                const int row = row0 + ai * HALF + m * 16;
                float ss = 0.f;
#pragma unroll
                for (int bj = 0; bj < 2; ++bj) {
                    const unsigned off = (unsigned)(row * DM + col0 + bj * HALF);
                    f32x4 b0, b1; unpack8(pre[ai][m][bj], b0, b1);
                    const f32x4 o0 = b0 + acc[ai][bj][m][0] * scale, o1 = b1 + acc[ai][bj][m][1] * scale;
                    *(u32x4*)(hb + off) = pack8(o0, o1);
                    ss += (o0[0] * o0[0] + o0[1] * o0[1]) + (o0[2] * o0[2] + o0[3] * o0[3]) + (o1[0] * o1[0] + o1[1] * o1[1]) + (o1[2] * o1[2] + o1[3] * o1[3]);
                }
                ss = rows_sum(ss);
                if (fq == 0) ssq[(unsigned)(row * 16 + u.pn * 4 + wc)] = ss;
            }
        }
    }
};
struct EpiP0 {
    static constexpr bool PERM = true, AFTER_DRAIN = false, IDEMPOTENT = true, USES_RS = true, RS_EARLY = true;
    const float* ssq; const float* gate_b; bf16_t* qk; bf16_t* v; bf16_t* g; bf16_t* uo; float* la;
    __device__ __forceinline__ void operator()(const f32x4 (&acc)[2][2][4][2], const Unit& u, int wr, int wc, int fr, int fq, const PG8_LAS float* rsb) const {
        const int pn = u.pn, lc = wc * 32 + 8 * fq, row0 = u.pm * BM + wr * 64 + fr;
        float rs[2][4]; rs_read(rsb, wr, fr, rs);
        f32x4 gb[2][2] = {};
        if (pn == 6) {
#pragma unroll
            for (int bj = 0; bj < 2; ++bj) { gb[bj][0] = *(const f32x4*)(gate_b + lc + bj * HALF); gb[bj][1] = *(const f32x4*)(gate_b + lc + bj * HALF + 4); } }
#pragma unroll
        for (int ai = 0; ai < 2; ++ai)
#pragma unroll
            for (int m = 0; m < 4; ++m) {
                const int row = row0 + ai * HALF + m * 16; const float r = rs[ai][m];
#pragma unroll
                for (int bj = 0; bj < 2; ++bj) {
                    f32x4 a0 = acc[ai][bj][m][0] * r, a1 = acc[ai][bj][m][1] * r;
                    const int c = lc + bj * HALF;
                    if (pn < 2) { *(u32x4*)(qk + (size_t)row * 512 + pn * 256 + c) = pack8(a0, a1); }
                    else if (pn < 4) { *(u32x4*)(v + (size_t)row * 512 + (pn - 2) * 256 + c) = pack8(a0, a1); }
                    else if (pn < 6) {
#pragma unroll
                        for (int e = 0; e < 4; ++e) { a0[e] = silu_f(a0[e]); a1[e] = silu_f(a1[e]); }
                        *(u32x4*)(g + (size_t)row * 512 + (pn - 4) * 256 + c) = pack8(a0, a1); }
                    else if (pn == 6) {
#pragma unroll
                        for (int e = 0; e < 4; ++e) {
                            float x0 = a0[e] + gb[bj][0][e], x1 = a1[e] + gb[bj][1][e];
                            a0[e] = (fminf(x0, 0.f) - logf(1.0f + __expf(-fabsf(x0)))) * (1.0f / 16.0f);
                            a1[e] = (fminf(x1, 0.f) - logf(1.0f + __expf(-fabsf(x1)))) * (1.0f / 16.0f); }
                        *(f32x4*)(la + (size_t)row * 256 + c) = a0; *(f32x4*)(la + (size_t)row * 256 + c + 4) = a1; }
                    else { *(u32x4*)(uo + (size_t)row * 512 + (pn - 7) * 256 + c) = pack8(a0, a1); }
                }
            }
    }
};
struct EpiP1 {
    static constexpr bool PERM = true, AFTER_DRAIN = false, IDEMPOTENT = true, USES_RS = true, RS_EARLY = false;
    const float* ssq; const unsigned* cs; bf16_t* q; bf16_t* k; bf16_t* v; bf16_t* qih; bf16_t* qil; bf16_t* kih; bf16_t* kil; float* wi;
    __device__ __forceinline__ void rope8(f32x4& a0, f32x4& a1, const f32x4 c0, const f32x4 c1) const {
        const float x0 = a0[0], x1 = a0[1], x2 = a0[2], x3 = a0[3], y0 = a1[0], y1 = a1[1], y2 = a1[2], y3 = a1[3];
        a0[0] = x0 * c0[0] - x1 * c0[1]; a0[1] = x1 * c0[0] + x0 * c0[1];
        a0[2] = x2 * c0[2] - x3 * c0[3]; a0[3] = x3 * c0[2] + x2 * c0[3];
        a1[0] = y0 * c1[0] - y1 * c1[1]; a1[1] = y1 * c1[0] + y0 * c1[1];
        a1[2] = y2 * c1[2] - y3 * c1[3]; a1[3] = y3 * c1[2] + y2 * c1[3];
    }
    __device__ __forceinline__ void split_store(bf16_t* ph, bf16_t* pl, f32x4 a0, f32x4 a1) const {
        const u32x4 h = pack8(a0, a1);
        f32x4 r0, r1;
        r0[0] = a0[0] - bf2f(h.x & 0xffffu); r0[1] = a0[1] - bf2f(h.x >> 16); r0[2] = a0[2] - bf2f(h.y & 0xffffu); r0[3] = a0[3] - bf2f(h.y >> 16);
        r1[0] = a1[0] - bf2f(h.z & 0xffffu); r1[1] = a1[1] - bf2f(h.z >> 16); r1[2] = a1[2] - bf2f(h.w & 0xffffu); r1[3] = a1[3] - bf2f(h.w >> 16);
        *(u32x4*)ph = h; *(u32x4*)pl = pack8(r0, r1);
    }
    __device__ __forceinline__ void operator()(const f32x4 (&acc)[2][2][4][2], const Unit& u, int wr, int wc, int fr, int fq, const PG8_LAS float* rsb) const {
        const int pn = u.pn, lc = wc * 32 + 8 * fq, row0 = u.pm * BM + wr * 64 + fr;
        const bool r128 = pn < 5, r64 = pn == 6 || (pn == 7 && wc < 2);
        unsigned cw[2][4][4];
#pragma unroll
        for (int ai = 0; ai < 2; ++ai)
#pragma unroll
            for (int m = 0; m < 4; ++m) { const int row = row0 + ai * HALF + m * 16;
                cw[ai][m][0] = 0x3c00u; cw[ai][m][1] = 0x3c00u; cw[ai][m][2] = 0x3c00u; cw[ai][m][3] = 0x3c00u;
                if (r128 && pn != 5) { const u32x4 w = *(const u32x4*)(cs + (size_t)row * 64 + (lc >> 1)); cw[ai][m][0] = w.x; cw[ai][m][1] = w.y; cw[ai][m][2] = w.z; cw[ai][m][3] = w.w; }
                else if (r64) { const unsigned* cp = cs + (size_t)row * 64 + (lc & 63); cw[ai][m][0] = cp[0]; cw[ai][m][1] = cp[2]; cw[ai][m][2] = cp[4]; cw[ai][m][3] = cp[6]; } }
#pragma unroll
        for (int ai = 0; ai < 2; ++ai) {
            f32x4 cA[4], cB[4]; float rs[4];
#pragma unroll
            for (int m = 0; m < 4; ++m) { rs[m] = rsb[wr * 64 + fr + ai * HALF + m * 16];
#define H2F(w_, hi_) ((float)__builtin_bit_cast(_Float16, (unsigned short)((hi_) ? ((w_) >> 16) : ((w_) & 0xffffu))))
                cA[m] = (f32x4){H2F(cw[ai][m][0], 0), H2F(cw[ai][m][0], 1), H2F(cw[ai][m][1], 0), H2F(cw[ai][m][1], 1)};
                cB[m] = (f32x4){H2F(cw[ai][m][2], 0), H2F(cw[ai][m][2], 1), H2F(cw[ai][m][3], 0), H2F(cw[ai][m][3], 1)}; }
#undef H2F
#pragma unroll
            for (int m = 0; m < 4; ++m) {
                const int row = row0 + ai * HALF + m * 16;
                const int b = row >> 12, s = row & 4095; const float r = rs[m];
#pragma unroll
                for (int bj = 0; bj < 2; ++bj) {
                    f32x4 a0 = acc[ai][bj][m][0] * r, a1 = acc[ai][bj][m][1] * r;
                    if (pn < 4) { rope8(a0, a1, cA[m], cB[m]); a0 = a0 * QSCALE; a1 = a1 * QSCALE;
                        *(u32x4*)(q + ((size_t)(b * 8 + pn * 2 + bj) * SEQ + s) * 128 + lc) = pack8(a0, a1); }
                    else if (pn == 4) { rope8(a0, a1, cA[m], cB[m]);
                        *(u32x4*)(k + ((size_t)(b * 2 + bj) * SEQ + s) * 128 + lc) = pack8(a0, a1); }
                    else if (pn == 5) { *(u32x4*)(v + ((size_t)(b * 2 + bj) * SEQ + s) * 128 + lc) = pack8(a0, a1); }
                    else if (pn == 6) { const int ct = bj * HALF + lc; rope8(a0, a1, cA[m], cB[m]);
                        split_store(qih + (size_t)row * 256 + ct, qil + (size_t)row * 256 + ct, a0, a1); }
                    else if (bj == 0) {
                        if (wc < 2) { const int c64 = lc; rope8(a0, a1, cA[m], cB[m]);
                            const int q8 = c64 >> 3; const size_t tb = ((size_t)(b * 128 + (s >> 5)) * 4096) + (size_t)(((q8 >> 1) * 4 + (q8 & 1)) * 256 + (s & 31) * 8);
                            split_store(kih + tb, kih + tb + 512, a0, a1); }
                        else if (wc == 2 && fq == 0) { *(f32x4*)(wi + (size_t)row * 4) = a0; }
                    }
                }
            }
        }
    }
};

template <class Epi, class Sched, bool ALIGN_EPI = false, bool SP2 = false>
__device__ __forceinline__ void gemm_phase(PG8_LAS unsigned char* lds, const Gemm g, const Sched& S, const Epi& E, const int tid) {
    const int wid = __builtin_amdgcn_readfirstlane(tid >> 6), lane = tid & 63, wr = wid >> 2, wc = wid & 3, fr = lane & 15, fq = lane >> 4;
    const int K = g.K, nt = K / BK;
    unsigned voffA[2], voffB[2];
#pragma unroll
    for (int i = 0; i < 2; ++i) { int R, C; stage_rc(tid * 16 + i * 8192, R, C); const int Rb = Epi::PERM ? ((R & ~31) + perm32(R & 31)) : R;
        voffA[i] = (unsigned)(R * K + C) * 2u; voffB[i] = (unsigned)(Rb * K + C) * 2u; }
    const size_t kstep = (size_t)(BK * 2);
    const size_t hstep = (size_t)HALF * K * 2;
    const size_t tstep = 2 * hstep;
    const unsigned ldsw = (unsigned)wid * 1024u;
    const int aoff = lds_byte(wr * 64 + fr, fq * 8), boff = lds_byte(wc * 32 + fr, fq * 8);
#define PG8_SA(b, h) (((b) * 2 + (h)) * HTB)
#define PG8_SB(b, h) ((4 + (b) * 2 + (h)) * HTB)
#define PG8_STAGE(bufoff, gbase, voff) do { _Pragma("unroll") for (int _i = 0; _i < 2; ++_i) \
        __builtin_amdgcn_global_load_lds((const unsigned*)((const char*)(gbase) + (voff)[_i]), (PG8_LAS unsigned*)(lds + (bufoff) + ldsw + _i * 8192), 16, 0, 0); } while (0)
#define PG8_LDA(dst, b, h) do { _Pragma("unroll") for (int m = 0; m < 4; ++m) _Pragma("unroll") for (int k = 0; k < 2; ++k) dst[m][k] = *(const PG8_LAS bf16x8*)(lds + PG8_SA(b, h) + aoff + m * 2048 + k * 1024); } while (0)
#define PG8_LDB(dst, b, h) do { _Pragma("unroll") for (int n = 0; n < 2; ++n) _Pragma("unroll") for (int k = 0; k < 2; ++k) dst[n][k] = *(const PG8_LAS bf16x8*)(lds + PG8_SB(b, h) + boff + n * 2048 + k * 1024); } while (0)
#define PG8_MMA(ai, bj, At, Bt) do { __builtin_amdgcn_s_setprio(1); _Pragma("unroll") for (int m = 0; m < 4; ++m) _Pragma("unroll") for (int n = 0; n < 2; ++n) _Pragma("unroll") for (int k = 0; k < 2; ++k) \
        acc[ai][bj][m][n] = __builtin_amdgcn_mfma_f32_16x16x32_bf16(Bt[n][k], At[m][k], acc[ai][bj][m][n], 0, 0, 0); __builtin_amdgcn_s_setprio(0); } while (0)
#define PG8_WAIT_V(n) asm volatile("s_waitcnt vmcnt(" #n ")" ::: "memory")
#define PG8_WAIT_L(n) asm volatile("s_waitcnt lgkmcnt(" #n ")" ::: "memory")
#define PG8_BAR __builtin_amdgcn_s_barrier()
#define PG8_SCHED __builtin_amdgcn_sched_barrier(0)
    Unit cur, nxt; int ui = 0;
    if (!S.next(0, cur)) return;
    f32x4 acc[2][2][4][2];
#pragma unroll
    for (int a = 0; a < 2; ++a)
#pragma unroll
        for (int b = 0; b < 2; ++b)
#pragma unroll
            for (int m = 0; m < 4; ++m)
#pragma unroll
                for (int n = 0; n < 2; ++n) { f32x2 z0, z1; asm volatile("v_mov_b64 %0, 0" : "=v"(z0)); asm volatile("v_mov_b64 %0, 0" : "=v"(z1)); acc[a][b][m][n] = (f32x4){z0[0], z0[1], z1[0], z1[1]}; }
    bf16x8 At[4][2], B0[2][2], B1[2][2];
    const char* cA = (const char*)g.A + (size_t)cur.pm * tstep; const char* cB = (const char*)g.Bt + (size_t)cur.pn * tstep;
    S.a_ready(cur);
    f32x4 rf0, rf1;
    if constexpr (Epi::USES_RS) rs_issue(E.ssq, cur.pm, tid, rf0, rf1);
    if constexpr (SP2) {
        PG8_STAGE(PG8_SB(0, 0), cB, voffB); PG8_STAGE(PG8_SB(0, 1), cB + hstep, voffB); PG8_STAGE(PG8_SA(0, 0), cA, voffA); PG8_STAGE(PG8_SA(0, 1), cA + hstep, voffA);
        if (wr == 1) PG8_BAR;
        PG8_WAIT_V(2); PG8_BAR;
        PG8_STAGE(PG8_SB(1, 0), cB + kstep, voffB); PG8_STAGE(PG8_SA(1, 0), cA + kstep, voffA); PG8_STAGE(PG8_SB(1, 1), cB + hstep + kstep, voffB);
        PG8_WAIT_V(6); PG8_BAR;
    } else {
        PG8_STAGE(PG8_SB(0, 0), cB, voffB); PG8_STAGE(PG8_SA(0, 0), cA, voffA); PG8_STAGE(PG8_SB(0, 1), cB + hstep, voffB); PG8_STAGE(PG8_SA(0, 1), cA + hstep, voffA);
        if (wr == 1) PG8_BAR;
        PG8_WAIT_V(4); PG8_BAR;
        PG8_STAGE(PG8_SB(1, 0), cB + kstep, voffB); PG8_STAGE(PG8_SA(1, 0), cA + kstep, voffA); PG8_STAGE(PG8_SB(1, 1), cB + hstep + kstep, voffB);
        PG8_WAIT_V(6); PG8_BAR;
    }
    if constexpr (Epi::USES_RS) rs_commit(lds, 0, tid, rf0, rf1);
    for (;;) {
        const bool has_next = S.next(ui + 1, nxt);
        const char* nA = has_next ? (const char*)g.A + (size_t)nxt.pm * tstep : cA; const char* nB = has_next ? (const char*)g.Bt + (size_t)nxt.pn * tstep : cB;
        for (int t = 0; t < nt; t += 2) {
            const bool last = (t == nt - 2);
            const char* a1 = cA + (size_t)(t + 1) * kstep;
            const char* a2 = last ? nA : cA + (size_t)(t + 2) * kstep; const char* b2 = last ? nB : cB + (size_t)(t + 2) * kstep;
            const char* a3 = a2 + kstep; const char* b3 = b2 + kstep;
            if (last && has_next) S.a_ready(nxt);
            if constexpr (SP2) {
            PG8_LDB(B0, 0, 0); PG8_LDB(B1, 0, 1); PG8_SCHED; PG8_LDA(At, 0, 0); PG8_STAGE(PG8_SA(1, 1), a1 + hstep, voffA);
            PG8_WAIT_V(8); PG8_WAIT_L(0); PG8_BAR; PG8_MMA(0, 0, At, B0); PG8_MMA(0, 1, At, B1); PG8_BAR; PG8_SCHED;
            PG8_LDA(At, 0, 1); PG8_STAGE(PG8_SB(0, 0), b2, voffB); PG8_STAGE(PG8_SB(0, 1), b2 + hstep, voffB); PG8_STAGE(PG8_SA(0, 0), a2, voffA);
            PG8_WAIT_V(8); PG8_WAIT_L(0); PG8_BAR; PG8_MMA(1, 0, At, B0); PG8_MMA(1, 1, At, B1); PG8_BAR; PG8_SCHED;
            PG8_LDB(B0, 1, 0); PG8_LDB(B1, 1, 1); PG8_SCHED; PG8_LDA(At, 1, 0); PG8_STAGE(PG8_SA(0, 1), a2 + hstep, voffA);
            PG8_WAIT_V(8); PG8_WAIT_L(0); PG8_BAR; PG8_MMA(0, 0, At, B0); PG8_MMA(0, 1, At, B1); PG8_BAR; PG8_SCHED;
            PG8_LDA(At, 1, 1); PG8_STAGE(PG8_SB(1, 0), b3, voffB); PG8_STAGE(PG8_SB(1, 1), b3 + hstep, voffB); PG8_STAGE(PG8_SA(1, 0), a3, voffA);
            PG8_WAIT_V(8); PG8_WAIT_L(0); PG8_BAR; PG8_MMA(1, 0, At, B0); PG8_MMA(1, 1, At, B1); PG8_BAR; PG8_SCHED;
            } else {
            PG8_LDB(B0, 0, 0); PG8_SCHED; PG8_LDA(At, 0, 0); PG8_STAGE(PG8_SA(1, 1), a1 + hstep, voffA);
            PG8_WAIT_L(8); PG8_BAR; PG8_WAIT_L(0); PG8_MMA(0, 0, At, B0); PG8_BAR; PG8_SCHED;
            PG8_LDB(B1, 0, 1); PG8_STAGE(PG8_SB(0, 0), b2, voffB);
            PG8_BAR; PG8_WAIT_L(0); PG8_MMA(0, 1, At, B1); PG8_BAR;
            PG8_LDA(At, 0, 1); PG8_STAGE(PG8_SA(0, 0), a2, voffA);
            PG8_BAR; PG8_WAIT_L(0); PG8_MMA(1, 0, At, B0); PG8_BAR; PG8_SCHED;
            PG8_STAGE(PG8_SB(0, 1), b2 + hstep, voffB);
            PG8_WAIT_V(6); PG8_BAR; PG8_MMA(1, 1, At, B1); PG8_BAR;
            PG8_LDB(B0, 1, 0); PG8_SCHED; PG8_LDA(At, 1, 0); PG8_STAGE(PG8_SA(0, 1), a2 + hstep, voffA);
            PG8_WAIT_L(8); PG8_BAR; PG8_WAIT_L(0); PG8_MMA(0, 0, At, B0); PG8_BAR; PG8_SCHED;
            PG8_LDB(B1, 1, 1); PG8_STAGE(PG8_SB(1, 0), b3, voffB);
            PG8_BAR; PG8_WAIT_L(0); PG8_MMA(0, 1, At, B1); PG8_BAR;
            PG8_LDA(At, 1, 1); PG8_STAGE(PG8_SA(1, 0), a3, voffA);
            PG8_BAR; PG8_WAIT_L(0); PG8_MMA(1, 0, At, B0); PG8_BAR; PG8_SCHED;
            PG8_STAGE(PG8_SB(1, 1), b3 + hstep, voffB);
            PG8_WAIT_V(6); PG8_BAR; PG8_MMA(1, 1, At, B1); PG8_BAR;
            }
        }
        if constexpr (ALIGN_EPI) { if (wr == 0) PG8_BAR; }
        if constexpr (!Epi::AFTER_DRAIN) { int fr_ = fr, fq_ = fq; asm volatile("" : "+v"(fr_), "+v"(fq_));
            if constexpr (Epi::USES_RS) { int t_ = tid; asm volatile("" : "+v"(t_)); f32x4 rp0, rp1;
                const int npm = has_next ? nxt.pm : cur.pm;
                if constexpr (Epi::RS_EARLY) rs_issue(E.ssq, npm, t_, rp0, rp1);
                E(acc, cur, wr, wc, fr_, fq_, (const PG8_LAS float*)(lds + RSB_OFF + (ui & 1) * 1024));
                if constexpr (!Epi::RS_EARLY) rs_issue(E.ssq, npm, t_, rp0, rp1);
                rs_commit(lds, (ui + 1) & 1, t_, rp0, rp1); }
            else E(acc, cur, wr, wc, fr_, fq_, (const PG8_LAS float*)nullptr);
            S.done(cur); }
        if (!has_next) break;
#pragma unroll
    for (int a = 0; a < 2; ++a)
#pragma unroll
        for (int b = 0; b < 2; ++b)
#pragma unroll
            for (int m = 0; m < 4; ++m)
#pragma unroll
                for (int n = 0; n < 2; ++n) { f32x2 z0, z1; asm volatile("v_mov_b64 %0, 0" : "=v"(z0)); asm volatile("v_mov_b64 %0, 0" : "=v"(z1)); acc[a][b][m][n] = (f32x4){z0[0], z0[1], z1[0], z1[1]}; }
        cur = nxt; cA = nA; cB = nB; ++ui;
        if constexpr (ALIGN_EPI) { if (wr == 1) PG8_BAR; }
    }
    PG8_WAIT_V(0);
    if constexpr (!ALIGN_EPI) { if (wr == 0) PG8_BAR; }
    PG8_BAR;
#undef PG8_SA
#undef PG8_SB
#undef PG8_STAGE
#undef PG8_LDA
#undef PG8_LDB
#undef PG8_MMA
#undef PG8_WAIT_V
#undef PG8_WAIT_L
#undef PG8_BAR
#undef PG8_SCHED
}
}

namespace att {
constexpr int D = 128, NW = 8, QBLK = 32, KVBLK = 64, QB = NW * QBLK, OSTRIDE = 1024;
constexpr float SCALE = 0.08838834764831845f, THR = 8.f;
constexpr int SHM_V = KVBLK * D * 2, SHM_K = KVBLK * D * 2;
constexpr int LDS_BYTES = 2 * SHM_V + 2 * SHM_K + NW * 64 * 4;
#define KSWZ(row, colB) ((row) * 256 + ((colB) ^ (((row) & 7) << 4)))
#define SBAR() __builtin_amdgcn_sched_barrier(0)
__device__ __forceinline__ int v_st(int k, int c) { const int kk = (k & ~0xC) | ((k & 4) << 1) | ((k & 8) >> 1); return ((kk >> 3) * 4 + (c >> 5)) * 512 + ((kk & 7) * 32 + (c & 31)) * 2; }
__device__ __forceinline__ int v_rd_base(int lane) { return ((lane & 3) << 3) | (((lane >> 2) & 3) << 6) | (((lane >> 4) & 1) << 5) | (((lane >> 5) & 1) << 8); }
constexpr int v_rd_off(int d0, int ks, int half) { return d0 * 512 + ks * 4096 + half * 2048; }
__device__ __forceinline__ int crow(int r, int hi) { return (r & 3) + 8 * (r >> 2) + 4 * hi; }
__device__ __forceinline__ unsigned cvtpk(float lo, float hi) { unsigned r; asm volatile("v_cvt_pk_bf16_f32 %0, %1, %2" : "=v"(r) : "v"(lo), "v"(hi)); return r; }
__device__ __forceinline__ bf16x8 load8(const bf16_t* p) { return *reinterpret_cast<const bf16x8*>(p); }
__device__ __forceinline__ void mask_bits(f32x16& p0, f32x16& p1, unsigned long long w, int hi) {
    const float NEG = -__builtin_inff();
    const unsigned lo = (unsigned)w >> (4 * hi), hw = (unsigned)(w >> 32) >> (4 * hi);
#pragma unroll
    for (int r = 0; r < 16; ++r) {
        const int c = (r & 3) + 8 * (r >> 2);
        if (!((lo >> c) & 1u)) p0[r] = NEG;
        if (!((hw >> c) & 1u)) p1[r] = NEG;
    }
}
__device__ __forceinline__ void partialSM(f32x16& p0, f32x16& p1, float& m_reg, float& mn, float& alpha) {
    float pmax = p0[0]; for (int r = 1; r < 16; ++r) pmax = fmaxf(pmax, p0[r]); for (int r = 0; r < 16; ++r) pmax = fmaxf(pmax, p1[r]);
    { auto rr = __builtin_amdgcn_permlane32_swap(__float_as_uint(pmax), __float_as_uint(pmax), false, false);
      pmax = fmaxf(__uint_as_float(rr[0]), __uint_as_float(rr[1])); }
    constexpr float THR2 = THR * 1.4426950408889634f;
    if (__builtin_expect(__all(pmax <= THR2), 1)) { alpha = 1.f; }
    else { const float dl = fmaxf(pmax, 0.f); m_reg += dl; alpha = __builtin_amdgcn_exp2f(-dl);
        for (int r = 0; r < 16; ++r) { p0[r] -= dl; p1[r] -= dl; } }
    mn = m_reg;
    for (int r = 0; r < 16; ++r) p0[r] = __builtin_amdgcn_exp2f(p0[r]);
}
__device__ __forceinline__ void finishSM(f32x16& p0, f32x16& p1, float alpha, float& l_reg, bf16x8& pa0, bf16x8& pa1, bf16x8& pa2, bf16x8& pa3) {
    for (int r = 0; r < 16; ++r) p1[r] = __builtin_amdgcn_exp2f(p1[r]);
    float ps = 0; for (int r = 0; r < 16; ++r) ps += p0[r]; for (int r = 0; r < 16; ++r) ps += p1[r];
    { auto rr = __builtin_amdgcn_permlane32_swap(__float_as_uint(ps), __float_as_uint(ps), false, false);
      ps = __uint_as_float(rr[0]) + __uint_as_float(rr[1]); }
    l_reg = l_reg * alpha + ps;
#define PK4(P, B_, OUT) do { unsigned a0 = cvtpk(P[B_+0], P[B_+1]), a1 = cvtpk(P[B_+2], P[B_+3]);                          \
        unsigned b0 = cvtpk(P[B_+4], P[B_+5]), b1 = cvtpk(P[B_+6], P[B_+7]);                                             \
        auto r0 = __builtin_amdgcn_permlane32_swap(a0, b0, false, false); auto r1 = __builtin_amdgcn_permlane32_swap(a1, b1, false, false); \
        u32x4 w = {r0[0], r1[0], r0[1], r1[1]}; OUT = *reinterpret_cast<bf16x8*>(&w); } while (0)
    PK4(p0, 0, pa0); PK4(p0, 8, pa1); PK4(p1, 0, pa2); PK4(p1, 8, pa3);
#undef PK4
}
template <int KB>
__device__ __forceinline__ void qkt(f32x16& p0, f32x16& p1, const char* K_lds, int r32_, int hi_, const bf16x8* qr, unsigned long long mw, float negm) {
    const int r32 = r32_, hi = hi_;
    { const int nlo = (int)~((unsigned)mw >> (4 * hi)), nhw = (int)~((unsigned)(mw >> 32) >> (4 * hi));
      const int nb = __builtin_bit_cast(int, negm);
#pragma unroll
      for (int r = 0; r < 16; ++r) { const int c = (r & 3) + 8 * (r >> 2);
          int m0 = __builtin_amdgcn_sbfe(nlo, c, 1), m1 = __builtin_amdgcn_sbfe(nhw, c, 1);
          asm("" : "+v"(m0), "+v"(m1));
          p0[r] = __builtin_bit_cast(float, (m0 & (int)0xFF800000) | (~m0 & nb));
          p1[r] = __builtin_bit_cast(float, (m1 & (int)0xFF800000) | (~m1 & nb)); } }
    const char* kb[4];
#pragma unroll
    for (int dd = 0; dd < 4; ++dd) kb[dd] = K_lds + KB * SHM_K + KSWZ(r32, (dd * 16 + hi * 8) * 2);
    bf16x8 b0 = *reinterpret_cast<const bf16x8*>(kb[0]), b1 = *reinterpret_cast<const bf16x8*>(kb[0] + 32 * 256);
#pragma unroll
    for (int d0 = 0; d0 < 8; ++d0) {
        bf16x8 n0 = b0, n1 = b1;
        if (d0 < 7) { const char* a = kb[(d0 + 1) & 3] + ((d0 + 1) >> 2) * 128; n0 = *reinterpret_cast<const bf16x8*>(a); n1 = *reinterpret_cast<const bf16x8*>(a + 32 * 256); }
        __builtin_amdgcn_sched_barrier(0);
        p0 = __builtin_amdgcn_mfma_f32_32x32x16_bf16(b0, qr[d0], p0, 0, 0, 0);
        p1 = __builtin_amdgcn_mfma_f32_32x32x16_bf16(b1, qr[d0], p1, 0, 0, 0);
        __builtin_amdgcn_sched_barrier(0);
        b0 = n0; b1 = n1; }
}
template <int VB>
__device__ __forceinline__ void pv_tile(f32x16* o, int vbase, int lane_, bf16x8 pa0, bf16x8 pa1, bf16x8 pa2, bf16x8 pa3) {
    const int vb0 = vbase + v_rd_base(lane_);
#define TRRD(dst, off) asm volatile("ds_read_b64_tr_b16 %0, %1 offset:%2" : "=&v"(dst) : "v"(vb0), "i"(off) : "memory")
#define PV_D0(d0) do { s16x4 l0, l1, l2, l3, h0, h1, h2, h3; constexpr int b_ = VB * SHM_V + v_rd_off(d0, 0, 0); \
        TRRD(l0, b_); TRRD(h0, b_ + 2048); TRRD(l1, b_ + 4096); TRRD(h1, b_ + 6144); TRRD(l2, b_ + 8192); TRRD(h2, b_ + 10240); TRRD(l3, b_ + 12288); TRRD(h3, b_ + 14336); \
        asm volatile("s_waitcnt lgkmcnt(0)" ::: "memory"); SBAR();   \
        o[d0] = __builtin_amdgcn_mfma_f32_32x32x16_bf16(pa0, (bf16x8){l0[0], l0[1], l0[2], l0[3], h0[0], h0[1], h0[2], h0[3]}, o[d0], 0, 0, 0);   \
        o[d0] = __builtin_amdgcn_mfma_f32_32x32x16_bf16(pa1, (bf16x8){l1[0], l1[1], l1[2], l1[3], h1[0], h1[1], h1[2], h1[3]}, o[d0], 0, 0, 0);   \
        o[d0] = __builtin_amdgcn_mfma_f32_32x32x16_bf16(pa2, (bf16x8){l2[0], l2[1], l2[2], l2[3], h2[0], h2[1], h2[2], h2[3]}, o[d0], 0, 0, 0);   \
        o[d0] = __builtin_amdgcn_mfma_f32_32x32x16_bf16(pa3, (bf16x8){l3[0], l3[1], l3[2], l3[3], h3[0], h3[1], h3[2], h3[3]}, o[d0], 0, 0, 0); } while (0)
    PV_D0(0); PV_D0(1); PV_D0(2); PV_D0(3);
#undef PV_D0
#undef TRRD
}
constexpr size_t VOFF = (size_t)4 * 1024 * 1024;
struct BlockRef { const bf16_t* Q; const bf16_t* K; bf16_t* O; const unsigned long long* MW; int P0; };
struct Seam { bf16x8 qr[8]; bf16x8 st_v0, st_v1, st_k0, st_k1; };
#define ROW(p, k0, rr) ((p) + (unsigned)(((k0) + (rr)) * D + sc))
#define VMW() asm volatile("s_waitcnt vmcnt(0)" ::: "memory")
#define VMWN(n) asm volatile("s_waitcnt vmcnt(%0)" :: "i"(n) : "memory")
#define SLOAD_H(Kp, Vp, k0) do { S.st_v0 = load8(ROW(Vp, k0, sr)); S.st_v1 = load8(ROW(Vp, k0, 32 + sr));              \
                         S.st_k0 = load8(ROW(Kp, k0, sr)); S.st_k1 = load8(ROW(Kp, k0, 32 + sr)); } while (0)
#define SWOFF() int t_ = tid; asm volatile("" : "+v"(t_)); const int sr_ = t_ >> 4, sc_ = (t_ & 15) * 8
#define SWRITE_HK(bf) do { SWOFF(); const int kws_ = KSWZ(sr_, sc_ * 2); *(bf16x8*)(K_lds + (bf) * SHM_K + kws_) = S.st_k0; *(bf16x8*)(K_lds + (bf) * SHM_K + kws_ + 32 * 256) = S.st_k1; } while (0)
#define SWRITE_HV(bf) do { SWOFF(); *(bf16x8*)(V_lds + (bf) * SHM_V + v_st(sr_, sc_)) = S.st_v0; *(bf16x8*)(V_lds + (bf) * SHM_V + v_st(32 + sr_, sc_)) = S.st_v1; } while (0)
#define SWRITE_H(bf) do { SWRITE_HV(bf); SWRITE_HK(bf); } while (0)
__device__ __forceinline__ void attn_prime(const BlockRef& cur, char* lds, Seam& S, const int tid) {
    const int wid = __builtin_amdgcn_readfirstlane(tid >> 6), lane = tid & 63, r32 = lane & 31, hi = lane >> 5;
    const int sr = tid >> 4, sc = (tid & 15) * 8; char* K_lds = lds + 2 * SHM_V;
#pragma unroll
    for (int d0 = 0; d0 < 8; ++d0) S.qr[d0] = load8(cur.Q + (unsigned)((wid * QBLK + r32) * D + d0 * 16 + hi * 8));
    SLOAD_H(cur.K, cur.K + VOFF, 0); VMW(); SWRITE_HK(0);
    __syncthreads();
}
__device__ __forceinline__ void attn_block(const BlockRef& cur, const BlockRef& nxt, char* lds, Seam& S, const int tid) {
    const int wid = __builtin_amdgcn_readfirstlane(tid >> 6), lane = tid & 63, r32 = lane & 31, hi = lane >> 5;
    const int NT = (cur.P0 + QB - 1) / KVBLK + 1;
    const int mro = wid * QBLK + r32;
    char* V_lds = lds; char* K_lds = lds + 2 * SHM_V;
    float* ws = (float*)(lds + 2 * SHM_V + 2 * SHM_K) + wid * 64; float* li_l = ws, * al_l = ws + 32;
    float m_reg = 0.f, l_reg = 0; f32x16 o[4] = {};
    const int sr = tid >> 4, sc = (tid & 15) * 8;
    const int vbase = (int)(uintptr_t)V_lds;
    const bf16_t* Kh = cur.K; const bf16_t* Vh = cur.K + VOFF;
#define RESC(a) do { if (__any((a) < 1.f)) { if (hi == 0) al_l[r32] = (a); asm volatile("s_waitcnt lgkmcnt(0)" ::: "memory");              \
                     for (int d_ = 0; d_ < 4; ++d_) for (int r = 0; r < 16; ++r) o[d_][r] *= al_l[crow(r, hi)]; } } while (0)
#define KBASE(t) ((t) * KVBLK)
    f32x16 pA0, pA1, pB0, pB1; float mnA, mnB, alA, alB; bf16x8 pa0, pa1, pa2, pa3; unsigned long long mwA, mwB;
    mwA = cur.MW[mro]; mwB = cur.MW[mro + (NT > 1 ? SEQ : 0)];
    const int swk_ = KSWZ(sr, sc * 2), swv0_ = v_st(sr, sc), swv1_ = v_st(32 + sr, sc);
#define SWRITE_HK2(bf) do { *(bf16x8*)(K_lds + (bf) * SHM_K + swk_) = S.st_k0; *(bf16x8*)(K_lds + (bf) * SHM_K + swk_ + 32 * 256) = S.st_k1; } while (0)
#define SWRITE_HV2(bf) do { *(bf16x8*)(V_lds + (bf) * SHM_V + swv0_) = S.st_v0; *(bf16x8*)(V_lds + (bf) * SHM_V + swv1_) = S.st_v1; } while (0)
#define SWRITE_H2(bf) do { SWRITE_HV2(bf); SWRITE_HK2(bf); } while (0)
    SWRITE_HV2(0); SBAR();
    if (NT > 1) { SLOAD_H(Kh, Vh, KBASE(1)); }
    SBAR(); qkt<0>(pA0, pA1, K_lds, r32, hi, S.qr, mwA, -m_reg);
    partialSM(pA0, pA1, m_reg, mnA, alA);
    if (NT > 1) { VMW(); SWRITE_H2(1); }
    __syncthreads();
#define HALF_STEP(PX0, PX1, mnX, alX, mwX, mwY, PY0, PY1, alY, t, KB, VB, SB) do {                                            \
        SBAR();                                                                                                               \
          \
          \
        if (wid < 4) { qkt<KB>(PX0, PX1, K_lds, r32, hi, S.qr, mwX, -m_reg);                                                  \
            mwY = cur.MW[mro + ((t) + 1 < NT ? (t) + 1 : (t)) * SEQ];    \
            finishSM(PY0, PY1, alY, l_reg, pa0, pa1, pa2, pa3); }                                                             \
        else { mwY = cur.MW[mro + ((t) + 1 < NT ? (t) + 1 : (t)) * SEQ];                                                      \
            finishSM(PY0, PY1, alY, l_reg, pa0, pa1, pa2, pa3); SBAR();                                                       \
            qkt<KB>(PX0, PX1, K_lds, r32, hi, S.qr, mwX, -m_reg); }                                                           \
        SBAR();                                                                                                               \
        if ((t) + 1 < NT) { SLOAD_H(Kh, Vh, KBASE((t) + 1)); SBAR(); }                                               \
        pv_tile<VB>(o, vbase, lane, pa0, pa1, pa2, pa3); partialSM(PX0, PX1, m_reg, mnX, alX);                                        \
        __syncthreads();                                                                                                      \
        if ((t) + 1 < NT) { VMW(); SWRITE_H2(SB); }                                                                         \
        RESC(alX); __syncthreads(); } while (0)
    for (int t = 1; t + 1 < NT; t += 2) {
        HALF_STEP(pB0, pB1, mnB, alB, mwB, mwA, pA0, pA1, alA, t, 1, 0, 0);
        HALF_STEP(pA0, pA1, mnA, alA, mwA, mwB, pB0, pB1, alB, t + 1, 0, 1, 1);
    }
    const bool even = (NT & 1) == 0;
    if (even) { SBAR(); qkt<1>(pB0, pB1, K_lds, r32, hi, S.qr, mwB, -m_reg); SBAR(); }
    SLOAD_H(nxt.K, nxt.K + VOFF, 0); SBAR();
#pragma unroll
    for (int d0 = 0; d0 < 8; ++d0) S.qr[d0] = load8(nxt.Q + (unsigned)((wid * QBLK + r32) * D + d0 * 16 + hi * 8));
    SBAR();
    finishSM(pA0, pA1, alA, l_reg, pa0, pa1, pa2, pa3); SBAR();
    pv_tile<0>(o, vbase, lane, pa0, pa1, pa2, pa3);
    if (even) { partialSM(pB0, pB1, m_reg, mnB, alB); __syncthreads(); RESC(alB);
        finishSM(pB0, pB1, alB, l_reg, pa0, pa1, pa2, pa3); SBAR(); pv_tile<1>(o, vbase, lane, pa0, pa1, pa2, pa3); }
    SBAR(); VMWN(8); SWRITE_HK2(0); SBAR();
    if (hi == 0) li_l[r32] = l_reg; asm volatile("s_waitcnt lgkmcnt(0)" ::: "memory");
    float rli[16];
#pragma unroll
    for (int r = 0; r < 16; ++r) rli[r] = __builtin_amdgcn_rcpf(li_l[crow(r, hi)]);
    bf16_t* Ow = cur.O + (unsigned)(wid * QBLK * OSTRIDE);
    int le = lane; asm volatile("" : "+v"(le)); const int r32e = le & 31, hie = le >> 5;
#pragma unroll
    for (int r = 0; r < 16; ++r) { const int orow = crow(r, hie);
#pragma unroll
        for (int d0 = 0; d0 < 4; ++d0) { const float v = o[d0][r] * rli[r];
            const float vn = DPP_F(v, 0xB1);
            if ((r32e & 1) == 0) *(unsigned*)(Ow + (unsigned)(orow * OSTRIDE + d0 * 32 + r32e)) = cvtpk(v, vn); } }
    __syncthreads();
#undef RESC
#undef KBASE
#undef HALF_STEP
#undef SWRITE_HK2
#undef SWRITE_HV2
#undef SWRITE_H2
}
#undef ROW
#undef VMW
#undef VMWN
#undef SLOAD_H
#undef SWRITE_HK
#undef SWOFF
#undef SWRITE_HV
#undef SWRITE_H
#undef SBAR
#undef KSWZ
}

__device__ __forceinline__ bf16x8 tr_frag(int base, int off) {
    const s16x4 l = __builtin_amdgcn_ds_read_tr16_b64_v4i16((__attribute__((address_space(3))) s16x4*)(base + off)), h = __builtin_amdgcn_ds_read_tr16_b64_v4i16((__attribute__((address_space(3))) s16x4*)(base + off + 2048));
    return (bf16x8){l[0], l[1], l[2], l[3], h[0], h[1], h[2], h[3]}; }
typedef const __attribute__((address_space(4))) KArgs* KArgsCP;
__device__ __forceinline__ KArgsCP kargs() { KArgsCP p = (KArgsCP)__builtin_amdgcn_kernarg_segment_ptr(); asm volatile("" : "+s"(p)); return p; }
__device__ __forceinline__ KArgs load_kargs() { KArgsCP p = kargs(); KArgs a;
    a.x = p->x; a.pos = p->pos; a.ffn1_norm = p->ffn1_norm; a.ffn1_wi = p->ffn1_wi; a.ffn1_wo = p->ffn1_wo; a.mix_norm = p->mix_norm; a.ffn2_norm = p->ffn2_norm; a.ffn2_wi = p->ffn2_wi; a.ffn2_wo = p->ffn2_wo;
    a.even_w_in = p->even_w_in; a.gate_w = p->gate_w; a.gate_b = p->gate_b; a.out_norm = p->out_norm; a.pool_w = p->pool_w; a.pool_scale = p->pool_scale; a.even_w_out = p->even_w_out; a.odd_w_in = p->odd_w_in;
    a.odd_w_out = p->odd_w_out; a.final_norm = p->final_norm; a.out = p->out; a.ws = p->ws; return a; }
__device__ __forceinline__ int opaque_lane() { int l; asm volatile("v_mbcnt_lo_u32_b32 %0, -1, 0\n\tv_mbcnt_hi_u32_b32 %0, -1, %0" : "=v"(l)); return l; }
__device__ __forceinline__ int fresh_tid_(int wv) { return (wv << 6) | opaque_lane(); }
#define fresh_tid() fresh_tid_(wv_)
__device__ __forceinline__ float wave_sum(float v) {
    v += DPP_F(v, 0xB1); v += DPP_F(v, 0x4E); v += DPP_F(v, 0x141); v += DPP_F(v, 0x140);
    return (__builtin_bit_cast(float, __builtin_amdgcn_readlane(__builtin_bit_cast(int, v), 0)) + __builtin_bit_cast(float, __builtin_amdgcn_readlane(__builtin_bit_cast(int, v), 16)))
         + (__builtin_bit_cast(float, __builtin_amdgcn_readlane(__builtin_bit_cast(int, v), 32)) + __builtin_bit_cast(float, __builtin_amdgcn_readlane(__builtin_bit_cast(int, v), 48)));
}
__constant__ float INV128[64] = {1.0f, 0.8659643530845642f, 0.7498942613601685f, 0.6493816375732422f, 0.5623413324356079f, 0.486967533826828f, 0.4216965138912201f, 0.3651741147041321f, 0.3162277638912201f, 0.2738419771194458f, 0.23713737726211548f, 0.20535250008106232f, 0.17782793939113617f, 0.1539926528930664f, 0.133352130651474f, 0.11547820270061493f, 0.10000000149011612f, 0.08659642934799194f, 0.07498941570520401f, 0.06493816524744034f, 0.05623413249850273f, 0.04869675263762474f, 0.04216965287923813f, 0.03651741147041321f, 0.03162277489900589f, 0.02738419733941555f, 0.023713737726211548f, 0.02053525112569332f, 0.017782794311642647f, 0.015399265103042126f, 0.01333521492779255f, 0.011547820642590523f, 0.009999999776482582f, 0.00865964312106371f, 0.007498941849917173f, 0.006493816152215004f, 0.005623413249850273f, 0.004869675263762474f, 0.0042169648222625256f, 0.0036517411936074495f, 0.003162277629598975f, 0.0027384196873754263f, 0.00237137358635664f, 0.0020535248331725597f, 0.0017782794311642647f, 0.0015399265103042126f, 0.0013335214462131262f, 0.0011547819012776017f, 0.0010000000474974513f, 0.0008659643353894353f, 0.0007498942431993783f, 0.0006493816617876291f, 0.000562341301701963f, 0.0004869675321970135f, 0.0004216965171508491f, 0.0003651741426438093f, 0.0003162277571391314f, 0.00027384195709601045f, 0.00023713737027719617f, 0.00020535250951070338f, 0.00017782794020604342f, 0.00015399264520965517f, 0.0001333521504420787f, 0.00011547820031410083f};

__device__ __forceinline__ void sincos_acc(float ang, float& c, float& s) {
    const double a = (double)ang;
    const double k = __builtin_rint(a * 0.63661977236758134308);
    double r = __builtin_fma(-k, 1.57079632679489661923, a);
    r = __builtin_fma(-k, 6.123233995736766e-17, r);
    const double r2 = r * r;
    double sp = -2.5052108385441718775e-8;
    sp = __builtin_fma(sp, r2, 2.7557319223985890653e-6);
    sp = __builtin_fma(sp, r2, -1.9841269841269841270e-4);
    sp = __builtin_fma(sp, r2, 8.3333333333333333333e-3);
    sp = __builtin_fma(sp, r2, -1.6666666666666666667e-1);
    const double sr = __builtin_fma(sp * r2, r, r);
    double cp = 2.0876756987868098979e-9;
    cp = __builtin_fma(cp, r2, -2.7557319223985890653e-7);
    cp = __builtin_fma(cp, r2, 2.4801587301587301587e-5);
    cp = __builtin_fma(cp, r2, -1.3888888888888888889e-3);
    cp = __builtin_fma(cp, r2, 4.1666666666666666667e-2);
    cp = __builtin_fma(cp, r2, -0.5);
    const double cr = __builtin_fma(cp, r2, 1.0);
    const int q = (int)((long long)k & 3);
    const double cc = (q == 0) ? cr : (q == 1) ? -sr : (q == 2) ? -cr : sr;
    const double ss = (q == 0) ? sr : (q == 1) ? cr : (q == 2) ? -sr : -cr;
    c = (float)cc; s = (float)ss;
}

enum { J_WI = 0, J_WO = 1, J_EVIN = 2, J_ODIN = 3, J_PLAIN = 4 };
__device__ __forceinline__ int dst_row(int job, int j) {
    switch (job) {
    case J_WI: { const int half = j >= DFF ? 1 : 0, jj = j - half * DFF; return (jj >> 7) * 256 + half * 128 + (jj & 127); }
    case J_EVIN: return j < 1536 ? j : (j < 1552 ? -1 : 1792 + (j - 1552));
    case J_ODIN: if (j < 1280) { const int d = j & 127; return (j & ~127) + 2 * (d & 63) + (d >> 6); }
                 if (j < 1536) return j;
                 if (j < 1856) { const int d = j & 63; return (j & ~63) + 2 * (d & 31) + (d >> 5); }
                 return j;
    default: return j;
    }
}
__device__ __forceinline__ void conv_item(const float* W, int N, int K, const float* gain, bf16_t* WT, int job, int k0, int c0, LAS unsigned char* scr, int lane) {
    const int c4 = lane & 15, kr = lane >> 4, col = c0 + 4 * c4;
    f32x4 v[16];
    const bool ok = col < N;
    const float* src = W + (size_t)(k0 + kr * 16) * N + col;
#pragma unroll
    for (int i = 0; i < 16; ++i) v[i] = ok ? __builtin_nontemporal_load((const f32x4*)(src + (size_t)i * N)) : (f32x4){0.f, 0.f, 0.f, 0.f};
    if (gain) {
        const f32x4* gp = (const f32x4*)(gain + k0 + kr * 16);
#pragma unroll
        for (int q = 0; q < 4; ++q) { const f32x4 g4 = gp[q];
#pragma unroll
            for (int e = 0; e < 4; ++e) v[4 * q + e] = v[4 * q + e] * g4[e]; }
    }
#pragma unroll
    for (int e = 0; e < 4; ++e) {
        u32x4 w0, w1;
        w0.x = cvt_pk_bf16(v[0][e], v[1][e]); w0.y = cvt_pk_bf16(v[2][e], v[3][e]); w0.z = cvt_pk_bf16(v[4][e], v[5][e]); w0.w = cvt_pk_bf16(v[6][e], v[7][e]);
        w1.x = cvt_pk_bf16(v[8][e], v[9][e]); w1.y = cvt_pk_bf16(v[10][e], v[11][e]); w1.z = cvt_pk_bf16(v[12][e], v[13][e]); w1.w = cvt_pk_bf16(v[14][e], v[15][e]);
        LAS unsigned char* d = scr + (4 * c4 + e) * 144 + kr * 32;
        *(LAS u32x4*)d = w0; *(LAS u32x4*)(d + 16) = w1;
    }
    asm volatile("s_waitcnt lgkmcnt(0)" ::: "memory");
#pragma unroll
    for (int j = 0; j < 8; ++j) {
        const int cl = (lane >> 3) + 8 * j, ch = lane & 7, sc_ = c0 + cl;
        const u32x4 w = *(const LAS u32x4*)(scr + cl * 144 + ch * 16);
        const int n = sc_ < N ? dst_row(job, sc_) : -1;
        if (n >= 0) *(u32x4*)(WT + (size_t)n * K + k0 + ch * 8) = w;
    }
    asm volatile("s_waitcnt lgkmcnt(0)" ::: "memory");
}


constexpr int C_WI = NFF / 64, I_WI = (DM / 64) * C_WI, C_WO = DM / 64, I_WO = (DFF / 64) * C_WO, C_EV = (EVEN_IN + 63) / 64, I_EV = (DM / 64) * C_EV, C_OD = (ODD_IN + 63) / 64, I_OD = (DM / 64) * C_OD;
constexpr int I_EO = 8 * 16, I_OO = 16 * 16;
constexpr int CV_WO0 = 4 * I_WI, CV_EV = CV_WO0 + 4 * I_WO, CV_OD = CV_EV + I_EV, CV_EO = CV_OD + I_OD, CV_OO = CV_EO + I_EO, CV_END = CV_OO + I_OO;
#define CV_WI(sub) ((sub) * I_WI)
#define CV_WO(sub) (CV_WO0 + (sub) * I_WO)
__device__ __forceinline__ void conv_range(const KArgs& A, unsigned char* ws, int lo, int hi, int widx, int nw, LAS unsigned char* scr, int lane) {
    for (int it = lo + widx; it < hi; it += nw) {
        int r = it;
        if (r < 4 * I_WI) { const int sub = r / I_WI, q = r % I_WI, l = sub >> 1, f = sub & 1;
            conv_item((f ? A.ffn2_wi : A.ffn1_wi) + (size_t)l * DM * NFF, NFF, DM, (f ? A.ffn2_norm : A.ffn1_norm) + l * DM, (bf16_t*)(ws + WS_WIT + (size_t)sub * 11 * MiB), J_WI, (q / C_WI) * 64, (q % C_WI) * 64, scr, lane); continue; } r -= 4 * I_WI;
        if (r < 4 * I_WO) { const int sub = r / I_WO, q = r % I_WO, l = sub >> 1, f = sub & 1;
            conv_item((f ? A.ffn2_wo : A.ffn1_wo) + (size_t)l * DFF * DM, DM, DFF, nullptr, (bf16_t*)(ws + WS_WOT + (size_t)sub * 5632 * 1024), J_WO, (q / C_WO) * 64, (q % C_WO) * 64, scr, lane); continue; } r -= 4 * I_WO;
        if (r < I_EV) { conv_item(A.even_w_in, EVEN_IN, DM, A.mix_norm, (bf16_t*)(ws + WS_EVIN), J_EVIN, (r / C_EV) * 64, (r % C_EV) * 64, scr, lane); continue; } r -= I_EV;
        if (r < I_OD) { conv_item(A.odd_w_in, ODD_IN, DM, A.mix_norm + DM, (bf16_t*)(ws + WS_ODIN), J_ODIN, (r / C_OD) * 64, (r % C_OD) * 64, scr, lane); continue; } r -= I_OD;
        if (r < I_EO) { conv_item(A.even_w_out, DM, DM, nullptr, (bf16_t*)(ws + WS_EVOUT), J_PLAIN, (r / 16) * 64, (r % 16) * 64, scr, lane); continue; } r -= I_EO;
        conv_item(A.odd_w_out, DM, DM, nullptr, (bf16_t*)(ws + WS_ODOUT), J_PLAIN, (r / 16) * 64, (r % 16) * 64, scr, lane);
    }
}
__device__ __forceinline__ void conv_extras_even(const KArgs& A, unsigned char* ws, int widx, int nw, int lane) {
    for (int it = widx; it < 128 * 4; it += nw) {
        const int kc = it >> 2, j = (it & 3) * 64 + lane, k0 = kc * 8;
        float gwv[16];
#pragma unroll
        for (int r = 0; r < 16; ++r) gwv[r] = A.gate_w[r * 256 + j];
        float o[8];
#pragma unroll
        for (int e = 0; e < 8; ++e) { const f32x4* wp = (const f32x4*)(A.even_w_in + (size_t)(k0 + e) * EVEN_IN + 1536); float sacc = 0.f;
#pragma unroll
            for (int q = 0; q < 4; ++q) { const f32x4 w4 = wp[q]; sacc += w4[0] * gwv[4 * q] + w4[1] * gwv[4 * q + 1] + w4[2] * gwv[4 * q + 2] + w4[3] * gwv[4 * q + 3]; }
            o[e] = sacc * A.mix_norm[k0 + e]; }
        *(u32x4*)((bf16_t*)(ws + WS_EVIN) + (size_t)(1536 + j) * DM + k0) = pack8((f32x4){o[0], o[1], o[2], o[3]}, (f32x4){o[4], o[5], o[6], o[7]});
    }
    for (int it = widx; it < 16 * 4 * 32; it += nw) {
        const int ng = it & 15, g = (it >> 4) & 3, cc = it >> 6, n = ng * 64 + lane, ci0 = cc * 4;
        const float* pw = A.pool_w + ((size_t)g * 128 + ci0) * 128; const float* ps = A.pool_scale + g * 128; const float* wo = A.even_w_out + (size_t)(512 + g * 128) * DM + n;
        float o[4] = {0.f, 0.f, 0.f, 0.f};
#pragma unroll 1
        for (int d0 = 0; d0 < 128; d0 += 32) {
            float wv_[32];
#pragma unroll
            for (int dd = 0; dd < 32; ++dd) wv_[dd] = wo[(size_t)(d0 + dd) * DM];
#pragma unroll
            for (int dd = 0; dd < 32; ++dd) { const float x = wv_[dd] * ps[d0 + dd];
#pragma unroll
                for (int e = 0; e < 4; ++e) o[e] += pw[e * 128 + d0 + dd] * x; }
        }
        u32x2 w; w.x = cvt_pk_bf16(o[0], o[1]); w.y = cvt_pk_bf16(o[2], o[3]);
        *(u32x2*)((bf16_t*)(ws + WS_EVOUT) + (size_t)n * DM + 512 + g * 128 + ci0) = w;
    }
}
__device__ __forceinline__ void conv_zero_pad_odd(unsigned char* ws, int widx, int nw, int lane) {
    bf16_t* zp = (bf16_t*)(ws + WS_ODIN) + (size_t)ODD_IN * DM;
    unsigned z_ = 0u; asm volatile("" : "+v"(z_));
    for (int idx = widx * 64 + lane; idx < (ODD_N - ODD_IN) * DM / 8; idx += nw * 64) *(u32x4*)(zp + (size_t)idx * 8) = (u32x4){z_, z_, z_, z_};
}

template <int W> __device__ __forceinline__ void pool_item(const bf16_t* U, bf16_t* mix, int m, int c0, int s) {
    u32x4 r[W];
#pragma unroll
    for (int i = 0; i < W; ++i) r[i] = *(const u32x4*)(U + (size_t)(s >= i ? m - i : m) * 512 + c0);
    float sum[8] = {0.f, 0.f, 0.f, 0.f, 0.f, 0.f, 0.f, 0.f}, cur[8];
#pragma unroll
    for (int i = 0; i < W; ++i) { const float wgt = (s >= i) ? 1.f : 0.f; const unsigned w4[4] = {r[i].x, r[i].y, r[i].z, r[i].w};
#pragma unroll
        for (int e = 0; e < 8; ++e) { const float v = bf2f((e & 1) ? (w4[e >> 1] >> 16) : (w4[e >> 1] & 0xffffu)); if (i == 0) cur[e] = v; sum[e] += wgt * v; } }
    const float ic = 1.0f / (float)((s + 1 < W) ? s + 1 : W);
    f32x4 o0, o1;
#pragma unroll
    for (int e = 0; e < 4; ++e) { o0[e] = sum[e] * ic - cur[e]; o1[e] = sum[4 + e] * ic - cur[4 + e]; }
    *(u32x4*)(mix + (size_t)m * DM + 512 + c0) = pack8(o0, o1);
}
#define XB_TMO      128
#define XB_XCNT(j)  (256  + 64 * (j))
#define XB_XSUB(j)  (1280 + 64 * (j))
#define XB_XGEN(j)  (2304 + 64 * (j))
#define XB_TOP      3328
#define XB_TOPGEN   3392
#define XCD_BAR_WORDS 3456
#define XB_SPIN_CAP (1u << 18)
__device__ __forceinline__ unsigned xb_ld(unsigned* p)              { return __hip_atomic_load(p, __ATOMIC_RELAXED, __HIP_MEMORY_SCOPE_AGENT); }
__device__ __forceinline__ unsigned xb_add(unsigned* p, unsigned v) { return __hip_atomic_fetch_add(p, v, __ATOMIC_RELAXED, __HIP_MEMORY_SCOPE_AGENT); }
__device__ __forceinline__ unsigned xb_xcc_id() { return (unsigned)__builtin_amdgcn_s_getreg((3 << 11) | 20) & 0xFu; }
#define XB_SPIN(cond, bar) do { unsigned _sp = 0; while (cond) { __builtin_amdgcn_s_sleep(1); \
    if ((++_sp & 255u) == 0u) { if (xb_ld(&(bar)[XB_TMO])) break; if (_sp > XB_SPIN_CAP) { atomicAdd(&(bar)[XB_TMO], 1u); break; } } } } while (0)
struct XcdBarrier { unsigned* bar; unsigned x; volatile LAS unsigned* st; };
__device__ __forceinline__ XcdBarrier xcd_barrier_post(unsigned* bar, volatile LAS unsigned* st) {
    XcdBarrier b; b.bar = bar; b.x = xb_xcc_id(); b.st = st;
    if (threadIdx.x == 0) (void)xb_add(&bar[XB_XCNT(b.x)], 1u);
    return b;
}
__device__ __forceinline__ void xcd_barrier_complete(unsigned* bar, unsigned x, unsigned& nloc, unsigned& nx) {
    const unsigned G = gridDim.x * gridDim.y * gridDim.z;
    unsigned sum, cnt, mine, sp = 0u;
    for (;;) {
        sum = 0u; cnt = 0u; mine = 0u;
#pragma unroll
        for (unsigned j = 0; j < 16; ++j) { const unsigned c = xb_ld(&bar[XB_XCNT(j)]); sum += c; cnt += (c > 0u) ? 1u : 0u; mine = (j == x) ? c : mine; }
        if (sum == G) break;
        __builtin_amdgcn_s_sleep(1);
        if ((++sp & 255u) == 0u) { if (xb_ld(&bar[XB_TMO])) break; if (sp > XB_SPIN_CAP) { atomicAdd(&bar[XB_TMO], 1u); break; } }
    }
    nloc = mine > 0u ? mine : 1u; nx = cnt > 0u ? cnt : 1u;
}
__device__ __forceinline__ void xcd_barrier(const XcdBarrier& b, const int wv) {
    asm volatile("s_waitcnt vmcnt(0)" ::: "memory");
    __syncthreads();
    if (wv == 0 && opaque_lane() == 0) {
        unsigned* bar = b.bar;
        __builtin_amdgcn_s_waitcnt(0);
        unsigned nloc = b.st[0], nx = b.st[1];
        if (nloc == 0u) { xcd_barrier_complete(bar, b.x, nloc, nx); b.st[0] = nloc; b.st[1] = nx; }
        const unsigned old = xb_add(&bar[XB_XSUB(b.x)], 1u);
        const unsigned gen = old / nloc;
        if (old + 1u == (gen + 1u) * nloc) {
            __builtin_amdgcn_fence(__ATOMIC_RELEASE, "agent");
            asm volatile("s_waitcnt vmcnt(0)" ::: "memory");
            const unsigned og = xb_add(&bar[XB_TOP], 1u);
            const unsigned tg = og / nx;
            if (og + 1u == (tg + 1u) * nx) xb_add(&bar[XB_TOPGEN], 1u);
            else XB_SPIN(xb_ld(&bar[XB_TOPGEN]) == tg, bar);
            __builtin_amdgcn_fence(__ATOMIC_ACQUIRE, "agent");
            xb_add(&bar[XB_XGEN(b.x)], 1u);
            asm volatile("s_waitcnt vmcnt(0)" ::: "memory");
        } else {
            XB_SPIN(xb_ld(&bar[XB_XGEN(b.x)]) == gen, bar);
            __builtin_amdgcn_fence(__ATOMIC_ACQUIRE, "agent");
            asm volatile("s_waitcnt vmcnt(0)" ::: "memory");
        }
    }
    __syncthreads();
}

__device__ __forceinline__ void cnt_ge4(unsigned& a0, unsigned& a1, unsigned& a2, unsigned& a3, unsigned k0, unsigned k1, unsigned k2, unsigned k3, unsigned cand) {
    unsigned long long m0, m1, m2, m3;
    asm volatile("v_cmp_ge_u32_e64 %4, %8, %12\n\t"
                 "v_cmp_ge_u32_e64 %5, %9, %12\n\t"
                 "v_cmp_ge_u32_e64 %6, %10, %12\n\t"
                 "v_cmp_ge_u32_e64 %7, %11, %12\n\t"
                 "v_addc_co_u32_e64 %0, %4, 0, %0, %4\n\t"
                 "v_addc_co_u32_e64 %1, %5, 0, %1, %5\n\t"
                 "v_addc_co_u32_e64 %2, %6, 0, %2, %6\n\t"
                 "v_addc_co_u32_e64 %3, %7, 0, %3, %7"
                 : "+v"(a0), "+v"(a1), "+v"(a2), "+v"(a3), "=&s"(m0), "=&s"(m1), "=&s"(m2), "=&s"(m3)
                 : "v"(k0), "v"(k1), "v"(k2), "v"(k3), "s"(cand));
}
__device__ __forceinline__ int wave_sum_u32(unsigned x) {
    x += (unsigned)__builtin_amdgcn_update_dpp(0, (int)x, 0xB1, 0xf, 0xf, true);
    x += (unsigned)__builtin_amdgcn_update_dpp(0, (int)x, 0x4E, 0xf, 0xf, true);
    x += (unsigned)__builtin_amdgcn_update_dpp(0, (int)x, 0x141, 0xf, 0xf, true);
    x += (unsigned)__builtin_amdgcn_update_dpp(0, (int)x, 0x140, 0xf, 0xf, true);
    return (int)(__builtin_amdgcn_readlane((int)x, 0) + __builtin_amdgcn_readlane((int)x, 16) + __builtin_amdgcn_readlane((int)x, 32) + __builtin_amdgcn_readlane((int)x, 48));
}

__device__ __forceinline__ unsigned wave_prefix_incl_u32(unsigned x, int lane) {
    x += (unsigned)__builtin_amdgcn_update_dpp(0, (int)x, 0x111, 0xf, 0xf, false);
    x += (unsigned)__builtin_amdgcn_update_dpp(0, (int)x, 0x112, 0xf, 0xf, false);
    x += (unsigned)__builtin_amdgcn_update_dpp(0, (int)x, 0x114, 0xf, 0xf, false);
    x += (unsigned)__builtin_amdgcn_update_dpp(0, (int)x, 0x118, 0xf, 0xf, false);
    const unsigned r0 = (unsigned)__builtin_amdgcn_readlane((int)x, 15), r1 = (unsigned)__builtin_amdgcn_readlane((int)x, 31), r2 = (unsigned)__builtin_amdgcn_readlane((int)x, 47);
    const int row = lane >> 4;
    return x + (row > 0 ? r0 : 0u) + (row > 1 ? r1 : 0u) + (row > 2 ? r2 : 0u);
}
__device__ __forceinline__ unsigned wave_max_u32(unsigned x) {
    unsigned y;
    y = (unsigned)__builtin_amdgcn_update_dpp(0, (int)x, 0xB1, 0xf, 0xf, true); x = x > y ? x : y;
    y = (unsigned)__builtin_amdgcn_update_dpp(0, (int)x, 0x4E, 0xf, 0xf, true); x = x > y ? x : y;
    y = (unsigned)__builtin_amdgcn_update_dpp(0, (int)x, 0x141, 0xf, 0xf, true); x = x > y ? x : y;
    y = (unsigned)__builtin_amdgcn_update_dpp(0, (int)x, 0x140, 0xf, 0xf, true); x = x > y ? x : y;
    const unsigned a = (unsigned)__builtin_amdgcn_readlane((int)x, 0), b = (unsigned)__builtin_amdgcn_readlane((int)x, 16), c = (unsigned)__builtin_amdgcn_readlane((int)x, 32), d = (unsigned)__builtin_amdgcn_readlane((int)x, 48);
    const unsigned ab = a > b ? a : b, cd = c > d ? c : d; return ab > cd ? ab : cd;
}

__global__ void __launch_bounds__(512, 2) fwd_megakernel(KArgs Aarg) {
    extern __shared__ __attribute__((aligned(16))) unsigned char lds[];
    cg::grid_group grid = cg::this_grid();
    (void)Aarg;
    const int G = gridDim.x, bx = blockIdx.x;
    const int wv_ = __builtin_amdgcn_readfirstlane((int)threadIdx.x >> 6);
    const int vcu = (G % 8 == 0) ? (bx % 8) * (G / 8) + bx / 8 : bx;
    LAS unsigned char* ldsl = (LAS unsigned char*)lds;
#define PHASE_ARGS() const KArgs A = load_kargs(); unsigned char* const ws = A.ws; (void)ws
#define PHASE_IDS() PHASE_ARGS(); const int tid = fresh_tid(), lane = tid & 63, wave = __builtin_amdgcn_readfirstlane(tid >> 6); const int gw = vcu * 8 + wave, NGW = G * 8; (void)lane; (void)gw; (void)NGW
#define SSQ ((float*)(ws + WS_SSQ))
#define DVEC ((float*)(ws + WS_DVEC))
#define WI1 ((float*)(ws + WS_WI1))
#define HB ((bf16_t*)(ws + WS_HB))
#define HID ((bf16_t*)(ws + WS_HID))
#define CS ((unsigned*)(ws + WS_CS))
#define QK0 ((bf16_t*)(ws + WS_QK0))
#define V0 ((bf16_t*)(ws + WS_V0))
#define G0 ((bf16_t*)(ws + WS_G0))
#define U0 ((bf16_t*)(ws + WS_U0))
#define LA ((float*)(ws + WS_LA))
#define ST0 ((bf16_t*)(ws + WS_ST0))
#define MIX ((bf16_t*)(ws + WS_MIX))
#define Q1 ((bf16_t*)(ws + WS_Q1))
#define K1 ((bf16_t*)(ws + WS_K1))
#define V1 ((bf16_t*)(ws + WS_V1))
#define QIH ((bf16_t*)(ws + WS_QIH))
#define QIL ((bf16_t*)(ws + WS_QIL))
#define KIH ((bf16_t*)(ws + WS_KIH))
#define KIL ((bf16_t*)(ws + WS_KIL))
#define MASK ((unsigned long long*)(ws + WS_MASK))
    for (int u_ = threadIdx.x; u_ < (LDS_BYTES - RING_BYTES) / 4; u_ += 512) ((LAS unsigned*)(ldsl + RING_BYTES))[u_] = 0u;
    __syncthreads();
    XcdBarrier xbar;
    { KArgsCP kp_ = kargs(); xbar = xcd_barrier_post((unsigned*)(kp_->ws + WS_CTL) + 4096, (volatile LAS unsigned*)(ldsl + RING_BYTES + 512)); }
#define GSYNC() xcd_barrier(xbar, wv_)

#ifndef NO_P0
    for (int dup_ = 0; dup_ < NDUP_P0; ++dup_) { if (dup_) { GSYNC(); }
    {
        PHASE_IDS();
        LAS unsigned char* scr = ldsl + wave * 16384;
        conv_range(A, ws, CV_WI(0), CV_WI(1), gw, NGW, scr, lane);
        if (G != 256) { conv_range(A, ws, CV_WI(1), CV_END, gw, NGW, scr, lane); conv_extras_even(A, ws, gw, NGW, lane); conv_zero_pad_odd(ws, gw, NGW, lane); }
        for (int m0 = gw * 4; m0 < M; m0 += NGW * 4) {
            f32x4 v[4][4];
#pragma unroll
            for (int i = 0; i < 4; ++i) { const f32x4* xr = (const f32x4*)(A.x + (size_t)(m0 + i) * DM) + lane;
#pragma unroll
                for (int j = 0; j < 4; ++j) v[i][j] = __builtin_nontemporal_load(xr + 64 * j); }
#pragma unroll
            for (int i = 0; i < 4; ++i) { const int m = m0 + i; float s = 0.f;
#pragma unroll
                for (int j = 0; j < 4; ++j) s += (v[i][j][0] * v[i][j][0] + v[i][j][1] * v[i][j][1]) + (v[i][j][2] * v[i][j][2] + v[i][j][3] * v[i][j][3]);
                s = wave_sum(s);
                u32x2* o8 = (u32x2*)(HB + (size_t)m * DM) + lane;
#pragma unroll
                for (int j = 0; j < 4; ++j) { u32x2 w; w.x = cvt_pk_bf16(v[i][j][0], v[i][j][1]); w.y = cvt_pk_bf16(v[i][j][2], v[i][j][3]); o8[64 * j] = w; }
                if (lane < 16) SSQ[(size_t)m * 16 + lane] = (lane == 0) ? s : 0.f; }
        }
        for (int idx = (vcu * 512 + tid); idx < M * 64; idx += G * 512) {
            const int m = idx >> 6, i = idx & 63;
            const float ang = (float)A.pos[m] * INV128[i];
            float c, s; sincos_acc(ang, c, s);
            CS[idx] = (unsigned)__builtin_bit_cast(unsigned short, (_Float16)c) | ((unsigned)__builtin_bit_cast(unsigned short, (_Float16)s) << 16);
        }
    }
    }
#endif
    { KArgsCP kp_ = kargs(); if (kp_->ws == nullptr) grid.sync(); }
    GSYNC();

    for (int li = 0; li < 2; ++li) {
        for (int f = 0; f < 2; ++f) {
            if (f == 1) {
                if (li == 0) {
#ifndef NO_PROJ0
    for (int dup_ = 0; dup_ < NDUP_PROJ0; ++dup_) { if (dup_) { GSYNC(); }
                    { PHASE_ARGS(); pg8::Gemm g{HB, (const bf16_t*)(ws + WS_EVIN), M, EVEN_N, DM}; pg8::StaticOrder S; S.init(M, EVEN_N, G, bx);
                      pg8::EpiP0 E{SSQ, A.gate_b, QK0, V0, G0, U0, LA};
                      pg8::gemm_phase<pg8::EpiP0, pg8::StaticOrder, true, true>(ldsl, g, S, E, fresh_tid()); }
                    if (bx >= 64 && G == 256) { PHASE_IDS(); const int widx = (bx - 64) * 8 + wave, nw = 192 * 8; LAS unsigned char* scr = ldsl + wave * 16384;
                        conv_range(A, ws, CV_WI(1), CV_WI(2), widx, nw, scr, lane); conv_range(A, ws, CV_WO(1), CV_WO(2), widx, nw, scr, lane); }
    }
#endif
                    GSYNC();
#ifndef NO_G1
    for (int dup_ = 0; dup_ < NDUP_G1; ++dup_) { if (dup_) { GSYNC(); }
                    {
                        PHASE_IDS();
                        LAS float* BL = (LAS float*)ldsl; LAS float* TOT = (LAS float*)(ldsl + 16384); LAS unsigned char* KDT = ldsl + 18432; LAS unsigned char* VT = ldsl + 46080;
                        const int r32 = lane & 31, hh = lane >> 5;
                        for (int unit = vcu; unit < 1024; unit += G) {
                            const int bh = unit >> 6, n = unit & 63, b = bh >> 2, h = bh & 3; const size_t m0 = (size_t)b * SEQ + n * 64;
                            float lav[8];
#pragma unroll
                            for (int i = 0; i < 8; ++i) lav[i] = LA[(m0 + wave * 8 + i) * 256 + h * 64 + lane];
                            const u32x4 kq_p = *(const u32x4*)(QK0 + (m0 + (tid >> 3)) * 512 + 256 + h * 64 + (tid & 7) * 8);
                            u32x4 vq_p[2];
#pragma unroll
                            for (int c2 = 0; c2 < 2; ++c2) { const int c = tid + 512 * c2; vq_p[c2] = *(const u32x4*)(V0 + (m0 + (c >> 4)) * 512 + h * 128 + (c & 15) * 8); }
                            { const int d = lane; float pr[8]; float run = 0.f;
#pragma unroll
                              for (int i = 0; i < 8; ++i) { run += lav[i]; pr[i] = run; }
                              TOT[wave * 64 + d] = run; __syncthreads();
                              float tv_[8];
#pragma unroll
                              for (int s_ = 0; s_ < 8; ++s_) tv_[s_] = TOT[s_ * 64 + d];
                              float off = 0.f;
#pragma unroll
                              for (int s_ = 0; s_ < 7; ++s_) off += (s_ < wave) ? tv_[s_] : 0.f;
#pragma unroll
                              for (int i = 0; i < 8; ++i) BL[(wave * 8 + i) * 64 + d] = off + pr[i]; }
                            __syncthreads();
                            { const int t = tid >> 3, d0 = (tid & 7) * 8;
                              const u32x4 kq = kq_p;
                              const unsigned kw[4] = {kq.x, kq.y, kq.z, kq.w};
                              float xf[8];
#pragma unroll
                              for (int i = 0; i < 8; ++i) { const float kv = bf2f((i & 1) ? (kw[i >> 1] >> 16) : (kw[i >> 1] & 0xffffu));
                                  xf[i] = kv * __expf(BL[63 * 64 + d0 + i] - BL[t * 64 + d0 + i]); }
                              *(LAS u32x4*)(KDT + att::v_st(t, d0)) = pack8((f32x4){xf[0], xf[1], xf[2], xf[3]}, (f32x4){xf[4], xf[5], xf[6], xf[7]});
                              if (tid < 64) DVEC[unit * 64 + tid] = __expf(BL[63 * 64 + tid]);
#pragma unroll
                              for (int c2 = 0; c2 < 2; ++c2) { const int c = tid + 512 * c2, tt = c >> 4, e0 = (c & 15) * 8;
                                  *(LAS u32x4*)(VT + att::v_st(tt, e0)) = vq_p[c2]; } }
                            __syncthreads();
                            { const int dt = wave >> 2, et = wave & 3; f32x16 c = {};
                              const int kb0_ = (int)(uintptr_t)KDT + att::v_rd_base(lane), vb0_ = (int)(uintptr_t)VT + att::v_rd_base(lane);
#pragma unroll
                              for (int ks = 0; ks < 4; ++ks) { const bf16x8 a = tr_frag(kb0_, att::v_rd_off(dt, ks, 0)), bb = tr_frag(vb0_, att::v_rd_off(et, ks, 0));
                                  c = __builtin_amdgcn_mfma_f32_32x32x16_bf16(a, bb, c, 0, 0, 0); }
                              bf16_t* dst = ST0 + (size_t)unit * 8192 + (32 * et + r32) * 64 + 32 * dt + 4 * hh;
#pragma unroll
                              for (int g4 = 0; g4 < 4; ++g4) { u32x2 w; w.x = cvt_pk_bf16(c[4 * g4], c[4 * g4 + 1]); w.y = cvt_pk_bf16(c[4 * g4 + 2], c[4 * g4 + 3]); *(u32x2*)(dst + 8 * g4) = w; } }
                            __syncthreads();
                        }
                        for (int idx = vcu * 512 + tid; idx < 4 * M * 16; idx += G * 512) {
                            const int gi = idx / (M * 16), rem = idx - gi * (M * 16), m = rem >> 4, c0 = gi * 128 + (rem & 15) * 8, s = m & (SEQ - 1);
                            if (gi == 0) pool_item<2>(U0, MIX, m, c0, s); else if (gi == 1) pool_item<4>(U0, MIX, m, c0, s); else if (gi == 2) pool_item<8>(U0, MIX, m, c0, s); else pool_item<16>(U0, MIX, m, c0, s);
                        }
                    }
    }
#endif
                    GSYNC();
#ifndef NO_G2
                    { PHASE_IDS();
                    if (wave < 4) for (int it = (vcu * 4 + wave) * 64 + lane; it < 16 * 4096; it += G * 256) {
                        const int bh = it >> 12, de = (it & 4095) * 2, d = de & 63;
                        bf16_t* p = ST0 + (size_t)bh * 64 * 8192 + de; const float* dv = DVEC + bh * 64 * 64 + d;
                        unsigned uu[64];
#pragma unroll
                        for (int n = 0; n < 64; ++n) uu[n] = *(const unsigned*)(p + (size_t)n * 8192);
                        float s0 = 0.f, s1 = 0.f;
#pragma unroll
                        for (int n = 0; n < 64; ++n) { *(unsigned*)(p + (size_t)n * 8192) = cvt_pk_bf16(s0, s1);
                            const f32x2 dd = *(const f32x2*)(dv + n * 64);
                            s0 = dd[0] * s0 + bf2f(uu[n] & 0xffffu); s1 = dd[1] * s1 + bf2f(uu[n] >> 16); }
                    } }
#endif
                    GSYNC();
#ifndef NO_G3
    for (int dup_ = 0; dup_ < NDUP_G3; ++dup_) { if (dup_) { GSYNC(); }
                    {
                        PHASE_IDS();
                        LAS float* BL = (LAS float*)ldsl; LAS float* TOT = (LAS float*)(ldsl + 16384); LAS unsigned char* QS = ldsl + 18432; LAS unsigned char* KS = ldsl + 27648; LAS unsigned char* SCB = ldsl + 36864;
                        LAS unsigned char* VT = ldsl + 46080; LAS unsigned char* SLT = ldsl + 64512; LAS float* OUTL = (LAS float*)(ldsl + 82944);
                        const int r32 = lane & 31, hh = lane >> 5;
                        for (int unit = vcu; unit < 1024; unit += G) {
                            const int bh = unit >> 6, n = unit & 63, b = bh >> 2, h = bh & 3; const size_t m0 = (size_t)b * SEQ + n * 64;
                            float lav[8];
#pragma unroll
                            for (int i = 0; i < 8; ++i) lav[i] = LA[(m0 + wave * 8 + i) * 256 + h * 64 + lane];
                            const u32x4 qq_p = *(const u32x4*)(QK0 + (m0 + (tid >> 3)) * 512 + h * 64 + (tid & 7) * 8), kq_p = *(const u32x4*)(QK0 + (m0 + (tid >> 3)) * 512 + 256 + h * 64 + (tid & 7) * 8);
                            u32x4 vq_p[2], sq_p[2];
#pragma unroll
                            for (int c2 = 0; c2 < 2; ++c2) { const int c = tid + 512 * c2; vq_p[c2] = *(const u32x4*)(V0 + (m0 + (c >> 4)) * 512 + h * 128 + (c & 15) * 8);
                                sq_p[c2] = *(const u32x4*)(ST0 + (size_t)unit * 8192 + (c >> 3) * 64 + (c & 7) * 8); }
                            const u32x4 g0_p = *(const u32x4*)(G0 + (m0 + (tid >> 3)) * 512 + h * 128 + (tid & 7) * 16), g1_p = *(const u32x4*)(G0 + (m0 + (tid >> 3)) * 512 + h * 128 + (tid & 7) * 16 + 8);
                            f32x4 on_p[4];
#pragma unroll
                            for (int j4 = 0; j4 < 4; ++j4) on_p[j4] = *(const f32x4*)(A.out_norm + h * 128 + (tid & 7) * 16 + j4 * 4);
                            { const int d = lane; float pr[8]; float run = 0.f;
#pragma unroll
                              for (int i = 0; i < 8; ++i) { run += lav[i]; pr[i] = run; }
                              TOT[wave * 64 + d] = run; __syncthreads();
                              float tv_[8];
#pragma unroll
                              for (int s_ = 0; s_ < 8; ++s_) tv_[s_] = TOT[s_ * 64 + d];
                              float off = 0.f;
#pragma unroll
                              for (int s_ = 0; s_ < 7; ++s_) off += (s_ < wave) ? tv_[s_] : 0.f;
#pragma unroll
                              for (int i = 0; i < 8; ++i) BL[(wave * 8 + i) * 64 + d] = off + pr[i]; }
                            __syncthreads();
                            { const int t = tid >> 3, d0 = (tid & 7) * 8;
                              const u32x4 qq = qq_p, kq = kq_p;
                              const unsigned qw[4] = {qq.x, qq.y, qq.z, qq.w}, kw[4] = {kq.x, kq.y, kq.z, kq.w};
                              float qf[8], kf[8];
#pragma unroll
                              for (int i = 0; i < 8; ++i) { const float bb = BL[t * 64 + d0 + i];
                                  qf[i] = bf2f((i & 1) ? (qw[i >> 1] >> 16) : (qw[i >> 1] & 0xffffu)) * 0.125f * __expf(bb);
                                  kf[i] = bf2f((i & 1) ? (kw[i >> 1] >> 16) : (kw[i >> 1] & 0xffffu)) * __expf(-bb); }
                              *(LAS u32x4*)(QS + t * 144 + d0 * 2) = pack8((f32x4){qf[0], qf[1], qf[2], qf[3]}, (f32x4){qf[4], qf[5], qf[6], qf[7]});
                              *(LAS u32x4*)(KS + t * 144 + d0 * 2) = pack8((f32x4){kf[0], kf[1], kf[2], kf[3]}, (f32x4){kf[4], kf[5], kf[6], kf[7]});
#pragma unroll
                              for (int c2 = 0; c2 < 2; ++c2) { const int c = tid + 512 * c2, tt = c >> 4, e0 = (c & 15) * 8;
                                  *(LAS u32x4*)(VT + att::v_st(tt, e0)) = vq_p[c2];
                                  const int e = c >> 3, dd0 = (c & 7) * 8;
                                  *(LAS u32x4*)(SLT + e * 144 + dd0 * 2) = sq_p[c2]; } }
                            __syncthreads();
                            if (wave < 3) { const int it = (wave + 1) >> 1, jt = wave == 2 ? 1 : 0; f32x16 c = {};
#pragma unroll
                                for (int ks = 0; ks < 4; ++ks) { const bf16x8 a = *(const LAS bf16x8*)(QS + (32 * it + r32) * 144 + ks * 32 + hh * 16), bb = *(const LAS bf16x8*)(KS + (32 * jt + r32) * 144 + ks * 32 + hh * 16);
                                    c = __builtin_amdgcn_mfma_f32_32x32x16_bf16(a, bb, c, 0, 0, 0); }
#pragma unroll
                                for (int ii = 0; ii < 16; ++ii) { const int i = 32 * it + (ii & 3) + 8 * (ii >> 2) + 4 * hh, j = 32 * jt + r32;
                                    *(LAS bf16_t*)(SCB + i * 144 + j * 2) = (bf16_t)f2bf(j <= i ? c[ii] : 0.f); } }
                            __syncthreads();
                            { const int it = wave >> 2, et = wave & 3; f32x16 c = {};
#pragma unroll
                              for (int ks = 0; ks < 4; ++ks) { const bf16x8 a = *(const LAS bf16x8*)(QS + (32 * it + r32) * 144 + ks * 32 + hh * 16), bb = *(const LAS bf16x8*)(SLT + (32 * et + r32) * 144 + ks * 32 + hh * 16);
                                  c = __builtin_amdgcn_mfma_f32_32x32x16_bf16(a, bb, c, 0, 0, 0); }
#pragma unroll
                              for (int ks = 0; ks < 4; ++ks) if (ks < 2 * (it + 1)) { const bf16x8 a = *(const LAS bf16x8*)(SCB + (32 * it + r32) * 144 + ks * 32 + hh * 16), bb = tr_frag((int)(uintptr_t)VT + att::v_rd_base(lane), att::v_rd_off(et, ks, 0));
                                  c = __builtin_amdgcn_mfma_f32_32x32x16_bf16(a, bb, c, 0, 0, 0); }
#pragma unroll
                              for (int ii = 0; ii < 16; ++ii) OUTL[(32 * it + (ii & 3) + 8 * (ii >> 2) + 4 * hh) * 132 + 32 * et + r32] = c[ii]; }
                            __syncthreads();
                            { const int i = tid >> 3, e0 = (tid & 7) * 16; float acc[16];
#pragma unroll
                              for (int j4 = 0; j4 < 4; ++j4) { const f32x4 v4 = *(const LAS f32x4*)(OUTL + i * 132 + e0 + j4 * 4); acc[j4 * 4] = v4[0]; acc[j4 * 4 + 1] = v4[1]; acc[j4 * 4 + 2] = v4[2]; acc[j4 * 4 + 3] = v4[3]; }
                              float ss = 0.f;
#pragma unroll
                              for (int j = 0; j < 16; ++j) ss += acc[j] * acc[j];
                              ss += DPP_F(ss, 0xB1); ss += DPP_F(ss, 0x4E); ss += DPP_F(ss, 0x141);
                              const float rs = __builtin_amdgcn_rsqf(ss * (1.0f / 128.0f) + RMS_EPS);
                              const size_t mrow = m0 + i; const int cb = h * 128 + e0;
                              const u32x4 g0 = g0_p, g1 = g1_p;
                              const unsigned gw_[8] = {g0.x, g0.y, g0.z, g0.w, g1.x, g1.y, g1.z, g1.w};
                              float o[16];
#pragma unroll
                              for (int j = 0; j < 16; ++j) { const float gv = bf2f((j & 1) ? (gw_[j >> 1] >> 16) : (gw_[j >> 1] & 0xffffu)); o[j] = acc[j] * rs * on_p[j >> 2][j & 3] * gv; }
                              bf16_t* dst = MIX + mrow * DM + cb;
                              *(u32x4*)dst = pack8((f32x4){o[0], o[1], o[2], o[3]}, (f32x4){o[4], o[5], o[6], o[7]});
                              *(u32x4*)(dst + 8) = pack8((f32x4){o[8], o[9], o[10], o[11]}, (f32x4){o[12], o[13], o[14], o[15]}); }
                            __syncthreads();
                        }
                    }
    }
#endif
                    GSYNC();
                } else {
#ifndef NO_PROJ1
    for (int dup_ = 0; dup_ < NDUP_PROJ1; ++dup_) { if (dup_) { GSYNC(); }
                    { PHASE_ARGS(); pg8::Gemm g{HB, (const bf16_t*)(ws + WS_ODIN), M, ODD_N, DM}; pg8::StaticOrder S; S.init(M, ODD_N, G, bx);
                      pg8::EpiP1 E{SSQ, CS, Q1, K1, V1, QIH, QIL, KIH, KIL, WI1};
                      pg8::gemm_phase<pg8::EpiP1, pg8::StaticOrder, true, true>(ldsl, g, S, E, fresh_tid()); }
    }
#endif
                    GSYNC();
#ifndef NO_IDX
    for (int dup_ = 0; dup_ < NDUP_IDX; ++dup_) { if (dup_) { GSYNC(); }
                    {
                        PHASE_IDS();
                        LAS float* SC = (LAS float*)ldsl;
                        const int r32 = lane & 31, h2 = lane >> 5;
                        const bool scorer = wave < 4; const int sw = wave & 3;
                        LAS unsigned* histw = (LAS unsigned*)(ldsl + RING_BYTES + 2048 + sw * 1024);
                        LAS unsigned long long* wroww = (LAS unsigned long long*)(ldsl + RING_BYTES + 6144 + sw * 512);
                        int up = -1;
#pragma unroll 1
                        for (int k = 0; ; ++k) {
                            const int u = (G == 256) ? ((((k & 1) | ((k >> 2) << 1)) << 9) + ((((k + 2) >> 2) & 1) << 8) + vcu) : vcu + k * G;
                            const bool have = (G == 256) ? k < 8 : u < 2048;
                            const int bp = up >> 9, urp = up & 511; const int rgp = (urp & 256) ? 511 - (urp & 255) : (urp & 255);
                            const int t0p = rgp * 8; const int nk64p = (t0p >> 6) + 1;
                            if (scorer) {
                                const int b = u >> 9, ur = u & 511; const int rg = (ur & 256) ? 511 - (ur & 255) : (ur & 255);
                                const int t0 = rg * 8; const size_t mb = (size_t)(b & 3) * SEQ;
                                const bool act = have && t0 >= 256;
                                const int nk64 = (t0 >> 6) + 1, nkb = 2 * nk64;
                                const bf16_t* kt = KIH + (size_t)(b & 3) * 128 * 4096 + lane * 8;
                                bf16x8 ah[4], al[4]; f32x4 wv[4]; bf16x8 bA[8], bB[8], bC[8], bD[8];
#define IDX_LOAD(dst, kb_) do { __builtin_amdgcn_sched_barrier(0); _Pragma("unroll") for (int q = 0; q < 8; ++q) dst[q] = *(const bf16x8*)(kt + (size_t)(kb_) * 4096 + q * 512); __builtin_amdgcn_sched_barrier(0); } while (0)
                                {
                                    { const size_t qrow = mb + t0 + (r32 >> 2); const int hd = r32 & 3;
#pragma unroll
                                      for (int ks = 0; ks < 4; ++ks) { ah[ks] = *(const bf16x8*)(QIH + qrow * 256 + hd * 64 + ks * 16 + h2 * 8); al[ks] = *(const bf16x8*)(QIL + qrow * 256 + hd * 64 + ks * 16 + h2 * 8); } }
#pragma unroll
                                    for (int g = 0; g < 4; ++g) wv[g] = *(const f32x4*)(WI1 + (mb + t0 + 2 * g + h2) * 4);
                                    IDX_LOAD(bA, sw); IDX_LOAD(bB, (sw + 4 < nkb ? sw + 4 : nkb - 1)); IDX_LOAD(bC, (sw + 8 < nkb ? sw + 8 : nkb - 1)); }
                                __syncthreads();
                                if (act) {
                                    LAS unsigned* H0w = (LAS unsigned*)(ldsl + RING_BYTES + 16384 + (k & 1) * 8192);
#define IDX_FMA(d, a, b, c) asm("v_fma_f32 %0, %1, %2, %3" : "=v"(d) : "v"(a), "v"(b), "v"(c))
#define IDX_COMP(src, kb_) do { const int key = (kb_) * 32 + r32; f32x16 acc = {}; \
                                _Pragma("unroll") for (int ks = 0; ks < 4; ++ks) { \
                                    acc = __builtin_amdgcn_mfma_f32_32x32x16_bf16(ah[ks], src[2 * ks], acc, 0, 0, 0); \
                                    acc = __builtin_amdgcn_mfma_f32_32x32x16_bf16(ah[ks], src[2 * ks + 1], acc, 0, 0, 0); \
                                    acc = __builtin_amdgcn_mfma_f32_32x32x16_bf16(al[ks], src[2 * ks], acc, 0, 0, 0); } \
                                const bool diag_ = (kb_) * 32 + 31 > t0;            \
                                _Pragma("unroll") for (int g = 0; g < 4; ++g) { \
                                      \
                                    const float e0 = acc[4 * g + 0], e1 = acc[4 * g + 1], e2 = acc[4 * g + 2], e3 = acc[4 * g + 3];       \
                                    int r0 = __float_as_int(e0), r1 = __float_as_int(e1), r2 = __float_as_int(e2), r3 = __float_as_int(e3); \
                                    r0 = r0 > 0 ? r0 : 0; r1 = r1 > 0 ? r1 : 0; r2 = r2 > 0 ? r2 : 0; r3 = r3 > 0 ? r3 : 0; \
                                    float sc, z_ = 0.0f; IDX_FMA(sc, wv[g][0], __builtin_bit_cast(float, r0), z_);               \
                                    IDX_FMA(sc, wv[g][1], __builtin_bit_cast(float, r1), sc); IDX_FMA(sc, wv[g][2], __builtin_bit_cast(float, r2), sc); IDX_FMA(sc, wv[g][3], __builtin_bit_cast(float, r3), sc); \
                                    unsigned uu = __builtin_bit_cast(unsigned, sc); uu ^= (unsigned)((int)uu >> 31) | 0x80000000u;     \
                                    const int rl = 2 * g + h2; if (diag_ && key > t0 + rl) uu = 0u;                                      \
                                    SC[rl * 4096 + key] = __builtin_bit_cast(float, uu); \
                                    atomicAdd((unsigned*)(H0w + rl * 256 + (uu >> 24)), 1u); } } while (0)
                                    { int kb = sw;
#define IDX_CL(x) ((x) < nkb ? (x) : nkb - 1)
#pragma unroll 1
                                      for (; kb < nkb; kb += 16) {
                                          IDX_LOAD(bD, IDX_CL(kb + 12)); IDX_COMP(bA, kb);
                                          IDX_LOAD(bA, IDX_CL(kb + 16)); if (kb + 4 < nkb) IDX_COMP(bB, kb + 4);
                                          IDX_LOAD(bB, IDX_CL(kb + 20)); if (kb + 8 < nkb) IDX_COMP(bC, kb + 8);
                                          IDX_LOAD(bC, IDX_CL(kb + 24)); if (kb + 12 < nkb) IDX_COMP(bD, kb + 12);
                                      } }
#undef IDX_CL
#undef IDX_LOAD
#undef IDX_COMP
#undef IDX_FMA
                                }
                                __syncthreads();
                            } else {
                                const bool selp = up >= 0 && t0p >= 256;
                                unsigned key[64], key2[64];
                                { const int nkl = selp ? nk64p : 0;
#pragma unroll
                                  for (int j = 0; j < 64; ++j) {
                                    unsigned k0 = 0u, k1 = 0u;
                                    if (j < nkl) { k0 = __builtin_bit_cast(unsigned, SC[(2 * sw) * 4096 + j * 64 + lane]); k1 = __builtin_bit_cast(unsigned, SC[(2 * sw + 1) * 4096 + j * 64 + lane]); }
                                    key[j] = k0; key2[j] = k1;
                                  } }
                                __syncthreads();
                                if (up >= 0) {
                                if (t0p < 256) {
#pragma unroll 1
                                    for (int r = 0; r < 2; ++r) { const int tp = t0p + 2 * sw + r; const int j = lane; unsigned long long w;
                                        if (64 * j + 63 <= tp) w = ~0ull; else if (64 * j > tp) w = 0ull; else w = (~0ull) >> (63 - (tp - 64 * j));
                                        MASK[((size_t)bp * 64 + lane) * SEQ + tp] = w; }
                                } else {
                                unsigned Tq0 = 0u, Tq1 = 0u, neqq0 = 0u, neqq1 = 0u; int needq0 = 256, needq1 = 256, p0q0 = 1, p0q1 = 1;
                                { LAS unsigned* H0r = (LAS unsigned*)(ldsl + RING_BYTES + 16384 + ((k + 1) & 1) * 8192 + (2 * sw) * 1024);
                                  const u32x4 hA = *(const LAS u32x4*)(H0r + 4 * lane), hB = *(const LAS u32x4*)(H0r + 256 + 4 * lane);
                                  { unsigned z_ = 0u; asm volatile("" : "+v"(z_)); *(LAS u32x4*)(H0r + 4 * lane) = (u32x4){z_, z_, z_, z_}; *(LAS u32x4*)(H0r + 256 + 4 * lane) = (u32x4){z_, z_, z_, z_}; }
#define IDX_TOPB(h, Tq, needq, neqq, p0q) do { const unsigned sl = (h.x + h.y) + (h.z + h.w); const unsigned P_ = wave_prefix_incl_u32(sl, lane); \
                                      const unsigned S = (unsigned)__builtin_amdgcn_readlane((int)P_, 63) - P_ + sl, C = S - sl; \
                                      const unsigned long long bm = __ballot(C < 256u && 256u <= S); \
                                      const int L = __builtin_amdgcn_readfirstlane((int)__builtin_ctzll(bm | (1ull << 63))); \
                                      const unsigned h0 = __builtin_amdgcn_readlane(h.x, L), h1 = __builtin_amdgcn_readlane(h.y, L), h2_ = __builtin_amdgcn_readlane(h.z, L), h3 = __builtin_amdgcn_readlane(h.w, L); \
                                      unsigned c = __builtin_amdgcn_readlane(C, L); int D = 3; \
                                      if (c + h3 < 256u) { c += h3; D = 2; if (c + h2_ < 256u) { c += h2_; D = 1; if (c + h1 < 256u) { c += h1; D = 0; } } } \
                                      needq = 256 - (int)c; Tq = (unsigned)(4 * L + D) << 24; neqq = (D == 3) ? h3 : (D == 2) ? h2_ : (D == 1) ? h1 : h0; \
                                      p0q = (neqq == (unsigned)needq) ? 4 : 1; } while (0)
                                  IDX_TOPB(hA, Tq0, needq0, neqq0, p0q0); IDX_TOPB(hB, Tq1, needq1, neqq1, p0q1);
#undef IDX_TOPB
                                  const bool zA = Tq0 == 0x80000000u && p0q0 != 4, zB = Tq1 == 0x80000000u && p0q1 != 4;
                                  if (zA || zB) {
                                      unsigned a0 = 0u, a1 = 0u, a2 = 0u, a3 = 0u, b0 = 0u, b1 = 0u, b2 = 0u, b3 = 0u;
                                      unsigned zp = 0x80000001u; asm volatile("" : "+s"(zp));
#pragma unroll
                                      for (int grp = 0; grp < 8; ++grp) if (grp * 8 < nk64p) {
#pragma unroll
                                          for (int q4 = 0; q4 < 2; ++q4) {
                                              cnt_ge4(a0, a1, a2, a3, key[grp * 8 + q4 * 4 + 0], key[grp * 8 + q4 * 4 + 1], key[grp * 8 + q4 * 4 + 2], key[grp * 8 + q4 * 4 + 3], zp);
                                              cnt_ge4(b0, b1, b2, b3, key2[grp * 8 + q4 * 4 + 0], key2[grp * 8 + q4 * 4 + 1], key2[grp * 8 + q4 * 4 + 2], key2[grp * 8 + q4 * 4 + 3], zp); } }
                                      const int posA = wave_sum_u32((a0 + a1) + (a2 + a3)), posB = wave_sum_u32((b0 + b1) + (b2 + b3));
                                      if (zA && posA < 256) { const int nnA = (256 - needq0) + (int)neqq0; needq0 = 256 - posA; neqq0 = (unsigned)(nnA - posA); p0q0 = 4; }
                                      if (zB && posB < 256) { const int nnB = (256 - needq1) + (int)neqq1; needq1 = 256 - posB; neqq1 = (unsigned)(nnB - posB); p0q1 = 4; } } }
#pragma unroll 1
                                for (int r = 0; r < 2; ++r) {
                                if (r) {
#pragma unroll
                                    for (int j = 0; j < 64; ++j) key[j] = key2[j]; }
                                const int tp = t0p + 2 * sw + r;
                                unsigned T = r ? Tq1 : Tq0; int need = r ? needq1 : needq0; unsigned neq = r ? neqq1 : neqq0; const int pass0 = r ? p0q1 : p0q0;
                                { LAS unsigned* hist = histw;
#pragma unroll 1
                                  for (int pass = pass0; pass < 4; ++pass) {
                                    const int shift = 24 - 8 * pass; const unsigned pmask = pass == 0 ? 0u : (0xFFFFFFFFu << (shift + 8));
                                    { unsigned z_ = 0u; asm volatile("" : "+v"(z_)); *(LAS u32x4*)(hist + 4 * lane) = (u32x4){z_, z_, z_, z_}; }
#pragma unroll
                                    for (int grp = 0; grp < 8; ++grp) if (grp * 8 < nk64p) {
#pragma unroll
                                        for (int jj = 0; jj < 8; ++jj) { const unsigned k = key[grp * 8 + jj];
                                            if (((k ^ T) & pmask) == 0u) atomicAdd((unsigned*)(hist + ((k >> shift) & 255u)), 1u); } }
                                    const u32x4 h = *(const LAS u32x4*)(hist + 4 * lane);
                                    const unsigned sl = (h.x + h.y) + (h.z + h.w);
                                    const unsigned P_ = wave_prefix_incl_u32(sl, lane);
                                    const unsigned S = (unsigned)__builtin_amdgcn_readlane((int)P_, 63) - P_ + sl;
                                    const unsigned C = S - sl;
                                    const unsigned long long bm = __ballot(C < (unsigned)need && (unsigned)need <= S);
                                    const int L = __builtin_amdgcn_readfirstlane((int)__builtin_ctzll(bm | (1ull << 63)));
                                    const unsigned h0 = __builtin_amdgcn_readlane(h.x, L), h1 = __builtin_amdgcn_readlane(h.y, L), h2_ = __builtin_amdgcn_readlane(h.z, L), h3 = __builtin_amdgcn_readlane(h.w, L);
                                    unsigned c = __builtin_amdgcn_readlane(C, L); int D = 3;
                                    if (c + h3 < (unsigned)need) { c += h3; D = 2; if (c + h2_ < (unsigned)need) { c += h2_; D = 1; if (c + h1 < (unsigned)need) { c += h1; D = 0; } } }
                                    need -= (int)c; T |= (unsigned)(4 * L + D) << shift;
                                    neq = (D == 3) ? h3 : (D == 2) ? h2_ : (D == 1) ? h1 : h0;
                                    if (neq == (unsigned)need) break;
                                  } }
                                if (neq == (unsigned)need) {
                                    unsigned wlo = 0u, whi = 0u; unsigned Tv = T; asm volatile("" : "+v"(Tv));
                                    if (0 < nk64p) {
                                        asm volatile("v_cmp_le_u32_e32 vcc, %2, %3\n\ts_nop 1\n\tv_writelane_b32 %0, vcc_lo, 0\n\tv_writelane_b32 %1, vcc_hi, 0" : "+v"(wlo), "+v"(whi) : "v"(Tv), "v"(key[0]) : "vcc");
                                        asm volatile("v_cmp_le_u32_e32 vcc, %2, %3\n\ts_nop 1\n\tv_writelane_b32 %0, vcc_lo, 1\n\tv_writelane_b32 %1, vcc_hi, 1" : "+v"(wlo), "+v"(whi) : "v"(Tv), "v"(key[1]) : "vcc");
                                        asm volatile("v_cmp_le_u32_e32 vcc, %2, %3\n\ts_nop 1\n\tv_writelane_b32 %0, vcc_lo, 2\n\tv_writelane_b32 %1, vcc_hi, 2" : "+v"(wlo), "+v"(whi) : "v"(Tv), "v"(key[2]) : "vcc");
                                        asm volatile("v_cmp_le_u32_e32 vcc, %2, %3\n\ts_nop 1\n\tv_writelane_b32 %0, vcc_lo, 3\n\tv_writelane_b32 %1, vcc_hi, 3" : "+v"(wlo), "+v"(whi) : "v"(Tv), "v"(key[3]) : "vcc");
                                        asm volatile("v_cmp_le_u32_e32 vcc, %2, %3\n\ts_nop 1\n\tv_writelane_b32 %0, vcc_lo, 4\n\tv_writelane_b32 %1, vcc_hi, 4" : "+v"(wlo), "+v"(whi) : "v"(Tv), "v"(key[4]) : "vcc");
                                        asm volatile("v_cmp_le_u32_e32 vcc, %2, %3\n\ts_nop 1\n\tv_writelane_b32 %0, vcc_lo, 5\n\tv_writelane_b32 %1, vcc_hi, 5" : "+v"(wlo), "+v"(whi) : "v"(Tv), "v"(key[5]) : "vcc");
                                        asm volatile("v_cmp_le_u32_e32 vcc, %2, %3\n\ts_nop 1\n\tv_writelane_b32 %0, vcc_lo, 6\n\tv_writelane_b32 %1, vcc_hi, 6" : "+v"(wlo), "+v"(whi) : "v"(Tv), "v"(key[6]) : "vcc");
                                        asm volatile("v_cmp_le_u32_e32 vcc, %2, %3\n\ts_nop 1\n\tv_writelane_b32 %0, vcc_lo, 7\n\tv_writelane_b32 %1, vcc_hi, 7" : "+v"(wlo), "+v"(whi) : "v"(Tv), "v"(key[7]) : "vcc");
                                    }
                                    if (8 < nk64p) {
                                        asm volatile("v_cmp_le_u32_e32 vcc, %2, %3\n\ts_nop 1\n\tv_writelane_b32 %0, vcc_lo, 8\n\tv_writelane_b32 %1, vcc_hi, 8" : "+v"(wlo), "+v"(whi) : "v"(Tv), "v"(key[8]) : "vcc");
                                        asm volatile("v_cmp_le_u32_e32 vcc, %2, %3\n\ts_nop 1\n\tv_writelane_b32 %0, vcc_lo, 9\n\tv_writelane_b32 %1, vcc_hi, 9" : "+v"(wlo), "+v"(whi) : "v"(Tv), "v"(key[9]) : "vcc");
                                        asm volatile("v_cmp_le_u32_e32 vcc, %2, %3\n\ts_nop 1\n\tv_writelane_b32 %0, vcc_lo, 10\n\tv_writelane_b32 %1, vcc_hi, 10" : "+v"(wlo), "+v"(whi) : "v"(Tv), "v"(key[10]) : "vcc");
                                        asm volatile("v_cmp_le_u32_e32 vcc, %2, %3\n\ts_nop 1\n\tv_writelane_b32 %0, vcc_lo, 11\n\tv_writelane_b32 %1, vcc_hi, 11" : "+v"(wlo), "+v"(whi) : "v"(Tv), "v"(key[11]) : "vcc");
                                        asm volatile("v_cmp_le_u32_e32 vcc, %2, %3\n\ts_nop 1\n\tv_writelane_b32 %0, vcc_lo, 12\n\tv_writelane_b32 %1, vcc_hi, 12" : "+v"(wlo), "+v"(whi) : "v"(Tv), "v"(key[12]) : "vcc");
                                        asm volatile("v_cmp_le_u32_e32 vcc, %2, %3\n\ts_nop 1\n\tv_writelane_b32 %0, vcc_lo, 13\n\tv_writelane_b32 %1, vcc_hi, 13" : "+v"(wlo), "+v"(whi) : "v"(Tv), "v"(key[13]) : "vcc");
                                        asm volatile("v_cmp_le_u32_e32 vcc, %2, %3\n\ts_nop 1\n\tv_writelane_b32 %0, vcc_lo, 14\n\tv_writelane_b32 %1, vcc_hi, 14" : "+v"(wlo), "+v"(whi) : "v"(Tv), "v"(key[14]) : "vcc");
                                        asm volatile("v_cmp_le_u32_e32 vcc, %2, %3\n\ts_nop 1\n\tv_writelane_b32 %0, vcc_lo, 15\n\tv_writelane_b32 %1, vcc_hi, 15" : "+v"(wlo), "+v"(whi) : "v"(Tv), "v"(key[15]) : "vcc");
                                    }
                                    if (16 < nk64p) {
                                        asm volatile("v_cmp_le_u32_e32 vcc, %2, %3\n\ts_nop 1\n\tv_writelane_b32 %0, vcc_lo, 16\n\tv_writelane_b32 %1, vcc_hi, 16" : "+v"(wlo), "+v"(whi) : "v"(Tv), "v"(key[16]) : "vcc");
                                        asm volatile("v_cmp_le_u32_e32 vcc, %2, %3\n\ts_nop 1\n\tv_writelane_b32 %0, vcc_lo, 17\n\tv_writelane_b32 %1, vcc_hi, 17" : "+v"(wlo), "+v"(whi) : "v"(Tv), "v"(key[17]) : "vcc");
                                        asm volatile("v_cmp_le_u32_e32 vcc, %2, %3\n\ts_nop 1\n\tv_writelane_b32 %0, vcc_lo, 18\n\tv_writelane_b32 %1, vcc_hi, 18" : "+v"(wlo), "+v"(whi) : "v"(Tv), "v"(key[18]) : "vcc");
                                        asm volatile("v_cmp_le_u32_e32 vcc, %2, %3\n\ts_nop 1\n\tv_writelane_b32 %0, vcc_lo, 19\n\tv_writelane_b32 %1, vcc_hi, 19" : "+v"(wlo), "+v"(whi) : "v"(Tv), "v"(key[19]) : "vcc");
                                        asm volatile("v_cmp_le_u32_e32 vcc, %2, %3\n\ts_nop 1\n\tv_writelane_b32 %0, vcc_lo, 20\n\tv_writelane_b32 %1, vcc_hi, 20" : "+v"(wlo), "+v"(whi) : "v"(Tv), "v"(key[20]) : "vcc");
                                        asm volatile("v_cmp_le_u32_e32 vcc, %2, %3\n\ts_nop 1\n\tv_writelane_b32 %0, vcc_lo, 21\n\tv_writelane_b32 %1, vcc_hi, 21" : "+v"(wlo), "+v"(whi) : "v"(Tv), "v"(key[21]) : "vcc");
                                        asm volatile("v_cmp_le_u32_e32 vcc, %2, %3\n\ts_nop 1\n\tv_writelane_b32 %0, vcc_lo, 22\n\tv_writelane_b32 %1, vcc_hi, 22" : "+v"(wlo), "+v"(whi) : "v"(Tv), "v"(key[22]) : "vcc");
                                        asm volatile("v_cmp_le_u32_e32 vcc, %2, %3\n\ts_nop 1\n\tv_writelane_b32 %0, vcc_lo, 23\n\tv_writelane_b32 %1, vcc_hi, 23" : "+v"(wlo), "+v"(whi) : "v"(Tv), "v"(key[23]) : "vcc");
                                    }
                                    if (24 < nk64p) {
                                        asm volatile("v_cmp_le_u32_e32 vcc, %2, %3\n\ts_nop 1\n\tv_writelane_b32 %0, vcc_lo, 24\n\tv_writelane_b32 %1, vcc_hi, 24" : "+v"(wlo), "+v"(whi) : "v"(Tv), "v"(key[24]) : "vcc");
                                        asm volatile("v_cmp_le_u32_e32 vcc, %2, %3\n\ts_nop 1\n\tv_writelane_b32 %0, vcc_lo, 25\n\tv_writelane_b32 %1, vcc_hi, 25" : "+v"(wlo), "+v"(whi) : "v"(Tv), "v"(key[25]) : "vcc");
                                        asm volatile("v_cmp_le_u32_e32 vcc, %2, %3\n\ts_nop 1\n\tv_writelane_b32 %0, vcc_lo, 26\n\tv_writelane_b32 %1, vcc_hi, 26" : "+v"(wlo), "+v"(whi) : "v"(Tv), "v"(key[26]) : "vcc");
                                        asm volatile("v_cmp_le_u32_e32 vcc, %2, %3\n\ts_nop 1\n\tv_writelane_b32 %0, vcc_lo, 27\n\tv_writelane_b32 %1, vcc_hi, 27" : "+v"(wlo), "+v"(whi) : "v"(Tv), "v"(key[27]) : "vcc");
                                        asm volatile("v_cmp_le_u32_e32 vcc, %2, %3\n\ts_nop 1\n\tv_writelane_b32 %0, vcc_lo, 28\n\tv_writelane_b32 %1, vcc_hi, 28" : "+v"(wlo), "+v"(whi) : "v"(Tv), "v"(key[28]) : "vcc");
                                        asm volatile("v_cmp_le_u32_e32 vcc, %2, %3\n\ts_nop 1\n\tv_writelane_b32 %0, vcc_lo, 29\n\tv_writelane_b32 %1, vcc_hi, 29" : "+v"(wlo), "+v"(whi) : "v"(Tv), "v"(key[29]) : "vcc");
                                        asm volatile("v_cmp_le_u32_e32 vcc, %2, %3\n\ts_nop 1\n\tv_writelane_b32 %0, vcc_lo, 30\n\tv_writelane_b32 %1, vcc_hi, 30" : "+v"(wlo), "+v"(whi) : "v"(Tv), "v"(key[30]) : "vcc");
                                        asm volatile("v_cmp_le_u32_e32 vcc, %2, %3\n\ts_nop 1\n\tv_writelane_b32 %0, vcc_lo, 31\n\tv_writelane_b32 %1, vcc_hi, 31" : "+v"(wlo), "+v"(whi) : "v"(Tv), "v"(key[31]) : "vcc");
                                    }
                                    if (32 < nk64p) {
                                        asm volatile("v_cmp_le_u32_e32 vcc, %2, %3\n\ts_nop 1\n\tv_writelane_b32 %0, vcc_lo, 32\n\tv_writelane_b32 %1, vcc_hi, 32" : "+v"(wlo), "+v"(whi) : "v"(Tv), "v"(key[32]) : "vcc");
                                        asm volatile("v_cmp_le_u32_e32 vcc, %2, %3\n\ts_nop 1\n\tv_writelane_b32 %0, vcc_lo, 33\n\tv_writelane_b32 %1, vcc_hi, 33" : "+v"(wlo), "+v"(whi) : "v"(Tv), "v"(key[33]) : "vcc");
                                        asm volatile("v_cmp_le_u32_e32 vcc, %2, %3\n\ts_nop 1\n\tv_writelane_b32 %0, vcc_lo, 34\n\tv_writelane_b32 %1, vcc_hi, 34" : "+v"(wlo), "+v"(whi) : "v"(Tv), "v"(key[34]) : "vcc");
                                        asm volatile("v_cmp_le_u32_e32 vcc, %2, %3\n\ts_nop 1\n\tv_writelane_b32 %0, vcc_lo, 35\n\tv_writelane_b32 %1, vcc_hi, 35" : "+v"(wlo), "+v"(whi) : "v"(Tv), "v"(key[35]) : "vcc");
                                        asm volatile("v_cmp_le_u32_e32 vcc, %2, %3\n\ts_nop 1\n\tv_writelane_b32 %0, vcc_lo, 36\n\tv_writelane_b32 %1, vcc_hi, 36" : "+v"(wlo), "+v"(whi) : "v"(Tv), "v"(key[36]) : "vcc");
                                        asm volatile("v_cmp_le_u32_e32 vcc, %2, %3\n\ts_nop 1\n\tv_writelane_b32 %0, vcc_lo, 37\n\tv_writelane_b32 %1, vcc_hi, 37" : "+v"(wlo), "+v"(whi) : "v"(Tv), "v"(key[37]) : "vcc");
                                        asm volatile("v_cmp_le_u32_e32 vcc, %2, %3\n\ts_nop 1\n\tv_writelane_b32 %0, vcc_lo, 38\n\tv_writelane_b32 %1, vcc_hi, 38" : "+v"(wlo), "+v"(whi) : "v"(Tv), "v"(key[38]) : "vcc");
                                        asm volatile("v_cmp_le_u32_e32 vcc, %2, %3\n\ts_nop 1\n\tv_writelane_b32 %0, vcc_lo, 39\n\tv_writelane_b32 %1, vcc_hi, 39" : "+v"(wlo), "+v"(whi) : "v"(Tv), "v"(key[39]) : "vcc");
                                    }
                                    if (40 < nk64p) {
                                        asm volatile("v_cmp_le_u32_e32 vcc, %2, %3\n\ts_nop 1\n\tv_writelane_b32 %0, vcc_lo, 40\n\tv_writelane_b32 %1, vcc_hi, 40" : "+v"(wlo), "+v"(whi) : "v"(Tv), "v"(key[40]) : "vcc");
                                        asm volatile("v_cmp_le_u32_e32 vcc, %2, %3\n\ts_nop 1\n\tv_writelane_b32 %0, vcc_lo, 41\n\tv_writelane_b32 %1, vcc_hi, 41" : "+v"(wlo), "+v"(whi) : "v"(Tv), "v"(key[41]) : "vcc");
                                        asm volatile("v_cmp_le_u32_e32 vcc, %2, %3\n\ts_nop 1\n\tv_writelane_b32 %0, vcc_lo, 42\n\tv_writelane_b32 %1, vcc_hi, 42" : "+v"(wlo), "+v"(whi) : "v"(Tv), "v"(key[42]) : "vcc");
                                        asm volatile("v_cmp_le_u32_e32 vcc, %2, %3\n\ts_nop 1\n\tv_writelane_b32 %0, vcc_lo, 43\n\tv_writelane_b32 %1, vcc_hi, 43" : "+v"(wlo), "+v"(whi) : "v"(Tv), "v"(key[43]) : "vcc");
                                        asm volatile("v_cmp_le_u32_e32 vcc, %2, %3\n\ts_nop 1\n\tv_writelane_b32 %0, vcc_lo, 44\n\tv_writelane_b32 %1, vcc_hi, 44" : "+v"(wlo), "+v"(whi) : "v"(Tv), "v"(key[44]) : "vcc");
                                        asm volatile("v_cmp_le_u32_e32 vcc, %2, %3\n\ts_nop 1\n\tv_writelane_b32 %0, vcc_lo, 45\n\tv_writelane_b32 %1, vcc_hi, 45" : "+v"(wlo), "+v"(whi) : "v"(Tv), "v"(key[45]) : "vcc");
                                        asm volatile("v_cmp_le_u32_e32 vcc, %2, %3\n\ts_nop 1\n\tv_writelane_b32 %0, vcc_lo, 46\n\tv_writelane_b32 %1, vcc_hi, 46" : "+v"(wlo), "+v"(whi) : "v"(Tv), "v"(key[46]) : "vcc");
                                        asm volatile("v_cmp_le_u32_e32 vcc, %2, %3\n\ts_nop 1\n\tv_writelane_b32 %0, vcc_lo, 47\n\tv_writelane_b32 %1, vcc_hi, 47" : "+v"(wlo), "+v"(whi) : "v"(Tv), "v"(key[47]) : "vcc");
                                    }
                                    if (48 < nk64p) {
                                        asm volatile("v_cmp_le_u32_e32 vcc, %2, %3\n\ts_nop 1\n\tv_writelane_b32 %0, vcc_lo, 48\n\tv_writelane_b32 %1, vcc_hi, 48" : "+v"(wlo), "+v"(whi) : "v"(Tv), "v"(key[48]) : "vcc");
                                        asm volatile("v_cmp_le_u32_e32 vcc, %2, %3\n\ts_nop 1\n\tv_writelane_b32 %0, vcc_lo, 49\n\tv_writelane_b32 %1, vcc_hi, 49" : "+v"(wlo), "+v"(whi) : "v"(Tv), "v"(key[49]) : "vcc");
                                        asm volatile("v_cmp_le_u32_e32 vcc, %2, %3\n\ts_nop 1\n\tv_writelane_b32 %0, vcc_lo, 50\n\tv_writelane_b32 %1, vcc_hi, 50" : "+v"(wlo), "+v"(whi) : "v"(Tv), "v"(key[50]) : "vcc");
                                        asm volatile("v_cmp_le_u32_e32 vcc, %2, %3\n\ts_nop 1\n\tv_writelane_b32 %0, vcc_lo, 51\n\tv_writelane_b32 %1, vcc_hi, 51" : "+v"(wlo), "+v"(whi) : "v"(Tv), "v"(key[51]) : "vcc");
                                        asm volatile("v_cmp_le_u32_e32 vcc, %2, %3\n\ts_nop 1\n\tv_writelane_b32 %0, vcc_lo, 52\n\tv_writelane_b32 %1, vcc_hi, 52" : "+v"(wlo), "+v"(whi) : "v"(Tv), "v"(key[52]) : "vcc");
                                        asm volatile("v_cmp_le_u32_e32 vcc, %2, %3\n\ts_nop 1\n\tv_writelane_b32 %0, vcc_lo, 53\n\tv_writelane_b32 %1, vcc_hi, 53" : "+v"(wlo), "+v"(whi) : "v"(Tv), "v"(key[53]) : "vcc");
                                        asm volatile("v_cmp_le_u32_e32 vcc, %2, %3\n\ts_nop 1\n\tv_writelane_b32 %0, vcc_lo, 54\n\tv_writelane_b32 %1, vcc_hi, 54" : "+v"(wlo), "+v"(whi) : "v"(Tv), "v"(key[54]) : "vcc");
                                        asm volatile("v_cmp_le_u32_e32 vcc, %2, %3\n\ts_nop 1\n\tv_writelane_b32 %0, vcc_lo, 55\n\tv_writelane_b32 %1, vcc_hi, 55" : "+v"(wlo), "+v"(whi) : "v"(Tv), "v"(key[55]) : "vcc");
                                    }
                                    if (56 < nk64p) {
                                        asm volatile("v_cmp_le_u32_e32 vcc, %2, %3\n\ts_nop 1\n\tv_writelane_b32 %0, vcc_lo, 56\n\tv_writelane_b32 %1, vcc_hi, 56" : "+v"(wlo), "+v"(whi) : "v"(Tv), "v"(key[56]) : "vcc");
                                        asm volatile("v_cmp_le_u32_e32 vcc, %2, %3\n\ts_nop 1\n\tv_writelane_b32 %0, vcc_lo, 57\n\tv_writelane_b32 %1, vcc_hi, 57" : "+v"(wlo), "+v"(whi) : "v"(Tv), "v"(key[57]) : "vcc");
                                        asm volatile("v_cmp_le_u32_e32 vcc, %2, %3\n\ts_nop 1\n\tv_writelane_b32 %0, vcc_lo, 58\n\tv_writelane_b32 %1, vcc_hi, 58" : "+v"(wlo), "+v"(whi) : "v"(Tv), "v"(key[58]) : "vcc");
                                        asm volatile("v_cmp_le_u32_e32 vcc, %2, %3\n\ts_nop 1\n\tv_writelane_b32 %0, vcc_lo, 59\n\tv_writelane_b32 %1, vcc_hi, 59" : "+v"(wlo), "+v"(whi) : "v"(Tv), "v"(key[59]) : "vcc");
                                        asm volatile("v_cmp_le_u32_e32 vcc, %2, %3\n\ts_nop 1\n\tv_writelane_b32 %0, vcc_lo, 60\n\tv_writelane_b32 %1, vcc_hi, 60" : "+v"(wlo), "+v"(whi) : "v"(Tv), "v"(key[60]) : "vcc");
                                        asm volatile("v_cmp_le_u32_e32 vcc, %2, %3\n\ts_nop 1\n\tv_writelane_b32 %0, vcc_lo, 61\n\tv_writelane_b32 %1, vcc_hi, 61" : "+v"(wlo), "+v"(whi) : "v"(Tv), "v"(key[61]) : "vcc");
                                        asm volatile("v_cmp_le_u32_e32 vcc, %2, %3\n\ts_nop 1\n\tv_writelane_b32 %0, vcc_lo, 62\n\tv_writelane_b32 %1, vcc_hi, 62" : "+v"(wlo), "+v"(whi) : "v"(Tv), "v"(key[62]) : "vcc");
                                        asm volatile("v_cmp_le_u32_e32 vcc, %2, %3\n\ts_nop 1\n\tv_writelane_b32 %0, vcc_lo, 63\n\tv_writelane_b32 %1, vcc_hi, 63" : "+v"(wlo), "+v"(whi) : "v"(Tv), "v"(key[63]) : "vcc");
                                    }
                                    MASK[((size_t)bp * 64 + lane) * SEQ + tp] = ((unsigned long long)whi << 32) | wlo;
                                } else {
                                int base = 0;
                                LAS unsigned long long* wrow = wroww;
#pragma unroll
                                for (int grp = 0; grp < 8; ++grp) if (grp * 8 < nk64p) {
#pragma unroll
                                    for (int jj = 0; jj < 8; ++jj) { const int j = grp * 8 + jj;
                                        const bool eq = key[j] == T; const unsigned long long eqm = __ballot(eq);
                                        const int rank = base + (int)__builtin_amdgcn_mbcnt_hi((unsigned)(eqm >> 32), __builtin_amdgcn_mbcnt_lo((unsigned)eqm, 0u));
                                        const bool sel = (key[j] > T) || (eq && rank < need);
                                        const unsigned long long wj = __ballot(sel);
                                        if (lane == 0) wrow[j] = wj;
                                        base += __popcll(eqm); } }
                                { const unsigned long long wv_ = wrow[lane]; const unsigned lo_ = (lane < nk64p) ? (unsigned)wv_ : 0u, hi_ = (lane < nk64p) ? (unsigned)(wv_ >> 32) : 0u;
                                  MASK[((size_t)bp * 64 + lane) * SEQ + tp] = ((unsigned long long)hi_ << 32) | lo_; }
                                }

                                }
                                }
                                }
                                __syncthreads();
                            }
                            if (!have) break;
                            up = u;
                        }
                    }
    }
#endif
                    GSYNC();
#ifndef NO_ATT
    for (int dup_ = 0; dup_ < NDUP_ATT; ++dup_) { if (dup_) { GSYNC(); }
                    {
                        PHASE_ARGS();
                        att::Seam S;
                        auto mkref = [&](int L, int pass) {
                            const int x8 = L & 7, kk = L >> 3, b = x8 >> 1, kvh = x8 & 1, head = kvh * 4 + (kk >> 3), x = kk & 7;
                            const int qb = pass ? 15 - x : x;
                            att::BlockRef r;
                            r.Q = Q1 + ((size_t)(b * 8 + head) * SEQ + qb * 256) * 128; r.K = K1 + (size_t)(b * 2 + kvh) * SEQ * 128;
                            r.O = MIX + ((size_t)b * SEQ + qb * 256) * DM + head * 128; r.MW = MASK + (size_t)b * 64 * SEQ + qb * 256; r.P0 = qb * 256;
                            return r; };
                        int L = bx;
                        if (L < 256) {
                            int pass = 0; att::BlockRef cur = mkref(L, 0);
                            const int atid = fresh_tid();
                            att::attn_prime(cur, (char*)lds, S, atid);
                            for (;;) {
                                const bool more_pass = pass == 0, more_item = L + G < 256, last = !more_pass && !more_item;
                                int passn = pass + 1, Ln = L;
                                if (!more_pass) { passn = 0; Ln = more_item ? L + G : L; }
                                const att::BlockRef nxt = last ? cur : mkref(Ln, passn);
                                att::attn_block(cur, nxt, (char*)lds, S, atid);
                                if (last) break;
                                cur = nxt; pass = passn; L = Ln;
                            }
                        }
                    }
    }
#endif
                    GSYNC();
                }
#ifndef NO_OUTP
    for (int dup_ = 0; dup_ < NDUP_OUTP; ++dup_) { if (dup_) { GSYNC(); }
                { PHASE_ARGS(); pg8::Gemm g{MIX, (const bf16_t*)(ws + (li == 0 ? WS_EVOUT : WS_ODOUT)), M, DM, DM}; pg8::StaticOrder S; S.init(M, DM, G, bx);
                  pg8::EpiRes E{HB, SSQ, dup_ ? 0.0f : 1.0f};
                  pg8::gemm_phase<pg8::EpiRes, pg8::StaticOrder, true, true>(ldsl, g, S, E, fresh_tid()); }
    }
#endif
                GSYNC();
            }
#ifndef NO_UP
    for (int dup_ = 0; dup_ < NDUP_UP; ++dup_) { if (dup_) { GSYNC(); }
            { PHASE_ARGS(); pg8::Gemm g{HB, (const bf16_t*)(ws + WS_WIT + (size_t)(li * 2 + f) * 11 * MiB), M, NFF, DM}; pg8::StaticOrder S; S.init(M, NFF, G, bx);
              pg8::EpiUp E{SSQ, HID};
              pg8::gemm_phase<pg8::EpiUp, pg8::StaticOrder, true, true>(ldsl, g, S, E, fresh_tid()); }
            if (bx >= (M / 256) * (NFF / 256) % 256 && G == 256) { PHASE_IDS(); const int widx = (bx - 128) * 8 + wave, nw = 128 * 8; LAS unsigned char* scr = ldsl + wave * 16384;
                if (li == 0 && f == 0) { conv_range(A, ws, CV_WO(0), CV_WO(1), widx, nw, scr, lane);
                              conv_range(A, ws, CV_EV, CV_OD, widx, nw, scr, lane); conv_range(A, ws, CV_EO, CV_OO, widx, nw, scr, lane); conv_extras_even(A, ws, widx, nw, lane); }
                else if (li == 0) { conv_range(A, ws, CV_WI(2), CV_WI(3), widx, nw, scr, lane); conv_range(A, ws, CV_WO(2), CV_WO(3), widx, nw, scr, lane); }
                else if (f == 0) { conv_range(A, ws, CV_OD, CV_EO, widx, nw, scr, lane); conv_range(A, ws, CV_OO, CV_END, widx, nw, scr, lane); conv_zero_pad_odd(ws, widx, nw, lane);
                              conv_range(A, ws, CV_WI(3), CV_WI(4), widx, nw, scr, lane); }
                else conv_range(A, ws, CV_WO(3), CV_WO(4), widx, nw, scr, lane); }
    }
#endif
            GSYNC();
#ifndef NO_DOWN
    for (int dup_ = 0; dup_ < NDUP_DOWN; ++dup_) { if (dup_) { GSYNC(); }
            { PHASE_ARGS(); pg8::Gemm g{HID, (const bf16_t*)(ws + WS_WOT + (size_t)(li * 2 + f) * 5632 * 1024), M, DM, DFF}; pg8::StaticOrder S; S.init(M, DM, G, bx);
              pg8::EpiRes E{HB, SSQ, dup_ ? 0.0f : 0.5f};
              pg8::gemm_phase<pg8::EpiRes, pg8::StaticOrder, true, true>(ldsl, g, S, E, fresh_tid()); }
    }
#endif
            GSYNC();
        }
    }
    { PHASE_IDS();
    const f32x4* gn = (const f32x4*)A.final_norm + lane * 2;
    const f32x4 g0 = gn[0], g1 = gn[1], g2 = gn[128], g3 = gn[129];
    auto fin_load = [&](int m0, u32x4 (&v)[4][2], f32x4 (&sq)[4][4]) {
#pragma unroll
        for (int i = 0; i < 4; ++i) { const u32x4* xr = (const u32x4*)(HB + (size_t)(m0 + i) * DM) + lane; v[i][0] = xr[0]; v[i][1] = xr[64];
            const f32x4* sp = (const f32x4*)(SSQ + (size_t)(m0 + i) * 16); sq[i][0] = sp[0]; sq[i][1] = sp[1]; sq[i][2] = sp[2]; sq[i][3] = sp[3]; } };
    u32x4 vc[4][2]; f32x4 sc_[4][4];
    int m0 = gw * 4;
    if (m0 < M) fin_load(m0, vc, sc_);
    for (; m0 < M; m0 += NGW * 4) {
        u32x4 vn[4][2]; f32x4 sn[4][4]; const int m1 = m0 + NGW * 4;
        if (m1 < M) fin_load(m1, vn, sn);
        else {
#pragma unroll
            for (int i = 0; i < 4; ++i) { vn[i][0] = vc[i][0]; vn[i][1] = vc[i][1]; sn[i][0] = sc_[i][0]; sn[i][1] = sc_[i][1]; sn[i][2] = sc_[i][2]; sn[i][3] = sc_[i][3]; } }
#pragma unroll
        for (int i = 0; i < 4; ++i) {
            const f32x4 a = sc_[i][0], b = sc_[i][1], c = sc_[i][2], d = sc_[i][3];
            const float ssum = ((a[0] + a[1]) + (a[2] + a[3])) + ((b[0] + b[1]) + (b[2] + b[3])) + ((c[0] + c[1]) + (c[2] + c[3])) + ((d[0] + d[1]) + (d[2] + d[3]));
            const float rs = __builtin_amdgcn_rsqf(ssum * (1.0f / 1024.0f) + RMS_EPS);
            f32x4* xr = (f32x4*)(A.out + (size_t)(m0 + i) * DM) + lane * 2; f32x4 a0, a1, a2, a3; unpack8(vc[i][0], a0, a1); unpack8(vc[i][1], a2, a3);
            xr[0] = a0 * rs * g0; xr[1] = a1 * rs * g1; xr[128] = a2 * rs * g2; xr[129] = a3 * rs * g3; }
#pragma unroll
        for (int i = 0; i < 4; ++i) { vc[i][0] = vn[i][0]; vc[i][1] = vn[i][1]; sc_[i][0] = sn[i][0]; sc_[i][1] = sn[i][1]; sc_[i][2] = sn[i][2]; sc_[i][3] = sn[i][3]; }
    } }
#undef GSYNC
}

extern "C" void kernel_launch(void* const* d_in, const int* in_sizes, int n_in, void* d_out, int out_size, void* d_ws, size_t ws_size, hipStream_t stream) {
    static int grid = 0;
    if (grid == 0) {
        if (n_in != 19 || in_sizes[0] != M * DM || out_size != M * DM || ws_size < WS_END) { fprintf(stderr, "kernel_launch: unexpected shapes n_in %d in0 %d out %d ws %zu\n", n_in, n_in > 0 ? in_sizes[0] : -1, out_size, ws_size); grid = -1; return; }
        int dev = 0, cus = 0, per_cu = 0;
        if (hipGetDevice(&dev) != hipSuccess || hipDeviceGetAttribute(&cus, hipDeviceAttributeMultiprocessorCount, dev) != hipSuccess) { grid = -1; return; }
        if (hipFuncSetAttribute((const void*)fwd_megakernel, hipFuncAttributeMaxDynamicSharedMemorySize, LDS_BYTES) != hipSuccess) { fprintf(stderr, "kernel_launch: hipFuncSetAttribute failed\n"); grid = -1; return; }
        if (hipOccupancyMaxActiveBlocksPerMultiprocessor(&per_cu, (const void*)fwd_megakernel, 512, LDS_BYTES) != hipSuccess || per_cu < 1) { fprintf(stderr, "kernel_launch: occupancy query gave %d\n", per_cu); (void)hipGetLastError(); grid = -1; return; }
        grid = cus;
    }
    if (grid < 0) return;
    (void)hipMemsetAsync((char*)d_ws + WS_CTL + 16384, 0, 16384, stream);
    KArgs a{};
    a.x = (const float*)d_in[0]; a.pos = (const int*)d_in[1]; a.ffn1_norm = (const float*)d_in[2]; a.ffn1_wi = (const float*)d_in[3]; a.ffn1_wo = (const float*)d_in[4];
    a.mix_norm = (const float*)d_in[5]; a.ffn2_norm = (const float*)d_in[6]; a.ffn2_wi = (const float*)d_in[7]; a.ffn2_wo = (const float*)d_in[8];
    a.even_w_in = (const float*)d_in[9]; a.gate_w = (const float*)d_in[10]; a.gate_b = (const float*)d_in[11]; a.out_norm = (const float*)d_in[12];
    a.pool_w = (const float*)d_in[13]; a.pool_scale = (const float*)d_in[14]; a.even_w_out = (const float*)d_in[15]; a.odd_w_in = (const float*)d_in[16];
    a.odd_w_out = (const float*)d_in[17]; a.final_norm = (const float*)d_in[18];
    a.out = (float*)d_out; a.ws = (unsigned char*)d_ws;
    void* args[] = {&a};
    hipError_t e = hipLaunchCooperativeKernel((const void*)fwd_megakernel, dim3(grid), dim3(512), args, LDS_BYTES, stream);
    if (e != hipSuccess) fprintf(stderr, "cooperative launch failed: %s (grid %d)\n", hipGetErrorString(e), grid);
}
```
